# Optimizing an MI355X kernel written in HIP

```python
import jax, jax.numpy as jnp
from jax import lax
import numpy as np

D_MODEL = 4096
BATCH = 2
SEQ = 8192
DEPTH = 2

N_MIXERS = 2
HEAD_DIM = 128
ROPE_THETA = 10000.0
NORM_EPS = 1e-6
DILATED_GROUPS = ((128, 1), (512, 4), (2048, 16))
N_GROUPS = 3
A_HEADS_PER_GROUP = 16
A_BLOCK = 128
A_IN_WIDTH = N_GROUPS * 3 * A_HEADS_PER_GROUP * HEAD_DIM
A_OUT_WIDTH = A_HEADS_PER_GROUP * HEAD_DIM
B_HEADS = 32
B_KV_HEADS = 8
IDX_HEADS = 32
IDX_DIM = 128
IDX_Q_RANK = 1024
TOPK_MAX = 256
B_QBLOCK = 128
B_Q_WIDTH = B_HEADS * HEAD_DIM
B_KV_WIDTH = B_KV_HEADS * HEAD_DIM
B_IN_WIDTH = B_Q_WIDTH + 2 * B_KV_WIDTH + IDX_Q_RANK + IDX_DIM + IDX_HEADS
D_FF = 4 * D_MODEL
N_A_LAYERS = (DEPTH + 1) // 2
N_B_LAYERS = DEPTH // 2

kernel_name = "hybrid_dilated_dsa_sqrelu_trunk"


def rms_norm(x, g):
    xf = x.astype(jnp.float32)
    y = xf * lax.rsqrt(jnp.mean(xf * xf, axis=-1, keepdims=True) + NORM_EPS)
    return (y * g.astype(jnp.float32)).astype(x.dtype)


def layer_norm(x, g, b):
    xf = x.astype(jnp.float32)
    mu = jnp.mean(xf, axis=-1, keepdims=True)
    xc = xf - mu
    y = xc * lax.rsqrt(jnp.mean(xc * xc, axis=-1, keepdims=True) + NORM_EPS)
    return (y * g.astype(jnp.float32) + b.astype(jnp.float32)).astype(x.dtype)


def rope_tables(positions, dim):
    inv_freq = ROPE_THETA ** (-jnp.arange(0, dim, 2, dtype=jnp.float32) / dim)
    ang = positions.astype(jnp.float32)[..., None] * inv_freq
    return jnp.cos(ang), jnp.sin(ang)


def apply_rope(x, cos, sin):
    extra = (1,) * (x.ndim - 3)
    c = cos.reshape(cos.shape[:2] + extra + cos.shape[2:])
    s = sin.reshape(sin.shape[:2] + extra + sin.shape[2:])
    x1, x2 = jnp.split(x.astype(jnp.float32), 2, axis=-1)
    return jnp.concatenate([x1 * c - x2 * s, x2 * c + x1 * s], axis=-1).astype(x.dtype)


def dilated_window_attention(q, k, v, window, dilation):
    B, S, H, hd = q.shape
    r = dilation
    w = window // dilation
    n = S // r
    nb = -(-n // A_BLOCK)
    n_pad = nb * A_BLOCK

    def to_sub(t):
        t = t.reshape(B, n, r, H, hd).transpose(0, 2, 1, 3, 4)
        t = jnp.pad(t, ((0, 0), (0, 0), (0, n_pad - n), (0, 0), (0, 0)))
        return t.reshape(B, r, nb, A_BLOCK, H, hd)

    def with_prev(t):
        prev = jnp.pad(t, ((0, 0), (0, 0), (1, 0), (0, 0), (0, 0), (0, 0)))[:, :, :-1]
        return jnp.concatenate([prev, t], axis=3)

    qs, ks, vs = to_sub(q), to_sub(k), to_sub(v)
    kb, vb = with_prev(ks), with_prev(vs)
    logits = jnp.einsum('bcnqhd,bcnkhd->bcnhqk', qs.astype(jnp.float32),
                        kb.astype(jnp.float32)) * (hd ** -0.5)
    qi = jnp.arange(A_BLOCK)[:, None] + A_BLOCK
    kj = jnp.arange(2 * A_BLOCK)[None, :]
    dist = qi - kj
    band = (dist >= 0) & (dist <= w)
    has_prev = (jnp.arange(nb)[:, None, None] > 0) | (kj >= A_BLOCK)[None]
    mask = band[None] & has_prev
    logits = jnp.where(mask[None, None, :, None], logits, -jnp.inf)
    m = jnp.max(logits, axis=-1, keepdims=True)
    p = jnp.exp(logits - m)
    l = jnp.sum(p, axis=-1, keepdims=True)
    o = jnp.einsum('bcnhqk,bcnkhd->bcnqhd', p / l, vb.astype(jnp.float32))
    lse = (m + jnp.log(l))[..., 0]
    o = o.reshape(B, r, n_pad, H, hd)[:, :, :n].transpose(0, 2, 1, 3, 4).reshape(B, S, H, hd)
    lse = lse.transpose(0, 1, 2, 4, 3).reshape(B, r, n_pad, H)[:, :, :n]
    lse = lse.transpose(0, 2, 1, 3).reshape(B, S, H)
    return o, lse


def mixer_dilated(h, cos, sin, w_in, w_out):
    B, S, _ = h.shape
    qkv = (h @ w_in).reshape(B, S, N_GROUPS, 3, A_HEADS_PER_GROUP, HEAD_DIM)
    outs, lses = [], []
    for g, (window, dil) in enumerate(DILATED_GROUPS):
        q = apply_rope(qkv[:, :, g, 0], cos, sin)
        k = apply_rope(qkv[:, :, g, 1], cos, sin)
        o, lse = dilated_window_attention(q, k, qkv[:, :, g, 2], window, dil)
        outs.append(o)
        lses.append(lse)
    alpha = jax.nn.softmax(jnp.stack(lses, axis=0), axis=0)
    o = jnp.sum(alpha[..., None] * jnp.stack(outs, axis=0), axis=0)
    return o.reshape(B, S, A_OUT_WIDTH).astype(h.dtype) @ w_out


def mixer_sparse(h, cos, sin, w_in, idx_q_norm, w_idx_up, idx_k_w, idx_k_b, w_out):
    B, S, _ = h.shape
    splits = [int(s) for s in np.cumsum([B_Q_WIDTH, B_KV_WIDTH, B_KV_WIDTH, IDX_Q_RANK, IDX_DIM])]
    q, k, v, iq_lat, ik, iw = jnp.split(h @ w_in, splits, axis=-1)
    q = apply_rope(q.reshape(B, S, B_HEADS, HEAD_DIM), cos, sin)
    k = apply_rope(k.reshape(B, S, B_KV_HEADS, HEAD_DIM), cos, sin)
    v = v.reshape(B, S, B_KV_HEADS, HEAD_DIM)
    iq = (rms_norm(iq_lat, idx_q_norm) @ w_idx_up).reshape(B, S, IDX_HEADS, IDX_DIM)
    iq = apply_rope(iq, cos, sin)
    ik = apply_rope(layer_norm(ik, idx_k_w, idx_k_b), cos, sin).astype(jnp.float32)
    iw = iw.astype(jnp.float32) * (IDX_HEADS ** -0.5 * IDX_DIM ** -0.5)
    n_sel = min(TOPK_MAX, S // 4)
    nb = S // B_QBLOCK
    kpos = jnp.arange(S)
    bidx = jnp.arange(B)[:, None, None]

    def blocks(t):
        return t.reshape((B, nb, B_QBLOCK) + t.shape[2:]).swapaxes(0, 1)

    def one_block(args):
        q_b, iq_b, iw_b, start = args
        tpos = start + jnp.arange(B_QBLOCK)
        rel = jax.nn.relu(jnp.einsum('bqhd,bkd->bqhk', iq_b.astype(jnp.float32), ik))
        score = jnp.einsum('bqhk,bqh->bqk', rel, iw_b)
        causal = kpos[None, :] <= tpos[:, None]
        score = jnp.where(causal[None], score, -jnp.inf)
        _, sel = lax.top_k(score, n_sel)
        valid = sel <= tpos[None, :, None]
        k_sel = k[bidx, sel].astype(jnp.float32)
        v_sel = v[bidx, sel].astype(jnp.float32)
        qg = q_b.reshape(B, B_QBLOCK, B_KV_HEADS, B_HEADS // B_KV_HEADS, HEAD_DIM).astype(jnp.float32)
        logits = jnp.einsum('bqgrd,bqkgd->bqgrk', qg, k_sel) * (HEAD_DIM ** -0.5)
        logits = jnp.where(valid[:, :, None, None, :], logits, -jnp.inf)
        p = jax.nn.softmax(logits, axis=-1)
        o = jnp.einsum('bqgrk,bqkgd->bqgrd', p, v_sel)
        return o.reshape(B, B_QBLOCK, B_Q_WIDTH).astype(h.dtype)

    starts = jnp.arange(nb) * B_QBLOCK
    o = lax.map(one_block, (blocks(q), blocks(iq), blocks(iw), starts))
    o = o.swapaxes(0, 1).reshape(B, S, B_Q_WIDTH)
    return o @ w_out


def setup_inputs(seed: int = 0) -> dict:
    key = jax.random.key(seed)
    ks = jax.random.split(key, 16)

    def nrm(k, shape, fan_in):
        return jax.random.normal(k, shape, jnp.float32) * (fan_in ** -0.5)

    def gain(k, shape):
        return 1.0 + 0.02 * jax.random.normal(k, shape, jnp.float32)

    x = jax.random.normal(ks[0], (BATCH, SEQ, D_MODEL), jnp.float32)
    positions = jnp.broadcast_to(jnp.arange(SEQ, dtype=jnp.int32)[None, :], (BATCH, SEQ))
    return {
        "x": x,
        "positions": positions,
        "attn_pre_norm": gain(ks[1], (DEPTH, D_MODEL)),
        "attn_post_norm": gain(ks[2], (DEPTH, D_MODEL)),
        "mlp_pre_norm": gain(ks[3], (DEPTH, D_MODEL)),
        "mlp_post_norm": gain(ks[4], (DEPTH, D_MODEL)),
        "w_in_a": nrm(ks[5], (N_A_LAYERS, D_MODEL, A_IN_WIDTH), D_MODEL),
        "w_out_a": nrm(ks[6], (N_A_LAYERS, A_OUT_WIDTH, D_MODEL), A_OUT_WIDTH),
        "w_in_b": nrm(ks[7], (N_B_LAYERS, D_MODEL, B_IN_WIDTH), D_MODEL),
        "idx_q_norm": gain(ks[8], (N_B_LAYERS, IDX_Q_RANK)),
        "w_idx_up": nrm(ks[9], (N_B_LAYERS, IDX_Q_RANK, IDX_HEADS * IDX_DIM), IDX_Q_RANK),
        "idx_k_norm_w": gain(ks[10], (N_B_LAYERS, IDX_DIM)),
        "idx_k_norm_b": 0.02 * jax.random.normal(ks[11], (N_B_LAYERS, IDX_DIM), jnp.float32),
        "w_out_b": nrm(ks[12], (N_B_LAYERS, B_Q_WIDTH, D_MODEL), B_Q_WIDTH),
        "w_up": nrm(ks[13], (DEPTH, D_MODEL, D_FF), D_MODEL),
        "w_down": nrm(ks[14], (DEPTH, D_FF, D_MODEL), D_FF),
    }


def reference(x, positions, attn_pre_norm, attn_post_norm, mlp_pre_norm, mlp_post_norm,
              w_in_a, w_out_a, w_in_b, idx_q_norm, w_idx_up, idx_k_norm_w, idx_k_norm_b,
              w_out_b, w_up, w_down):
    cos, sin = rope_tables(positions, HEAD_DIM)
    h = x
    for i in range(DEPTH):
        j = i // N_MIXERS
        a = rms_norm(h, attn_pre_norm[i])
        if i % N_MIXERS == 0:
            m = mixer_dilated(a, cos, sin, w_in_a[j], w_out_a[j])
        else:
            m = mixer_sparse(a, cos, sin, w_in_b[j], idx_q_norm[j], w_idx_up[j],
                             idx_k_norm_w[j], idx_k_norm_b[j], w_out_b[j])
        h = h + rms_norm(m, attn_post_norm[i])
        f = rms_norm(h, mlp_pre_norm[i])
        f = jnp.square(jax.nn.relu(f @ w_up[i])) @ w_down[i]
        h = h + rms_norm(f, mlp_post_norm[i])
    return h
```

```cpp
#include <hip/hip_runtime.h>
#include <cstdio>
#include <cstdint>
namespace pg8 {
#define PG8_LAS __attribute__((address_space(3)))
typedef unsigned short bf16_t;
typedef short bf16x8 __attribute__((ext_vector_type(8)));
typedef float f32x4 __attribute__((ext_vector_type(4)));
typedef unsigned u32x4 __attribute__((ext_vector_type(4)));
constexpr int BM = 256, BK = 64, HALF = 128, HTB = HALF * BK * 2  , STAGE_BYTES = 8 * HTB, NXCD = 8, WGM = 8;

__host__ __device__ __forceinline__ int lds_byte(int r, int c) { const int st = (r >> 4) * 2 + (c >> 5), rr = r & 15, cc = c & 31, ob = rr * 64 + cc * 2; return st * 1024 + (ob ^ (((ob >> 9) & 1) << 5)); }
__host__ __device__ __forceinline__ void stage_rc(int b, int& R, int& C) { const int st = b / 1024, sb = b % 1024, swz = sb ^ (((sb >> 9) & 1) << 5); R = (st >> 1) * 16 + swz / 64; C = (st & 1) * 32 + (swz % 64) / 2; }
__host__ __device__ __forceinline__ int perm32(int rho) { const int n = rho >> 4, i = rho & 15; return 8 * (i >> 2) + 4 * n + (i & 3); }

struct Unit { int pm, pn; };
struct Gemm { const bf16_t* A; const bf16_t* Bt; int M, N, K; };

struct StaticOrder {
    int nM, nN, nwg, G, c;
    __host__ __device__ void init(int M, int N, int G_, int c_) { nM = M / BM; nN = N / BM; nwg = nM * nN; G = G_; c = c_; }
    __host__ __device__ bool next(int i, Unit& u) const {
        const long L = (long)i * G + c; if (L >= nwg) return false;
        int wgid = (int)L; { const int q = nwg / NXCD, r = nwg % NXCD, xcd = wgid % NXCD, off = wgid / NXCD; wgid = (xcd < r ? xcd * (q + 1) : r * (q + 1) + (xcd - r) * q) + off; }
        const int nig = WGM * nN, gid = wgid / nig, fm = gid * WGM, gsz = (nM - fm) < WGM ? (nM - fm) : WGM;
        u.pm = fm + ((wgid % nig) % gsz); u.pn = (wgid % nig) / gsz; return true;
    }
    __device__ __forceinline__ void a_ready(const Unit&) const {}
    __device__ __forceinline__ void done(const Unit&) const {}
};

__device__ __forceinline__ unsigned cvt_pk_bf16(float lo, float hi) { unsigned r; asm volatile("v_cvt_pk_bf16_f32 %0, %1, %2" : "=v"(r) : "v"(lo), "v"(hi)); return r; }

struct EpiF32 {
    static constexpr bool PERM = false, AFTER_DRAIN = false;
    float* C; int ldc;
    __device__ __forceinline__ void operator()(const f32x4 (&acc)[2][2][4][2], const Unit& u, int wr, int wc, int fr, int fq) const {
        const int row0 = u.pm * BM + wr * 64 + fr, col0 = u.pn * BM + wc * 32 + 4 * fq;
#pragma unroll
        for (int ai = 0; ai < 2; ++ai)
#pragma unroll
            for (int m = 0; m < 4; ++m) { float* rowp = C + (size_t)(row0 + ai * HALF + m * 16) * ldc + col0;
#pragma unroll
                for (int bj = 0; bj < 2; ++bj)
#pragma unroll
                    for (int n = 0; n < 2; ++n) *(f32x4*)(rowp + bj * HALF + n * 16) = acc[ai][bj][m][n]; }
    }
};
template <int ACT> struct EpiBf16 {
    static constexpr bool PERM = true, AFTER_DRAIN = false;
    bf16_t* O; int ldc;
    __device__ __forceinline__ void operator()(const f32x4 (&acc)[2][2][4][2], const Unit& u, int wr, int wc, int fr, int fq) const {
        const int row0 = u.pm * BM + wr * 64 + fr, col0 = u.pn * BM + wc * 32 + 8 * fq;
#pragma unroll
        for (int ai = 0; ai < 2; ++ai)
#pragma unroll
            for (int m = 0; m < 4; ++m) { bf16_t* rowp = O + (size_t)(row0 + ai * HALF + m * 16) * ldc + col0;
#pragma unroll
                for (int bj = 0; bj < 2; ++bj) { f32x4 v0 = acc[ai][bj][m][0], v1 = acc[ai][bj][m][1];
#pragma unroll
                    for (int j = 0; j < 4; ++j) { if (ACT == 1) { const float a = fmaxf(v0[j], 0.f), b = fmaxf(v1[j], 0.f); v0[j] = a * a; v1[j] = b * b; } }
                    u32x4 w; w.x = cvt_pk_bf16(v0[0], v0[1]); w.y = cvt_pk_bf16(v0[2], v0[3]); w.z = cvt_pk_bf16(v1[0], v1[1]); w.w = cvt_pk_bf16(v1[2], v1[3]);
                    *(u32x4*)(rowp + bj * HALF) = w; } }
    }
};
struct HeadTile { bf16_t* out; float* outf; int ldc; int col; int rope; float scale; };
template <class TileFn> struct EpiHead {
    static constexpr bool PERM = true, AFTER_DRAIN = false;
    TileFn fn; const float* rope;
    __device__ __forceinline__ void operator()(const f32x4 (&acc)[2][2][4][2], const Unit& u, int wr, int wc, int fr, int fq) const {
        const HeadTile t = fn(u.pn);
        const int row0 = u.pm * BM + wr * 64 + fr;
        const int dlo = 32 * (wc & 1) + 8 * fq;
        const int ncol = t.col + 128 * (wc >> 1) + dlo;
#pragma unroll
        for (int ai = 0; ai < 2; ++ai)
#pragma unroll
            for (int m = 0; m < 4; ++m) { const int row = row0 + ai * HALF + m * 16;
                f32x4 lo0 = acc[ai][0][m][0], lo1 = acc[ai][0][m][1], hi0 = acc[ai][1][m][0], hi1 = acc[ai][1][m][1];
                if (t.rope) { const float* rp = rope + (size_t)row * 128 + dlo;
                    const f32x4 c0 = *(const f32x4*)(rp), c1 = *(const f32x4*)(rp + 4), s0 = *(const f32x4*)(rp + 64), s1 = *(const f32x4*)(rp + 68);
                    const f32x4 a0 = lo0 * c0 - hi0 * s0, a1 = lo1 * c1 - hi1 * s1, b0 = hi0 * c0 + lo0 * s0, b1 = hi1 * c1 + lo1 * s1;
                    lo0 = a0; lo1 = a1; hi0 = b0; hi1 = b1; }
                lo0 = lo0 * t.scale; lo1 = lo1 * t.scale; hi0 = hi0 * t.scale; hi1 = hi1 * t.scale;
                if (t.outf) { float* p = t.outf + (size_t)row * t.ldc + ncol;
                    *(f32x4*)(p) = lo0; *(f32x4*)(p + 4) = lo1; *(f32x4*)(p + 64) = hi0; *(f32x4*)(p + 68) = hi1; }
                else { bf16_t* p = t.out + (size_t)row * t.ldc + ncol;
                    u32x4 w; w.x = cvt_pk_bf16(lo0[0], lo0[1]); w.y = cvt_pk_bf16(lo0[2], lo0[3]); w.z = cvt_pk_bf16(lo1[0], lo1[1]); w.w = cvt_pk_bf16(lo1[2], lo1[3]);
                    *(u32x4*)(p) = w;
                    w.x = cvt_pk_bf16(hi0[0], hi0[1]); w.y = cvt_pk_bf16(hi0[2], hi0[3]); w.z = cvt_pk_bf16(hi1[0], hi1[1]); w.w = cvt_pk_bf16(hi1[2], hi1[3]);
                    *(u32x4*)(p + 64) = w; } }
    }
};

template <class Epi, class Sched, bool ALIGN_EPI = false, bool SP2 = false>
__device__ __forceinline__ void gemm_phase(PG8_LAS unsigned char* lds, const Gemm g, const Sched& S, const Epi& E) {
    const int tid = threadIdx.x, wid = __builtin_amdgcn_readfirstlane(tid >> 6), lane = tid & 63, wr = wid >> 2, wc = wid & 3, fr = lane & 15, fq = lane >> 4;
    const int K = g.K, nt = K / BK;
    unsigned voffA[2], voffB[2];
#pragma unroll
    for (int i = 0; i < 2; ++i) { int R, C; stage_rc(tid * 16 + i * 8192, R, C); const int Rb = Epi::PERM ? ((R & ~31) + perm32(R & 31)) : R;
        voffA[i] = (unsigned)(R * K + C) * 2u; voffB[i] = (unsigned)(Rb * K + C) * 2u; }
    const size_t kstep = (size_t)(BK * 2);
    const size_t hstep = (size_t)HALF * K * 2;
    const size_t tstep = 2 * hstep;
    const unsigned ldsw = (unsigned)wid * 1024u;
    const int aoff = lds_byte(wr * 64 + fr, fq * 8), boff = lds_byte(wc * 32 + fr, fq * 8);
#define PG8_SA(b, h) (((b) * 2 + (h)) * HTB)
#define PG8_SB(b, h) ((4 + (b) * 2 + (h)) * HTB)
#define PG8_STAGE(bufoff, gbase, voff) do { _Pragma("unroll") for (int _i = 0; _i < 2; ++_i) \
        __builtin_amdgcn_global_load_lds((const unsigned*)((const char*)(gbase) + (voff)[_i]), (PG8_LAS unsigned*)(lds + (bufoff) + ldsw + _i * 8192), 16, 0, 0); } while (0)
#define PG8_LDA(dst, b, h) do { _Pragma("unroll") for (int m = 0; m < 4; ++m) _Pragma("unroll") for (int k = 0; k < 2; ++k) dst[m][k] = *(const PG8_LAS bf16x8*)(lds + PG8_SA(b, h) + aoff + m * 2048 + k * 1024); } while (0)
#define PG8_LDB(dst, b, h) do { _Pragma("unroll") for (int n = 0; n < 2; ++n) _Pragma("unroll") for (int k = 0; k < 2; ++k) dst[n][k] = *(const PG8_LAS bf16x8*)(lds + PG8_SB(b, h) + boff + n * 2048 + k * 1024); } while (0)
#define PG8_MMA(ai, bj, At, Bt) do { __builtin_amdgcn_s_setprio(1); _Pragma("unroll") for (int m = 0; m < 4; ++m) _Pragma("unroll") for (int n = 0; n < 2; ++n) _Pragma("unroll") for (int k = 0; k < 2; ++k) \
        acc[ai][bj][m][n] = __builtin_amdgcn_mfma_f32_16x16x32_bf16(Bt[n][k], At[m][k], acc[ai][bj][m][n], 0, 0, 0); __builtin_amdgcn_s_setprio(0); } while (0)
#define PG8_WAIT_V(n) asm volatile("s_waitcnt vmcnt(" #n ")" ::: "memory")
#define PG8_WAIT_L(n) asm volatile("s_waitcnt lgkmcnt(" #n ")" ::: "memory")
#define PG8_BAR __builtin_amdgcn_s_barrier()
#define PG8_SCHED __builtin_amdgcn_sched_barrier(0)
    Unit cur, nxt; int ui = 0;
    if (!S.next(0, cur)) return;
    f32x4 acc[2][2][4][2];
#pragma unroll
    for (int a = 0; a < 2; ++a)
#pragma unroll
        for (int b = 0; b < 2; ++b)
#pragma unroll
            for (int m = 0; m < 4; ++m)
#pragma unroll
                for (int n = 0; n < 2; ++n) acc[a][b][m][n] = (f32x4){0.f, 0.f, 0.f, 0.f};
    bf16x8 At[4][2], B0[2][2], B1[2][2];
    const char* cA = (const char*)g.A + (size_t)cur.pm * tstep; const char* cB = (const char*)g.Bt + (size_t)cur.pn * tstep;
    S.a_ready(cur);
    if constexpr (SP2) {
        PG8_STAGE(PG8_SB(0, 0), cB, voffB); PG8_STAGE(PG8_SB(0, 1), cB + hstep, voffB); PG8_STAGE(PG8_SA(0, 0), cA, voffA); PG8_STAGE(PG8_SA(0, 1), cA + hstep, voffA);
        if (wr == 1) PG8_BAR;
        PG8_WAIT_V(2); PG8_BAR;
        PG8_STAGE(PG8_SB(1, 0), cB + kstep, voffB); PG8_STAGE(PG8_SA(1, 0), cA + kstep, voffA); PG8_STAGE(PG8_SB(1, 1), cB + hstep + kstep, voffB);
        PG8_WAIT_V(6); PG8_BAR;
    } else {
        PG8_STAGE(PG8_SB(0, 0), cB, voffB); PG8_STAGE(PG8_SA(0, 0), cA, voffA); PG8_STAGE(PG8_SB(0, 1), cB + hstep, voffB); PG8_STAGE(PG8_SA(0, 1), cA + hstep, voffA);
        if (wr == 1) PG8_BAR;
        PG8_WAIT_V(4); PG8_BAR;
        PG8_STAGE(PG8_SB(1, 0), cB + kstep, voffB); PG8_STAGE(PG8_SA(1, 0), cA + kstep, voffA); PG8_STAGE(PG8_SB(1, 1), cB + hstep + kstep, voffB);
        PG8_WAIT_V(6); PG8_BAR;
    }
    for (;;) {
        const bool has_next = S.next(ui + 1, nxt);
        const char* nA = has_next ? (const char*)g.A + (size_t)nxt.pm * tstep : cA; const char* nB = has_next ? (const char*)g.Bt + (size_t)nxt.pn * tstep : cB;
        for (int t = 0; t < nt; t += 2) {
            const bool last = (t == nt - 2);
            const char* a1 = cA + (size_t)(t + 1) * kstep;
            const char* a2 = last ? nA : cA + (size_t)(t + 2) * kstep; const char* b2 = last ? nB : cB + (size_t)(t + 2) * kstep;
            const char* a3 = a2 + kstep; const char* b3 = b2 + kstep;
            if (last && has_next) S.a_ready(nxt);
            if constexpr (SP2) {
            PG8_LDB(B0, 0, 0); PG8_LDB(B1, 0, 1); PG8_SCHED; PG8_LDA(At, 0, 0); PG8_STAGE(PG8_SA(1, 1), a1 + hstep, voffA);
            PG8_WAIT_V(8); PG8_WAIT_L(0); PG8_BAR; PG8_MMA(0, 0, At, B0); PG8_MMA(0, 1, At, B1); PG8_BAR; PG8_SCHED;
            PG8_LDA(At, 0, 1); PG8_STAGE(PG8_SB(0, 0), b2, voffB); PG8_STAGE(PG8_SB(0, 1), b2 + hstep, voffB); PG8_STAGE(PG8_SA(0, 0), a2, voffA);
            PG8_WAIT_V(8); PG8_WAIT_L(0); PG8_BAR; PG8_MMA(1, 0, At, B0); PG8_MMA(1, 1, At, B1); PG8_BAR; PG8_SCHED;
            PG8_LDB(B0, 1, 0); PG8_LDB(B1, 1, 1); PG8_SCHED; PG8_LDA(At, 1, 0); PG8_STAGE(PG8_SA(0, 1), a2 + hstep, voffA);
            PG8_WAIT_V(8); PG8_WAIT_L(0); PG8_BAR; PG8_MMA(0, 0, At, B0); PG8_MMA(0, 1, At, B1); PG8_BAR; PG8_SCHED;
            PG8_LDA(At, 1, 1); PG8_STAGE(PG8_SB(1, 0), b3, voffB); PG8_STAGE(PG8_SB(1, 1), b3 + hstep, voffB); PG8_STAGE(PG8_SA(1, 0), a3, voffA);
            PG8_WAIT_V(8); PG8_WAIT_L(0); PG8_BAR; PG8_MMA(1, 0, At, B0); PG8_MMA(1, 1, At, B1); PG8_BAR; PG8_SCHED;
            } else {
            PG8_LDB(B0, 0, 0); PG8_SCHED; PG8_LDA(At, 0, 0); PG8_STAGE(PG8_SA(1, 1), a1 + hstep, voffA);
            PG8_WAIT_L(8); PG8_BAR; PG8_WAIT_L(0); PG8_MMA(0, 0, At, B0); PG8_BAR; PG8_SCHED;
            PG8_LDB(B1, 0, 1); PG8_STAGE(PG8_SB(0, 0), b2, voffB);
            PG8_BAR; PG8_WAIT_L(0); PG8_MMA(0, 1, At, B1); PG8_BAR;
            PG8_LDA(At, 0, 1); PG8_STAGE(PG8_SA(0, 0), a2, voffA);
            PG8_BAR; PG8_WAIT_L(0); PG8_MMA(1, 0, At, B0); PG8_BAR; PG8_SCHED;
            PG8_STAGE(PG8_SB(0, 1), b2 + hstep, voffB);
            PG8_WAIT_V(6); PG8_BAR; PG8_MMA(1, 1, At, B1); PG8_BAR;
            PG8_LDB(B0, 1, 0); PG8_SCHED; PG8_LDA(At, 1, 0); PG8_STAGE(PG8_SA(0, 1), a2 + hstep, voffA);
            PG8_WAIT_L(8); PG8_BAR; PG8_WAIT_L(0); PG8_MMA(0, 0, At, B0); PG8_BAR; PG8_SCHED;
            PG8_LDB(B1, 1, 1); PG8_STAGE(PG8_SB(1, 0), b3, voffB);
            PG8_BAR; PG8_WAIT_L(0); PG8_MMA(0, 1, At, B1); PG8_BAR;
            PG8_LDA(At, 1, 1); PG8_STAGE(PG8_SA(1, 0), a3, voffA);
            PG8_BAR; PG8_WAIT_L(0); PG8_MMA(1, 0, At, B0); PG8_BAR; PG8_SCHED;
            PG8_STAGE(PG8_SB(1, 1), b3 + hstep, voffB);
            PG8_WAIT_V(6); PG8_BAR; PG8_MMA(1, 1, At, B1); PG8_BAR;
            }
        }
        if constexpr (ALIGN_EPI) { if (wr == 0) PG8_BAR; }
        if constexpr (!Epi::AFTER_DRAIN) { E(acc, cur, wr, wc, fr, fq); S.done(cur); }
        if (!has_next) break;
#pragma unroll
        for (int a = 0; a < 2; ++a)
#pragma unroll
            for (int b = 0; b < 2; ++b)
#pragma unroll
                for (int m = 0; m < 4; ++m)
#pragma unroll
                    for (int n = 0; n < 2; ++n) acc[a][b][m][n] = (f32x4){0.f, 0.f, 0.f, 0.f};
        cur = nxt; cA = nA; cB = nB; ++ui;
        if constexpr (ALIGN_EPI) { if (wr == 1) PG8_BAR; }
    }
    PG8_WAIT_V(0);
    if constexpr (!ALIGN_EPI) { if (wr == 0) PG8_BAR; }
    PG8_BAR;
    if constexpr (Epi::AFTER_DRAIN) { E.fused(acc, cur, wr, wc, fr, fq, lds, wid, lane); S.done(cur); }
#undef PG8_SA
#undef PG8_SB
#undef PG8_STAGE
#undef PG8_LDA
#undef PG8_LDB
#undef PG8_MMA
#undef PG8_WAIT_V
#undef PG8_WAIT_L
#undef PG8_BAR
#undef PG8_SCHED
}
}
#define GAS __attribute__((address_space(1)))
#define LAS __attribute__((address_space(3)))
typedef unsigned short bf16;
typedef unsigned v4u __attribute__((ext_vector_type(4)));
typedef float f32x4 __attribute__((ext_vector_type(4)));
typedef short bf16x8 __attribute__((ext_vector_type(8)));
typedef GAS unsigned gu32;
typedef GAS unsigned long long gu64;
#define RLX_AGENT __ATOMIC_RELAXED, __HIP_MEMORY_SCOPE_AGENT
#define LDS_WAIT() asm volatile("s_waitcnt lgkmcnt(0)" ::: "memory")
#define VM_WAIT() asm volatile("s_waitcnt vmcnt(0)" ::: "memory")
__device__ __forceinline__ unsigned long long rt() { return __builtin_amdgcn_s_memrealtime(); }
__device__ __forceinline__ unsigned f2bf(float f) { unsigned u = __builtin_bit_cast(unsigned, f); return (u + 0x7fffu + ((u >> 16) & 1u)) >> 16; }
__device__ __forceinline__ unsigned pk2(float lo, float hi) { return f2bf(lo) | (f2bf(hi) << 16); }
#define XB_TMO      128
#define XB_XCNT(j)  (256  + 64 * (j))
#define XB_XSUB(j)  (1280 + 64 * (j))
#define XB_XGEN(j)  (2304 + 64 * (j))
#define XB_TOP      3328
#define XB_TOPGEN   3392
#define XCD_BAR_WORDS 3456
#define XB_SPIN_CAP (1u << 18)

__device__ __forceinline__ unsigned xb_ld(unsigned* p)              { return __hip_atomic_load(p, __ATOMIC_RELAXED, __HIP_MEMORY_SCOPE_AGENT); }
__device__ __forceinline__ unsigned xb_add(unsigned* p, unsigned v) { return __hip_atomic_fetch_add(p, v, __ATOMIC_RELAXED, __HIP_MEMORY_SCOPE_AGENT); }
__device__ __forceinline__ unsigned xb_xcc_id() { return (unsigned)__builtin_amdgcn_s_getreg((3 << 11) | 20) & 0xFu; }
#define XB_SPIN(cond, bar) do { unsigned _sp = 0; while (cond) { __builtin_amdgcn_s_sleep(1); \
    if ((++_sp & 255u) == 0u) { if (xb_ld(&(bar)[XB_TMO])) break; if (_sp > XB_SPIN_CAP) { atomicAdd(&(bar)[XB_TMO], 1u); break; } } } } while (0)

struct XcdBarrier {
    unsigned* bar; unsigned x;
    volatile LAS unsigned* st;
};

__device__ __forceinline__ XcdBarrier xcd_barrier_post(unsigned* bar, volatile LAS unsigned* st) {
    XcdBarrier b; b.bar = bar; b.x = xb_xcc_id(); b.st = st;
    if (threadIdx.x == 0) (void)xb_add(&bar[XB_XCNT(b.x)], 1u);
    return b;
}
__device__ __forceinline__ void xcd_barrier_complete(unsigned* bar, unsigned x, unsigned& nloc, unsigned& nx) {
    const unsigned G = gridDim.x * gridDim.y * gridDim.z;
    unsigned sum, cnt, mine, sp = 0u;
    for (;;) {
        sum = 0u; cnt = 0u; mine = 0u;
#pragma unroll
        for (unsigned j = 0; j < 16; ++j) { const unsigned c = xb_ld(&bar[XB_XCNT(j)]); sum += c; cnt += (c > 0u) ? 1u : 0u; mine = (j == x) ? c : mine; }
        if (sum == G) break;
        __builtin_amdgcn_s_sleep(1);
        if ((++sp & 255u) == 0u) { if (xb_ld(&bar[XB_TMO])) break; if (sp > XB_SPIN_CAP) { atomicAdd(&bar[XB_TMO], 1u); break; } }
    }
    nloc = mine > 0u ? mine : 1u; nx = cnt > 0u ? cnt : 1u;
}

__device__ __forceinline__ void xcd_barrier(const XcdBarrier& b) {
    asm volatile("s_waitcnt vmcnt(0)" ::: "memory");
    __syncthreads();
    if (threadIdx.x == 0) {
        unsigned* bar = b.bar;
        __builtin_amdgcn_s_waitcnt(0);
        unsigned nloc = b.st[0], nx = b.st[1];
        if (nloc == 0u) { xcd_barrier_complete(bar, b.x, nloc, nx); b.st[0] = nloc; b.st[1] = nx; }
        const unsigned old = xb_add(&bar[XB_XSUB(b.x)], 1u);
        const unsigned gen = old / nloc;
        if (old + 1u == (gen + 1u) * nloc) {
            __builtin_amdgcn_fence(__ATOMIC_RELEASE, "agent");
            asm volatile("s_waitcnt vmcnt(0)" ::: "memory");
            const unsigned og = xb_add(&bar[XB_TOP], 1u);
            const unsigned tg = og / nx;
            if (og + 1u == (tg + 1u) * nx) xb_add(&bar[XB_TOPGEN], 1u);
            else XB_SPIN(xb_ld(&bar[XB_TOPGEN]) == tg, bar);
            __builtin_amdgcn_fence(__ATOMIC_ACQUIRE, "agent");
            xb_add(&bar[XB_XGEN(b.x)], 1u);
            asm volatile("s_waitcnt vmcnt(0)" ::: "memory");
        } else {
            XB_SPIN(xb_ld(&bar[XB_XGEN(b.x)]) == gen, bar);
            __builtin_amdgcn_fence(__ATOMIC_ACQUIRE, "agent");
            asm volatile("s_waitcnt vmcnt(0)" ::: "memory");
        }
    }
    __syncthreads();
}
constexpr int NWAVES = 8;
constexpr int BATCH = 2, SEQ = 8192, DM = 4096, M = BATCH * SEQ, HD = 128;
constexpr int A_IN = 18432, A_OUT = 2048, A_HEADS = 16;
constexpr int B_IN = 7328, B_IN_PAD = 7424, B_QW = 4096, B_KVW = 1024, IDX_RANK = 1024, IDX_HEADS = 32, TOPK = 256;
constexpr int DFF = 16384;
constexpr float NORM_EPS = 1e-6f;
constexpr float QSCALE = 0.08838834764831845f;
constexpr float IWSCALE = 0.015625f;

constexpr size_t MiB = 1u << 20;
constexpr size_t WS_CTL = 0, CTL_ZERO_BYTES = 1 * MiB;
constexpr size_t WS_ROPE = 2 * MiB;
constexpr size_t WS_W_INA = 16 * MiB;
constexpr size_t WS_W_OUTA = WS_W_INA + 144 * MiB;
constexpr size_t WS_W_INB = WS_W_OUTA + 16 * MiB;
constexpr size_t WS_W_IDX = WS_W_INB + 58 * MiB;
constexpr size_t WS_W_OUTB = WS_W_IDX + 8 * MiB;
constexpr size_t WS_W_UP = WS_W_OUTB + 32 * MiB;
constexpr size_t WS_W_DOWN = WS_W_UP + 256 * MiB;
constexpr size_t WS_XN = 800 * MiB;
constexpr size_t WS_MIX = 928 * MiB;
constexpr size_t WS_R1 = 1056 * MiB;
constexpr size_t WS_HID = WS_R1;
constexpr size_t WS_QKVA = WS_R1;
constexpr size_t WS_OG = WS_QKVA + 576 * MiB;
constexpr size_t WS_LSE = WS_OG + 192 * MiB;
constexpr size_t WS_OMERGE = WS_LSE + 4 * MiB;
constexpr size_t WS_QB = WS_R1;
constexpr size_t WS_KB = WS_QB + 128 * MiB;
constexpr size_t WS_VB = WS_KB + 32 * MiB;
constexpr size_t WS_IQL = WS_VB + 32 * MiB;
constexpr size_t WS_IKW = WS_IQL + 32 * MiB;
constexpr size_t WS_IQLN = WS_IKW + 16 * MiB;
constexpr size_t WS_IKB = WS_IQLN + 32 * MiB;
constexpr size_t WS_IWS = WS_IKB + 4 * MiB;
constexpr size_t WS_IQ = WS_IWS + 2 * MiB;
constexpr size_t WS_SEL = WS_IQ + 128 * MiB;
constexpr size_t WS_SCORE = WS_SEL + 16 * MiB;
constexpr size_t WS_OB = WS_IQL;
constexpr size_t WS_END = 1992 * MiB;
static_assert(WS_W_DOWN + 256 * MiB <= WS_XN && WS_OMERGE + 64 * MiB <= WS_END && WS_SCORE + 512 * MiB <= WS_END && WS_OB + 128 * MiB <= WS_SEL && WS_HID + 512 * MiB <= WS_END, "d_ws map");
constexpr int CW_BAR = 4096;
constexpr int N_PHASES = 20;

constexpr int RING_OFF = 0, RING_BYTES = 131072;
constexpr int LDSCTL_OFF = RING_BYTES, MISC_OFF = LDSCTL_OFF + 320;
constexpr int LDS_BYTES = 147456;
static_assert(MISC_OFF + 128 <= LDS_BYTES, "LDS map");

struct Frame {
    LAS unsigned char* lds;
    volatile LAS unsigned* MISC;
    gu32* ctl;
    int tid, lane, wave;
    int vcu, G;
    unsigned char* ws;
};
__device__ __forceinline__ float wave_sum(float v) {
#pragma unroll
    for (int o = 1; o < 64; o <<= 1) v += __shfl_xor(v, o);
    return v;
}
__device__ __forceinline__ float wave_max(float v) {
#pragma unroll
    for (int o = 1; o < 64; o <<= 1) v = fmaxf(v, __shfl_xor(v, o));
    return v;
}
__device__ __forceinline__ float bf_lo(unsigned u) { return __builtin_bit_cast(float, u << 16); }
__device__ __forceinline__ float bf_hi(unsigned u) { return __builtin_bit_cast(float, u & 0xffff0000u); }

__device__ __forceinline__ void p0_transpose_item(const float* W, int K, int N, bf16* WT, int perm, LAS float* scr, int item, int lane) {
    const int nblk = N / 32, kb = item / nblk, nb = item % nblk, k0 = 64 * kb, n0 = 32 * nb;
#pragma unroll 8
    for (int i = 0; i < 32; ++i) { const int kk = 2 * i + (lane >> 5); scr[kk * 33 + (lane & 31)] = W[(size_t)(k0 + kk) * N + n0 + (lane & 31)]; }
    LDS_WAIT(); asm volatile("" ::: "memory");
    int d0 = n0;
    if (perm) { const int blk = (n0 >> 6) & 3, sb = (blk == 1) ? 2 : (blk == 2) ? 1 : blk; d0 = (n0 & ~255) + 64 * sb + (n0 & 63); }
    const int c = lane & 7;
#pragma unroll
    for (int j = 0; j < 4; ++j) { const int n = (lane >> 3) + 8 * j; const LAS float* s = scr + (8 * c) * 33 + n;
        v4u o; o.x = pk2(s[0 * 33], s[1 * 33]); o.y = pk2(s[2 * 33], s[3 * 33]); o.z = pk2(s[4 * 33], s[5 * 33]); o.w = pk2(s[6 * 33], s[7 * 33]);
        *(GAS v4u*)(WT + (size_t)(d0 + n) * K + k0 + 8 * c) = o; }
    LDS_WAIT(); asm volatile("" ::: "memory");
}
__device__ __forceinline__ void rms_row_to_bf16(const float* xrow, const float* g, bf16* orow, int lane) {
    const GAS f32x4* xr = (const GAS f32x4*)xrow + lane; const GAS f32x4* gr = (const GAS f32x4*)g + lane;
    f32x4 v[16]; float s = 0.f;
#pragma unroll
    for (int j = 0; j < 16; ++j) { v[j] = xr[64 * j]; s += (v[j].x * v[j].x + v[j].y * v[j].y) + (v[j].z * v[j].z + v[j].w * v[j].w); }
    const float rs = 1.0f / sqrtf(wave_sum(s) * (1.f / DM) + NORM_EPS);
    GAS unsigned long long* o8 = (GAS unsigned long long*)orow + lane;
#pragma unroll
    for (int j = 0; j < 16; ++j) { const f32x4 gg = gr[64 * j]; o8[64 * j] = (unsigned long long)pk2(v[j].x * rs * gg.x, v[j].y * rs * gg.y) | ((unsigned long long)pk2(v[j].z * rs * gg.z, v[j].w * rs * gg.w) << 32); }
}
__device__ __forceinline__ void resid_norm_row(const bf16* mixrow, const float* baserow, const float* gpost, float* outrow, const float* gnext, bf16* xnrow, int lane) {
    const GAS unsigned long long* mr = (const GAS unsigned long long*)mixrow + lane; const GAS f32x4* br = (const GAS f32x4*)baserow + lane; const GAS f32x4* gp = (const GAS f32x4*)gpost + lane;
    GAS f32x4* orow = (GAS f32x4*)outrow + lane;
    f32x4 v[16]; float s = 0.f;
#pragma unroll
    for (int j = 0; j < 16; ++j) { const unsigned long long q = mr[64 * j]; const unsigned ql = (unsigned)q, qh = (unsigned)(q >> 32); v[j] = (f32x4){bf_lo(ql), bf_hi(ql), bf_lo(qh), bf_hi(qh)};
        s += (v[j].x * v[j].x + v[j].y * v[j].y) + (v[j].z * v[j].z + v[j].w * v[j].w); }
    const float rs = 1.0f / sqrtf(wave_sum(s) * (1.f / DM) + NORM_EPS);
    float s2 = 0.f;
#pragma unroll
    for (int j = 0; j < 16; ++j) { const f32x4 gg = gp[64 * j], bb = br[64 * j]; v[j] = bb + v[j] * rs * gg; orow[64 * j] = v[j];
        s2 += (v[j].x * v[j].x + v[j].y * v[j].y) + (v[j].z * v[j].z + v[j].w * v[j].w); }
    if (xnrow) {
        const float rs2 = 1.0f / sqrtf(wave_sum(s2) * (1.f / DM) + NORM_EPS);
        const GAS f32x4* gn = (const GAS f32x4*)gnext + lane; GAS unsigned long long* o8 = (GAS unsigned long long*)xnrow + lane;
#pragma unroll
        for (int j = 0; j < 16; ++j) { const f32x4 gg = gn[64 * j]; o8[64 * j] = (unsigned long long)pk2(v[j].x * rs2 * gg.x, v[j].y * rs2 * gg.y) | ((unsigned long long)pk2(v[j].z * rs2 * gg.z, v[j].w * rs2 * gg.w) << 32); }
    }
}
struct Args { const void* in[16]; float* out; unsigned char* ws; int ph_lo, ph_hi, li, pad; };

typedef float f32x16 __attribute__((ext_vector_type(16)));
#define MFMA32(a, b, c) __builtin_amdgcn_mfma_f32_32x32x16_bf16((a), (b), (c), 0, 0, 0)

__device__ __forceinline__ void p0_prologue(Frame& F, const Args& a) {
    LAS float* scr = (LAS float*)(F.lds + RING_OFF + F.wave * 16384);
    const int gw = F.vcu * NWAVES + F.wave, NGW = F.G * NWAVES;
    unsigned char* ws = F.ws;
    constexpr int I_INA = (DM / 64) * (A_IN / 32), I_OUTA = (A_OUT / 64) * (DM / 32), I_INB = (DM / 64) * (B_IN / 32), I_IDX = (IDX_RANK / 64) * (4096 / 32),
                  I_OUTB = (4096 / 64) * (DM / 32), I_UP = (DM / 64) * (DFF / 32), I_DOWN = (DFF / 64) * (DM / 32);
    constexpr int NITEMS = I_INA + I_OUTA + I_INB + I_IDX + I_OUTB + 2 * I_UP + 2 * I_DOWN;
    for (int it = gw; it < NITEMS; it += NGW) {
        int r = it;
        if (r < I_INA) { p0_transpose_item((const float*)a.in[6], DM, A_IN, (bf16*)(ws + WS_W_INA), 1, scr, r, F.lane); continue; } r -= I_INA;
        if (r < I_OUTA) { p0_transpose_item((const float*)a.in[7], A_OUT, DM, (bf16*)(ws + WS_W_OUTA), 0, scr, r, F.lane); continue; } r -= I_OUTA;
        if (r < I_INB) { p0_transpose_item((const float*)a.in[8], DM, B_IN, (bf16*)(ws + WS_W_INB), 1, scr, r, F.lane); continue; } r -= I_INB;
        if (r < I_IDX) { p0_transpose_item((const float*)a.in[10], IDX_RANK, 4096, (bf16*)(ws + WS_W_IDX), 1, scr, r, F.lane); continue; } r -= I_IDX;
        if (r < I_OUTB) { p0_transpose_item((const float*)a.in[13], 4096, DM, (bf16*)(ws + WS_W_OUTB), 0, scr, r, F.lane); continue; } r -= I_OUTB;
        if (r < 2 * I_UP) { const int l = r / I_UP; p0_transpose_item((const float*)a.in[14] + (size_t)l * DM * DFF, DM, DFF, (bf16*)(ws + WS_W_UP) + (size_t)l * DM * DFF, 0, scr, r - l * I_UP, F.lane); continue; } r -= 2 * I_UP;
        { const int l = r / I_DOWN; p0_transpose_item((const float*)a.in[15] + (size_t)l * DM * DFF, DFF, DM, (bf16*)(ws + WS_W_DOWN) + (size_t)l * DM * DFF, 0, scr, r - l * I_DOWN, F.lane); }
    }
    const int gt = F.vcu * (NWAVES * 64) + F.tid, NGT = F.G * NWAVES * 64;
    { bf16* wt = (bf16*)(ws + WS_W_INB);
      for (int i = gt; i < 96 * 512; i += NGT) { const int rr = i >> 9, row = rr < 32 ? 7264 + rr : 7360 + (rr - 32); *(GAS v4u*)(wt + (size_t)row * DM + (i & 511) * 8) = (v4u){0u, 0u, 0u, 0u}; } }
    { const int* pos = (const int*)a.in[1]; float* rope = (float*)(ws + WS_ROPE);
      for (int idx = gt; idx < M * 64; idx += NGT) { const int m = idx >> 6, i = idx & 63;
          double f = 1.0, bs = 0.8659643233600653; int e = i;
#pragma unroll
          for (int s = 0; s < 6; ++s) { if (e & 1) f *= bs; bs *= bs; e >>= 1; }
          const double th = (double)pos[m] * f;
          const double nn = __builtin_rint(th * 0.15915494309189535);
          double rr = __builtin_fma(-nn, 6.283185307179586, th); rr = __builtin_fma(-nn, 2.4492935982947064e-16, rr);
          const double kq = __builtin_rint(rr * 0.6366197723675814);
          double y = __builtin_fma(-kq, 1.5707963267948966, rr); y = __builtin_fma(-kq, 6.123233995736766e-17, y);
          const double y2 = y * y;
          double sp = 1.6059043836821613e-10; sp = sp * y2 - 2.505210838544172e-08; sp = sp * y2 + 2.7557319223985893e-06; sp = sp * y2 - 1.984126984126984e-04; sp = sp * y2 + 8.333333333333333e-03; sp = sp * y2 - 1.6666666666666666e-01; sp = sp * y2 + 1.0;
          const double sy = sp * y;
          double cp = -1.1470745597729725e-11; cp = cp * y2 + 2.08767569878681e-09; cp = cp * y2 - 2.755731922398589e-07; cp = cp * y2 + 2.48015873015873e-05; cp = cp * y2 - 1.388888888888889e-03; cp = cp * y2 + 4.1666666666666664e-02; cp = cp * y2 - 0.5; cp = cp * y2 + 1.0;
          const int q = ((int)kq) & 3;
          const double cs = (q == 0) ? cp : (q == 1) ? -sy : (q == 2) ? -cp : sy;
          const double sn = (q == 0) ? sy : (q == 1) ? cp : (q == 2) ? -sy : -cp;
          rope[(size_t)m * 128 + i] = (float)cs; rope[(size_t)m * 128 + 64 + i] = (float)sn; } }
    { const float* x = (const float*)a.in[0]; const float* g = (const float*)a.in[2]; bf16* xn = (bf16*)(ws + WS_XN);
      for (int m = gw; m < M; m += NGW) rms_row_to_bf16(x + (size_t)m * DM, g, xn + (size_t)m * DM, F.lane); }
}

__device__ __forceinline__ void thin_resid(Frame& F, const bf16* mix, const float* base, const float* gpost, float* out, const float* gnext, bf16* xn) {
    const int gw = F.vcu * NWAVES + F.wave, NGW = F.G * NWAVES;
    for (int m = gw; m < M; m += NGW) resid_norm_row(mix + (size_t)m * DM, base + (size_t)m * DM, gpost, out + (size_t)m * DM, gnext, xn ? xn + (size_t)m * DM : nullptr, F.lane);
}

__device__ __forceinline__ void dil_attn_phase(Frame& F) {
    const bf16* QKV = (const bf16*)(F.ws + WS_QKVA); bf16* OG = (bf16*)(F.ws + WS_OG); float* LSE = (float*)(F.ws + WS_LSE);
    const int hb = F.wave >> 2, w = F.wave & 3, lane = F.lane, l31 = lane & 31, half = lane >> 5;
    LAS unsigned char* vt = F.lds + RING_OFF + hb * 65536;
    const int tid_item = w * 64 + lane;
    for (int p = blockIdx.x; p < 3072; p += F.G) {
        const int idx = 2 * p + hb;
        const int blk = idx & 63, head = (idx >> 6) & 15, bg = idx >> 10, g = bg % 3, b = bg / 3;
        const int r = (g == 0) ? 1 : (g == 1) ? 4 : 16, nbk = 64 / r, c = blk / nbk, nblk = blk % nbk;
        const bf16* Qp = QKV + (size_t)b * SEQ * A_IN + ((g * 3 + 0) * 16 + head) * 128;
        const bf16* Kp = Qp + 16 * 128; const bf16* Vp = Qp + 32 * 128;
        { const int ch = tid_item & 15;
#pragma unroll 4
          for (int pass = 0; pass < 16; ++pass) { const int kj = (tid_item >> 4) + 16 * pass; int j = 128 * (nblk - 1) + kj; j = j < 0 ? 0 : j;
              const v4u val = *(const GAS v4u*)(Vp + (size_t)(c + r * j) * A_IN + 8 * ch);
              *(LAS v4u*)(vt + kj * 256 + ch * 16) = val; } }
        const int qi = 32 * w + l31;
        bf16x8 qf[8];
        { const bf16* qrow = Qp + (size_t)(c + r * (128 * nblk + qi)) * A_IN + 8 * half;
#pragma unroll
          for (int ks = 0; ks < 8; ++ks) qf[ks] = *(const GAS bf16x8*)(qrow + 16 * ks); }
        f32x16 S[5];
#pragma unroll
        for (int k5 = 0; k5 < 5; ++k5) {
            const int kj = 32 * (w + k5) + l31; int j = 128 * (nblk - 1) + kj; j = j < 0 ? 0 : j;
            const bf16* krow = Kp + (size_t)(c + r * j) * A_IN + 8 * half;
            f32x16 acc;
#pragma unroll
            for (int e = 0; e < 16; ++e) acc[e] = 0.f;
#pragma unroll
            for (int ks = 0; ks < 8; ++ks) { const bf16x8 kf = *(const GAS bf16x8*)(krow + 16 * ks); acc = MFMA32(kf, qf[ks], acc); }
            S[k5] = acc;
        }
        float mx = -1e30f;
        {
            const float fl = (float)(4 * half - l31);
            const float fk = (nblk == 0) ? (float)(32 * w + 4 * half - 128) : 1e9f;
#pragma unroll
            for (int k5 = 0; k5 < 5; ++k5)
#pragma unroll
                for (int e = 0; e < 16; ++e) { const float C = (float)(32 * k5 + (e & 3) + 8 * (e >> 2));
                    const float tt = fl + C; float bb = fminf(fminf(tt, 128.f - tt), fk + C); bb = fminf(bb, 0.f) * 1e30f;
                    const float x = S[k5][e] + bb; S[k5][e] = x; mx = fmaxf(mx, x); }
        }
        mx = fmaxf(mx, __shfl_xor(mx, 32));
        float sum = 0.f;
#pragma unroll
        for (int k5 = 0; k5 < 5; ++k5)
#pragma unroll
            for (int e = 0; e < 16; ++e) { const float pv = __expf(S[k5][e] - mx); S[k5][e] = pv; sum += pv; }
        sum += __shfl_xor(sum, 32);
        const float inv = 1.0f / sum, lse = mx + __logf(sum);
        __syncthreads();
        f32x16 O[4];
#pragma unroll
        for (int dt = 0; dt < 4; ++dt)
#pragma unroll
            for (int e = 0; e < 16; ++e) O[dt][e] = 0.f;
#pragma unroll
        for (int k5 = 0; k5 < 5; ++k5)
#pragma unroll
            for (int s = 0; s < 2; ++s) {
                bf16x8 pb;
                { const unsigned u0 = pk2(S[k5][8 * s + 0] * inv, S[k5][8 * s + 1] * inv), u1 = pk2(S[k5][8 * s + 2] * inv, S[k5][8 * s + 3] * inv),
                                 u2 = pk2(S[k5][8 * s + 4] * inv, S[k5][8 * s + 5] * inv), u3 = pk2(S[k5][8 * s + 6] * inv, S[k5][8 * s + 7] * inv);
                  const v4u uu = (v4u){u0, u1, u2, u3}; pb = __builtin_bit_cast(bf16x8, uu); }
                const int kbase = 32 * (w + k5) + 16 * s + 4 * half;
#pragma unroll
                for (int dt = 0; dt < 4; ++dt) {
                    const LAS unsigned short* vp = (const LAS unsigned short*)(vt + kbase * 256 + (32 * dt + l31) * 2);
                    bf16x8 av;
#pragma unroll
                    for (int j = 0; j < 8; ++j) av[j] = (short)vp[(8 * (j >> 2) + (j & 3)) * 128];
                    O[dt] = MFMA32(av, pb, O[dt]);
                }
            }
        const size_t mrow = (size_t)b * SEQ + c + r * (128 * nblk + qi);
        bf16* op = OG + ((size_t)g * M + mrow) * A_OUT + head * 128;
#pragma unroll
        for (int dt = 0; dt < 4; ++dt)
#pragma unroll
            for (int k = 0; k < 4; ++k) { const unsigned long long v = (unsigned long long)pk2(O[dt][4 * k], O[dt][4 * k + 1]) | ((unsigned long long)pk2(O[dt][4 * k + 2], O[dt][4 * k + 3]) << 32);
                *(GAS unsigned long long*)(op + 32 * dt + 8 * k + 4 * half) = v; }
        if (half == 0) LSE[((size_t)g * M + mrow) * 16 + head] = lse;
        __syncthreads();
    }
}
__device__ __forceinline__ void merge_phase(Frame& F) {
    const bf16* OG = (const bf16*)(F.ws + WS_OG); const float* LSE = (const float*)(F.ws + WS_LSE); bf16* OM = (bf16*)(F.ws + WS_OMERGE);
    const int gw = F.vcu * NWAVES + F.wave, NGW = F.G * NWAVES, lane = F.lane, head = lane >> 2, d0 = (lane & 3) * 32;
    for (int m = gw; m < M; m += NGW) {
        const float l0 = LSE[((size_t)0 * M + m) * 16 + head], l1 = LSE[((size_t)1 * M + m) * 16 + head], l2 = LSE[((size_t)2 * M + m) * 16 + head];
        const float mx = fmaxf(l0, fmaxf(l1, l2)); float e0 = __expf(l0 - mx), e1 = __expf(l1 - mx), e2 = __expf(l2 - mx); const float inv = 1.0f / (e0 + e1 + e2); e0 *= inv; e1 *= inv; e2 *= inv;
        const size_t off = (size_t)m * A_OUT + head * 128 + d0;
#pragma unroll
        for (int c4 = 0; c4 < 4; ++c4) {
            const v4u a = *(const GAS v4u*)(OG + off + 8 * c4), bq = *(const GAS v4u*)(OG + (size_t)M * A_OUT + off + 8 * c4), cq = *(const GAS v4u*)(OG + (size_t)2 * M * A_OUT + off + 8 * c4);
            v4u o;
#pragma unroll
            for (int k = 0; k < 4; ++k) { const float lo = e0 * bf_lo(a[k]) + e1 * bf_lo(bq[k]) + e2 * bf_lo(cq[k]), hi = e0 * bf_hi(a[k]) + e1 * bf_hi(bq[k]) + e2 * bf_hi(cq[k]); o[k] = pk2(lo, hi); }
            *(GAS v4u*)(OM + off + 8 * c4) = o; }
    }
}
__device__ __forceinline__ void idx_prep_phase(Frame& F, const Args& a) {
    const bf16* IQL = (const bf16*)(F.ws + WS_IQL); const float* IKW = (const float*)(F.ws + WS_IKW); bf16* IQLN = (bf16*)(F.ws + WS_IQLN); bf16* IKB = (bf16*)(F.ws + WS_IKB); float* IWS = (float*)(F.ws + WS_IWS);
    const float* rope = (const float*)(F.ws + WS_ROPE); const float* gq = (const float*)a.in[9]; const float* kw = (const float*)a.in[11]; const float* kb = (const float*)a.in[12];
    const int gw = F.vcu * NWAVES + F.wave, NGW = F.G * NWAVES, lane = F.lane;
    for (int m = gw; m < M; m += NGW) {
        const v4u x0 = *(const GAS v4u*)(IQL + (size_t)m * 1024 + 8 * lane), x1 = *(const GAS v4u*)(IQL + (size_t)m * 1024 + 512 + 8 * lane);
        float xv[16];
#pragma unroll
        for (int k = 0; k < 4; ++k) { xv[2 * k] = bf_lo(x0[k]); xv[2 * k + 1] = bf_hi(x0[k]); xv[8 + 2 * k] = bf_lo(x1[k]); xv[8 + 2 * k + 1] = bf_hi(x1[k]); }
        float ss = 0.f;
#pragma unroll
        for (int k = 0; k < 16; ++k) ss += xv[k] * xv[k];
        const float rs = 1.0f / sqrtf(wave_sum(ss) * (1.f / 1024.f) + NORM_EPS);
        v4u o0, o1;
#pragma unroll
        for (int k = 0; k < 4; ++k) { o0[k] = pk2(xv[2 * k] * rs * gq[8 * lane + 2 * k], xv[2 * k + 1] * rs * gq[8 * lane + 2 * k + 1]);
                                      o1[k] = pk2(xv[8 + 2 * k] * rs * gq[512 + 8 * lane + 2 * k], xv[8 + 2 * k + 1] * rs * gq[512 + 8 * lane + 2 * k + 1]); }
        *(GAS v4u*)(IQLN + (size_t)m * 1024 + 8 * lane) = o0; *(GAS v4u*)(IQLN + (size_t)m * 1024 + 512 + 8 * lane) = o1;
        const float k1 = IKW[(size_t)m * 256 + lane], k2 = IKW[(size_t)m * 256 + 64 + lane];
        const float mu = wave_sum(k1 + k2) * (1.f / 128.f); const float c1 = k1 - mu, c2 = k2 - mu;
        const float rv = 1.0f / sqrtf(wave_sum(c1 * c1 + c2 * c2) * (1.f / 128.f) + NORM_EPS);
        const float y1 = c1 * rv * kw[lane] + kb[lane], y2 = c2 * rv * kw[64 + lane] + kb[64 + lane];
        const float cs = rope[(size_t)m * 128 + lane], sn = rope[(size_t)m * 128 + 64 + lane];
        IKB[(size_t)m * 128 + lane] = (bf16)f2bf(y1 * cs - y2 * sn); IKB[(size_t)m * 128 + 64 + lane] = (bf16)f2bf(y2 * cs + y1 * sn);
        if (lane < 32) IWS[(size_t)m * 32 + lane] = IKW[(size_t)m * 256 + 128 + lane] * IWSCALE;
    }
}
__device__ __forceinline__ void idx_score_phase(Frame& F) {
    const bf16* IQ = (const bf16*)(F.ws + WS_IQ); const bf16* IKB = (const bf16*)(F.ws + WS_IKB); const float* IWS = (const float*)(F.ws + WS_IWS); float* SC = (float*)(F.ws + WS_SCORE);
    const int w = F.wave, lane = F.lane, l31 = lane & 31, half = lane >> 5;
    for (int i = blockIdx.x; i < 1024; i += F.G) {
        const int b = i >> 9, jj = i & 511, qb = (b == 0) ? jj : 511 - jj;
        const int t0 = 16 * qb + 2 * w;
        bf16x8 af[2][8]; float wv[2][16];
#pragma unroll
        for (int q = 0; q < 2; ++q) { const size_t m = (size_t)b * SEQ + t0 + q; const bf16* arow = IQ + m * 4096 + l31 * 128 + 8 * half;
#pragma unroll
            for (int ks = 0; ks < 8; ++ks) af[q][ks] = *(const GAS bf16x8*)(arow + 16 * ks);
#pragma unroll
            for (int e = 0; e < 16; ++e) wv[q][e] = IWS[m * 32 + (e & 3) + 8 * (e >> 2) + 4 * half]; }
        const int ntile = (t0 + 1) / 32 + 1;
        for (int kt = 0; kt < ntile; ++kt) {
            const bf16* krow = IKB + ((size_t)b * SEQ + 32 * kt + l31) * 128 + 8 * half;
            bf16x8 bfr[8];
#pragma unroll
            for (int ks = 0; ks < 8; ++ks) bfr[ks] = *(const GAS bf16x8*)(krow + 16 * ks);
#pragma unroll
            for (int q = 0; q < 2; ++q) { f32x16 acc;
#pragma unroll
                for (int e = 0; e < 16; ++e) acc[e] = 0.f;
#pragma unroll
                for (int ks = 0; ks < 8; ++ks) acc = MFMA32(af[q][ks], bfr[ks], acc);
                float sc = 0.f;
#pragma unroll
                for (int e = 0; e < 16; ++e) sc += fmaxf(acc[e], 0.f) * wv[q][e];
                sc += __shfl_xor(sc, 32);
                if (half == 0) SC[((size_t)b * SEQ + t0 + q) * 8192 + 32 * kt + l31] = sc; }
        }
    }
}
__device__ __forceinline__ unsigned okey(float f) { const unsigned u = __builtin_bit_cast(unsigned, f); return u ^ ((unsigned)((int)u >> 31) | 0x80000000u); }
__device__ __forceinline__ int wave_sum_i(int v) {
#pragma unroll
    for (int o = 1; o < 64; o <<= 1) v += __shfl_xor(v, o);
    return v;
}
__device__ __forceinline__ int mbcnt64(unsigned long long m) { return (int)__builtin_amdgcn_mbcnt_hi((unsigned)(m >> 32), __builtin_amdgcn_mbcnt_lo((unsigned)m, 0u)); }
__device__ __forceinline__ void topk_phase(Frame& F) {
    const float* SC = (const float*)(F.ws + WS_SCORE); int* SEL = (int*)(F.ws + WS_SEL);
    const int gw = F.vcu * NWAVES + F.wave, NGW = F.G * NWAVES;
    for (int m = gw; m < M; m += NGW) {
        const int t = m & (SEQ - 1), n = t + 1; int* sel = SEL + (size_t)m * 256; const float* sc = SC + (size_t)m * 8192;
        int lane = F.lane; asm volatile("" : "+v"(lane));
        if (n <= 256) {
#pragma unroll
            for (int i = 0; i < 4; ++i) sel[64 * i + lane] = (64 * i + lane < n) ? 64 * i + lane : 0;
            continue; }
        unsigned k[128];
#pragma unroll
        for (int j = 0; j < 128; ++j) { const int i = 64 * j + lane; const int ic = i < n ? i : n - 1; k[j] = okey(sc[ic]) & (unsigned)((i - n) >> 31); if ((j & 15) == 15) __builtin_amdgcn_sched_barrier(0); }
        unsigned T = 0u;
        for (int bit = 31; bit >= 0; --bit) { const unsigned cand = T | (1u << bit); int cnt = 0;
#pragma unroll
            for (int j = 0; j < 128; ++j) cnt += (k[j] >= cand) ? 1 : 0;
            cnt = wave_sum_i(cnt);
            if (cnt >= TOPK) T = cand; }
        int cgt = 0;
#pragma unroll
        for (int j = 0; j < 128; ++j) cgt += (k[j] > T) ? 1 : 0;
        cgt = wave_sum_i(cgt);
        const int need = TOPK - cgt; int cur = 0, eqb = 0;
        int lane2 = F.lane; asm volatile("" : "+v"(lane2));
        unsigned T2 = T; asm volatile("" : "+v"(T2));
#pragma unroll
        for (int j = 0; j < 128; ++j) { const bool gt = k[j] > T2, eq = k[j] == T2; const unsigned long long me = __ballot(eq); const bool take = gt || (eq && (eqb + mbcnt64(me)) < need);
            const unsigned long long mt = __ballot(take); if (take) sel[cur + mbcnt64(mt)] = 64 * j + lane2; cur += __builtin_popcountll(mt); eqb += __builtin_popcountll(me);
            __builtin_amdgcn_sched_barrier(0); }
    }
}
__device__ __forceinline__ void sparse_attn_phase(Frame& F) {
    const bf16* QB = (const bf16*)(F.ws + WS_QB); const bf16* KB = (const bf16*)(F.ws + WS_KB); const bf16* VB = (const bf16*)(F.ws + WS_VB); const int* SEL = (const int*)(F.ws + WS_SEL); bf16* OB = (bf16*)(F.ws + WS_OB);
    const int g = F.wave, lane = F.lane;
    LAS int* sel_l = (LAS int*)(F.lds + RING_OFF);
    LAS float* q_l = (LAS float*)(F.lds + RING_OFF + 1024 + g * 6144);
    LAS f32x4* p_l = (LAS f32x4*)(F.lds + RING_OFF + 1024 + g * 6144 + 2048);
    for (int m = blockIdx.x; m < M; m += F.G) {
        const int b = m >> 13, t = m & (SEQ - 1), cnt = (t + 1 < TOPK) ? t + 1 : TOPK;
        if (F.tid < 256) sel_l[F.tid] = SEL[(size_t)m * 256 + F.tid];
        { const v4u qv = *(const GAS v4u*)(QB + (size_t)m * 4096 + (g * 4 + (lane >> 4)) * 128 + (lane & 15) * 8);
          LAS f32x4* qd = (LAS f32x4*)(q_l + (lane >> 4) * 128 + (lane & 15) * 8);
          qd[0] = (f32x4){bf_lo(qv.x), bf_hi(qv.x), bf_lo(qv.y), bf_hi(qv.y)}; qd[1] = (f32x4){bf_lo(qv.z), bf_hi(qv.z), bf_lo(qv.w), bf_hi(qv.w)}; }
        __syncthreads();
        float lg[4][4];
#pragma unroll
        for (int jj = 0; jj < 4; ++jj) { const int kidx = lane + 64 * jj; const bool valid = kidx < cnt; const int row = valid ? sel_l[kidx] : 0;
            const bf16* kp = KB + ((size_t)b * SEQ + row) * 1024 + g * 128;
            float d4[4] = {0.f, 0.f, 0.f, 0.f};
#pragma unroll 1
            for (int ch = 0; ch < 16; ++ch) { const v4u kv = *(const GAS v4u*)(kp + 8 * ch);
                const float k0 = bf_lo(kv.x), k1 = bf_hi(kv.x), k2 = bf_lo(kv.y), k3 = bf_hi(kv.y), k4 = bf_lo(kv.z), k5 = bf_hi(kv.z), k6 = bf_lo(kv.w), k7 = bf_hi(kv.w);
#pragma unroll
                for (int h = 0; h < 4; ++h) { const f32x4 qa = *(const LAS f32x4*)(q_l + h * 128 + 8 * ch), qc = *(const LAS f32x4*)(q_l + h * 128 + 8 * ch + 4);
                    d4[h] += (k0 * qa.x + k1 * qa.y) + (k2 * qa.z + k3 * qa.w) + (k4 * qc.x + k5 * qc.y) + (k6 * qc.z + k7 * qc.w); } }
#pragma unroll
            for (int h = 0; h < 4; ++h) lg[jj][h] = valid ? d4[h] : -1e30f; }
#pragma unroll
        for (int h = 0; h < 4; ++h) { const float mx = wave_max(fmaxf(fmaxf(lg[0][h], lg[1][h]), fmaxf(lg[2][h], lg[3][h])));
            float s = 0.f;
#pragma unroll
            for (int jj = 0; jj < 4; ++jj) { lg[jj][h] = __expf(lg[jj][h] - mx); s += lg[jj][h]; }
            const float inv = 1.0f / wave_sum(s);
#pragma unroll
            for (int jj = 0; jj < 4; ++jj) lg[jj][h] *= inv; }
#pragma unroll
        for (int jj = 0; jj < 4; ++jj) p_l[lane + 64 * jj] = (f32x4){lg[jj][0], lg[jj][1], lg[jj][2], lg[jj][3]};
        LDS_WAIT();
        float acc[4][2] = {{0.f, 0.f}, {0.f, 0.f}, {0.f, 0.f}, {0.f, 0.f}};
        const bf16* vbase = VB + (size_t)b * SEQ * 1024 + g * 128 + 2 * lane;
#pragma unroll 4
        for (int kidx = 0; kidx < cnt; ++kidx) { const int row = sel_l[kidx]; const unsigned vv = *(const GAS unsigned*)(vbase + (size_t)row * 1024); const f32x4 p4 = p_l[kidx];
            const float v0 = bf_lo(vv), v1 = bf_hi(vv);
#pragma unroll
            for (int h = 0; h < 4; ++h) { acc[h][0] += p4[h] * v0; acc[h][1] += p4[h] * v1; } }
#pragma unroll
        for (int h = 0; h < 4; ++h) *(GAS unsigned*)(OB + (size_t)m * 4096 + (g * 4 + h) * 128 + 2 * lane) = pk2(acc[h][0], acc[h][1]);
        __syncthreads();
    }
}
struct TileQKVA { bf16* out; __device__ __forceinline__ pg8::HeadTile operator()(int pn) const { const int which = (pn >> 3) % 3; return pg8::HeadTile{out, nullptr, A_IN, pn * 256, which < 2 ? 1 : 0, which == 0 ? QSCALE : 1.f}; } };
struct TileINB { bf16 *qb, *kb, *vb, *iql; float* ikw;
    __device__ __forceinline__ pg8::HeadTile operator()(int pn) const {
        if (pn < 16) return pg8::HeadTile{qb, nullptr, 4096, pn * 256, 1, QSCALE};
        if (pn < 20) return pg8::HeadTile{kb, nullptr, 1024, (pn - 16) * 256, 1, 1.f};
        if (pn < 24) return pg8::HeadTile{vb, nullptr, 1024, (pn - 20) * 256, 0, 1.f};
        if (pn < 28) return pg8::HeadTile{iql, nullptr, 1024, (pn - 24) * 256, 0, 1.f};
        return pg8::HeadTile{nullptr, ikw, 256, 0, 0, 1.f}; } };
struct TileIQ { bf16* out; __device__ __forceinline__ pg8::HeadTile operator()(int pn) const { return pg8::HeadTile{out, nullptr, 4096, pn * 256, 1, 1.f}; } };

#ifndef MK_PER_PHASE
#define MK_PER_PHASE 1
#endif
__global__ void __launch_bounds__(NWAVES * 64, 2) fwd(Args args) {
    extern __shared__ __attribute__((aligned(16))) unsigned char lds[];
    Frame F;
    F.lds = (LAS unsigned char*)lds;
    F.MISC = (volatile LAS unsigned*)(F.lds + MISC_OFF);
    F.tid = threadIdx.x; F.lane = F.tid & 63; F.wave = __builtin_amdgcn_readfirstlane(F.tid >> 6);
    F.G = gridDim.x; { const int bx = blockIdx.x; F.vcu = (F.G % 8 == 0) ? (bx % 8) * (F.G / 8) + bx / 8 : bx; }
    F.ws = args.ws; unsigned char* ws = args.ws;
    F.ctl = (gu32*)(ws + WS_CTL);
    for (int u = F.tid; u < (LDS_BYTES - LDSCTL_OFF) / 4; u += NWAVES * 64) ((LAS unsigned*)(F.lds + LDSCTL_OFF))[u] = 0u;
    __syncthreads();
    const int lo = args.ph_lo, hi = args.ph_hi;
    XcdBarrier bar; bar.bar = (unsigned*)(F.ctl + CW_BAR) + args.li * XCD_BAR_WORDS; bar.x = 0; bar.st = nullptr;
    if (hi - lo > 1) bar = xcd_barrier_post((unsigned*)(F.ctl + CW_BAR) + args.li * XCD_BAR_WORDS, F.MISC + 8);
#ifdef ONLY_PHASE
#define IN(k) ((k) == ONLY_PHASE && lo <= (k) && (k) < hi)
#else
#define IN(k) (lo <= (k) && (k) < hi)
#endif
#define SEAM(k) do { if (IN(k) && IN((k) + 1)) xcd_barrier(bar); } while (0)
    const float* x = (const float*)args.in[0];
    const float* g_attn_pre = (const float*)args.in[2]; const float* g_attn_post = (const float*)args.in[3];
    const float* g_mlp_pre = (const float*)args.in[4]; const float* g_mlp_post = (const float*)args.in[5];
    bf16* XN = (bf16*)(ws + WS_XN); bf16* MIX = (bf16*)(ws + WS_MIX); bf16* HID = (bf16*)(ws + WS_HID);
    const float* rope = (const float*)(ws + WS_ROPE);
    float* out = args.out;

    if (IN(0)) { p0_prologue(F, args); } SEAM(0);
    if (IN(1)) { pg8::Gemm g{XN, (const bf16*)(ws + WS_W_INA), M, A_IN, DM}; pg8::StaticOrder S; S.init(M, A_IN, F.G, (int)blockIdx.x);
        pg8::EpiHead<TileQKVA> E{TileQKVA{(bf16*)(ws + WS_QKVA)}, rope};
        pg8::gemm_phase<pg8::EpiHead<TileQKVA>, pg8::StaticOrder, true, true>(F.lds + RING_OFF, g, S, E); } SEAM(1);
    if (IN(2)) { dil_attn_phase(F); } SEAM(2);
    if (IN(3)) { merge_phase(F); } SEAM(3);
    if (IN(4)) { pg8::Gemm g{(const bf16*)(ws + WS_OMERGE), (const bf16*)(ws + WS_W_OUTA), M, DM, A_OUT}; pg8::StaticOrder S; S.init(M, DM, F.G, (int)blockIdx.x);
        pg8::EpiBf16<0> E{MIX, DM};
        pg8::gemm_phase<pg8::EpiBf16<0>, pg8::StaticOrder, true, true>(F.lds + RING_OFF, g, S, E); } SEAM(4);
    if (IN(5)) { thin_resid(F, MIX, x, g_attn_post, out, g_mlp_pre, XN); } SEAM(5);
    if (IN(6)) { pg8::Gemm g{XN, (const bf16*)(ws + WS_W_UP), M, DFF, DM}; pg8::StaticOrder S; S.init(M, DFF, F.G, (int)blockIdx.x);
        pg8::EpiBf16<1> E{HID, DFF};
        pg8::gemm_phase<pg8::EpiBf16<1>, pg8::StaticOrder, true, true>(F.lds + RING_OFF, g, S, E); } SEAM(6);
    if (IN(7)) { pg8::Gemm g{HID, (const bf16*)(ws + WS_W_DOWN), M, DM, DFF}; pg8::StaticOrder S; S.init(M, DM, F.G, (int)blockIdx.x);
        pg8::EpiBf16<0> E{MIX, DM};
        pg8::gemm_phase<pg8::EpiBf16<0>, pg8::StaticOrder, true, true>(F.lds + RING_OFF, g, S, E); } SEAM(7);
    if (IN(8)) { thin_resid(F, MIX, out, g_mlp_post, out, g_attn_pre + DM, XN); } SEAM(8);
    if (IN(9)) { pg8::Gemm g{XN, (const bf16*)(ws + WS_W_INB), M, B_IN_PAD, DM}; pg8::StaticOrder S; S.init(M, B_IN_PAD, F.G, (int)blockIdx.x);
        pg8::EpiHead<TileINB> E{TileINB{(bf16*)(ws + WS_QB), (bf16*)(ws + WS_KB), (bf16*)(ws + WS_VB), (bf16*)(ws + WS_IQL), (float*)(ws + WS_IKW)}, rope};
        pg8::gemm_phase<pg8::EpiHead<TileINB>, pg8::StaticOrder, true, true>(F.lds + RING_OFF, g, S, E); } SEAM(9);
    if (IN(10)) { idx_prep_phase(F, args); } SEAM(10);
    if (IN(11)) { pg8::Gemm g{(const bf16*)(ws + WS_IQLN), (const bf16*)(ws + WS_W_IDX), M, 4096, IDX_RANK}; pg8::StaticOrder S; S.init(M, 4096, F.G, (int)blockIdx.x);
        pg8::EpiHead<TileIQ> E{TileIQ{(bf16*)(ws + WS_IQ)}, rope};
        pg8::gemm_phase<pg8::EpiHead<TileIQ>, pg8::StaticOrder, true, true>(F.lds + RING_OFF, g, S, E); } SEAM(11);
    if (IN(12)) { idx_score_phase(F); } SEAM(12);
    if (IN(13)) { topk_phase(F); } SEAM(13);
    if (IN(14)) { sparse_attn_phase(F); } SEAM(14);
    if (IN(15)) { pg8::Gemm g{(const bf16*)(ws + WS_OB), (const bf16*)(ws + WS_W_OUTB), M, DM, 4096}; pg8::StaticOrder S; S.init(M, DM, F.G, (int)blockIdx.x);
        pg8::EpiBf16<0> E{MIX, DM};
        pg8::gemm_phase<pg8::EpiBf16<0>, pg8::StaticOrder, true, true>(F.lds + RING_OFF, g, S, E); } SEAM(15);
    if (IN(16)) { thin_resid(F, MIX, out, g_attn_post + DM, out, g_mlp_pre + DM, XN); } SEAM(16);
    if (IN(17)) { pg8::Gemm g{XN, (const bf16*)(ws + WS_W_UP) + (size_t)DM * DFF, M, DFF, DM}; pg8::StaticOrder S; S.init(M, DFF, F.G, (int)blockIdx.x);
        pg8::EpiBf16<1> E{HID, DFF};
        pg8::gemm_phase<pg8::EpiBf16<1>, pg8::StaticOrder, true, true>(F.lds + RING_OFF, g, S, E); } SEAM(17);
    if (IN(18)) { pg8::Gemm g{HID, (const bf16*)(ws + WS_W_DOWN) + (size_t)DM * DFF, M, DM, DFF}; pg8::StaticOrder S; S.init(M, DM, F.G, (int)blockIdx.x);
        pg8::EpiBf16<0> E{MIX, DM};
        pg8::gemm_phase<pg8::EpiBf16<0>, pg8::StaticOrder, true, true>(F.lds + RING_OFF, g, S, E); } SEAM(18);
    if (IN(19)) { thin_resid(F, MIX, out, g_mlp_post + DM, out, nullptr, nullptr); }
#undef IN
#undef SEAM
}

extern "C" void kernel_launch(void* const* d_in, const int* in_sizes, int n_in, void* d_out, int out_size, void* d_ws, size_t ws_size, hipStream_t stream) {
    static int grid = 0;
    if (grid == 0) {
        if (n_in != 16 || in_sizes[0] != M * DM || out_size != M * DM || ws_size < WS_END) { fprintf(stderr, "kernel_launch: unexpected shapes (n_in %d, in0 %d, out %d, ws %zu)\n", n_in, n_in > 0 ? in_sizes[0] : -1, out_size, ws_size); grid = -1; return; }
        int dev = 0, cus = 0, per_cu = 0;
        if (hipGetDevice(&dev) != hipSuccess || hipDeviceGetAttribute(&cus, hipDeviceAttributeMultiprocessorCount, dev) != hipSuccess) { grid = -1; return; }
        if (hipFuncSetAttribute((const void*)fwd, hipFuncAttributeMaxDynamicSharedMemorySize, LDS_BYTES) != hipSuccess) { fprintf(stderr, "kernel_launch: hipFuncSetAttribute failed\n"); grid = -1; return; }
        if (hipOccupancyMaxActiveBlocksPerMultiprocessor(&per_cu, (const void*)fwd, NWAVES * 64, LDS_BYTES) != hipSuccess || per_cu < 1) fprintf(stderr, "kernel_launch: occupancy query reports %d\n", per_cu);
        (void)hipGetLastError();
        grid = cus;
    }
    if (grid < 0) return;
    if (hipMemsetAsync((char*)d_ws + WS_CTL, 0, CTL_ZERO_BYTES, stream) != hipSuccess) return;
    Args a{};
    for (int i = 0; i < 16; ++i) a.in[i] = d_in[i];
    a.out = (float*)d_out; a.ws = (unsigned char*)d_ws; a.pad = 0;
#if MK_PER_PHASE
#ifndef LAST_PHASE
#define LAST_PHASE N_PHASES
#endif
    for (int li = 0; li < LAST_PHASE; ++li) { a.ph_lo = li; a.ph_hi = li + 1; a.li = li;
        hipLaunchKernelGGL(fwd, dim3(grid), dim3(NWAVES * 64), LDS_BYTES, stream, a); }
#else
    a.ph_lo = 0; a.ph_hi = N_PHASES; a.li = 0;
    hipLaunchKernelGGL(fwd, dim3(grid), dim3(NWAVES * 64), LDS_BYTES, stream, a);
#endif
}
```

```cpp
#include <hip/hip_runtime.h>
#include <cstdio>
#include <cstdint>
#ifndef I8_KOUTER
#define I8_KOUTER 0
#endif
#ifndef PG8_SKEW
#define PG8_SKEW 1
#endif
#ifndef PG8_B_NT
#define PG8_B_NT 0
#endif
#ifndef EPI_NT
#define EPI_NT 0
#endif
#ifndef PG8_WGM
#define PG8_WGM 4
#endif
namespace pg8 {
#define PG8_LAS __attribute__((address_space(3)))
typedef unsigned short bf16_t;
typedef short bf16x8 __attribute__((ext_vector_type(8)));
typedef float f32x4 __attribute__((ext_vector_type(4)));
typedef unsigned u32x4 __attribute__((ext_vector_type(4)));
constexpr int BM = 256, BK = 64, HALF = 128, HTB = HALF * BK * 2  , STAGE_BYTES = 8 * HTB, NXCD = 8, WGM = PG8_WGM;

__host__ __device__ __forceinline__ int lds_byte(int r, int c) { const int st = (r >> 4) * 2 + (c >> 5), rr = r & 15, cc = c & 31, ob = rr * 64 + cc * 2; return st * 1024 + (ob ^ (((ob >> 9) & 1) << 5)); }
__host__ __device__ __forceinline__ void stage_rc(int b, int& R, int& C) { const int st = b / 1024, sb = b % 1024, swz = sb ^ (((sb >> 9) & 1) << 5); R = (st >> 1) * 16 + swz / 64; C = (st & 1) * 32 + (swz % 64) / 2; }
__host__ __device__ __forceinline__ int perm32(int rho) { const int n = rho >> 4, i = rho & 15; return 8 * (i >> 2) + 4 * n + (i & 3); }

struct Unit { int pm, pn; };
struct Gemm { const bf16_t* A; const bf16_t* Bt; int M, N, K; };

struct StaticOrder {
    int nM, nN, nwg, G, c, wgm;
    __host__ __device__ void init(int M, int N, int G_, int c_, int wgm_ = WGM) { nM = M / BM; nN = N / BM; nwg = nM * nN; G = G_; c = c_; wgm = wgm_; }
    __host__ __device__ bool next(int i, Unit& u) const {
        const long L = (long)i * G + c; if (L >= nwg) return false;
        int wgid = (int)L; { const int q = nwg / NXCD, r = nwg % NXCD, xcd = wgid % NXCD, off = wgid / NXCD; wgid = (xcd < r ? xcd * (q + 1) : r * (q + 1) + (xcd - r) * q) + off; }
        const int nig = wgm * nN, gid = wgid / nig, fm = gid * wgm, gsz = (nM - fm) < wgm ? (nM - fm) : wgm;
        u.pm = fm + ((wgid % nig) % gsz); u.pn = (wgid % nig) / gsz;
        if (PG8_SKEW && nwg % NXCD == 0 && nM % NXCD == 0 && (nM / NXCD) % wgm == 0 && G % NXCD == 0) { const int xcd = (int)(L % NXCD); u.pn = (u.pn + xcd * nN / NXCD) % nN; }
        return true;
    }
    __device__ __forceinline__ void a_ready(const Unit&) const {}
    __device__ __forceinline__ void done(const Unit&) const {}
};
typedef int v4i_t __attribute__((ext_vector_type(4))); typedef int v8i_t __attribute__((ext_vector_type(8)));

typedef float f32x2_t __attribute__((ext_vector_type(2))); typedef __bf16 bf16x2_t __attribute__((ext_vector_type(2)));
__device__ __forceinline__ unsigned cvt_pk_bf16(float lo, float hi) { const f32x2_t v = {lo, hi}; const bf16x2_t b = __builtin_convertvector(v, bf16x2_t); return __builtin_bit_cast(unsigned, b); }

struct EpiF32 {
    static constexpr bool PERM = false, AFTER_DRAIN = false;
    float* C; int ldc;
    __device__ __forceinline__ void operator()(const f32x4 (&acc)[2][2][4][2], const Unit& u, int wr, int wc, int fr, int fq) const {
        const int row0 = u.pm * BM + wr * 64 + fr, col0 = u.pn * BM + wc * 32 + 4 * fq;
#pragma unroll
        for (int ai = 0; ai < 2; ++ai)
#pragma unroll
            for (int m = 0; m < 4; ++m) { float* rowp = C + (size_t)(row0 + ai * HALF + m * 16) * ldc + col0;
#pragma unroll
                for (int bj = 0; bj < 2; ++bj)
#pragma unroll
                    for (int n = 0; n < 2; ++n) *(f32x4*)(rowp + bj * HALF + n * 16) = acc[ai][bj][m][n]; }
    }
};
template <int ACT> struct EpiBf16 {
    static constexpr bool PERM = true, AFTER_DRAIN = false;
    bf16_t* O; int ldc; float scale; const float* srow; const float* scol;
    __device__ __forceinline__ void operator()(const f32x4 (&acc)[2][2][4][2], const Unit& u, int wr, int wc, int fr, int fq) const {
        const int row0 = u.pm * BM + wr * 64 + fr, col0 = u.pn * BM + wc * 32 + 8 * fq;
#pragma unroll
        for (int ai = 0; ai < 2; ++ai)
#pragma unroll
            for (int m = 0; m < 4; ++m) { bf16_t* rowp = O + (size_t)(row0 + ai * HALF + m * 16) * ldc + col0;
#pragma unroll
                for (int bj = 0; bj < 2; ++bj) { f32x4 v0 = acc[ai][bj][m][0], v1 = acc[ai][bj][m][1];
                    if (srow) { const float sr = srow[row0 + ai * HALF + m * 16]; const float* scp = scol + col0 + bj * HALF;
                        v0 = __builtin_convertvector(__builtin_bit_cast(v4i_t, v0), f32x4) * (*(const f32x4*)(scp) * sr); v1 = __builtin_convertvector(__builtin_bit_cast(v4i_t, v1), f32x4) * (*(const f32x4*)(scp + 4) * sr); }
                    v0 = v0 * scale; v1 = v1 * scale;
#pragma unroll
                    for (int j = 0; j < 4; ++j) { if (ACT == 1) { const float a = fmaxf(v0[j], 0.f), b = fmaxf(v1[j], 0.f); v0[j] = a * a; v1[j] = b * b; } }
                    u32x4 w; w.x = cvt_pk_bf16(v0[0], v0[1]); w.y = cvt_pk_bf16(v0[2], v0[3]); w.z = cvt_pk_bf16(v1[0], v1[1]); w.w = cvt_pk_bf16(v1[2], v1[3]);
                    if (EPI_NT == 1) __builtin_nontemporal_store(w, (u32x4*)(rowp + bj * HALF)); else *(u32x4*)(rowp + bj * HALF) = w; } }
    }
};
struct EpiSqReluF8 {
    static constexpr bool PERM = true, AFTER_DRAIN = false;
    unsigned char* O; int ldc; float pre, scale; const float* srow; const float* scol;
    __device__ __forceinline__ void operator()(const f32x4 (&acc)[2][2][4][2], const Unit& u, int wr, int wc, int fr, int fq) const {
        const int row0 = u.pm * BM + wr * 64 + fr, col0 = u.pn * BM + wc * 32 + 8 * fq;
#pragma unroll
        for (int ai = 0; ai < 2; ++ai)
#pragma unroll
            for (int m = 0; m < 4; ++m) { unsigned char* rowp = O + (size_t)(row0 + ai * HALF + m * 16) * ldc + col0;
#pragma unroll
                for (int bj = 0; bj < 2; ++bj) { f32x4 v0 = acc[ai][bj][m][0], v1 = acc[ai][bj][m][1];
                    if (srow) { const float sr = srow[row0 + ai * HALF + m * 16]; const float* scp = scol + col0 + bj * HALF;
                        v0 = __builtin_convertvector(__builtin_bit_cast(v4i_t, v0), f32x4) * (*(const f32x4*)(scp) * sr); v1 = __builtin_convertvector(__builtin_bit_cast(v4i_t, v1), f32x4) * (*(const f32x4*)(scp + 4) * sr); }
#pragma unroll
                    for (int j = 0; j < 4; ++j) { const float a = fmaxf(v0[j] * pre, 0.f), b = fmaxf(v1[j] * pre, 0.f); v0[j] = fminf(a * a * scale, 448.f); v1[j] = fminf(b * b * scale, 448.f); }
                    int p0 = 0, p1 = 0;
                    p0 = __builtin_amdgcn_cvt_pk_fp8_f32(v0[0], v0[1], p0, false); p0 = __builtin_amdgcn_cvt_pk_fp8_f32(v0[2], v0[3], p0, true);
                    p1 = __builtin_amdgcn_cvt_pk_fp8_f32(v1[0], v1[1], p1, false); p1 = __builtin_amdgcn_cvt_pk_fp8_f32(v1[2], v1[3], p1, true);
                    { const unsigned long long pv_ = (unsigned long long)(unsigned)p0 | ((unsigned long long)(unsigned)p1 << 32); if (EPI_NT) __builtin_nontemporal_store(pv_, (unsigned long long*)(rowp + bj * HALF)); else *(unsigned long long*)(rowp + bj * HALF) = pv_; } } }
    }
};
struct HeadTile { bf16_t* out; float* outf; int ldc; int col; int rope; float scale; unsigned char* out8; int hm_lg; };
template <class TileFn> struct EpiHead {
    static constexpr bool PERM = true, AFTER_DRAIN = false;
    TileFn fn; const float* rope; const float* srow; const float* scol;
    __device__ __forceinline__ void operator()(const f32x4 (&acc)[2][2][4][2], const Unit& u, int wr, int wc, int fr, int fq) const {
        const HeadTile t = fn(u.pn);
        const int row0 = u.pm * BM + wr * 64 + fr;
        const int dlo = 32 * (wc & 1) + 8 * fq;
        const int ncol = t.col + 128 * (wc >> 1) + dlo;
#pragma unroll
        for (int ai = 0; ai < 2; ++ai)
#pragma unroll
            for (int m = 0; m < 4; ++m) { const int row = row0 + ai * HALF + m * 16;
                f32x4 lo0 = acc[ai][0][m][0], lo1 = acc[ai][0][m][1], hi0 = acc[ai][1][m][0], hi1 = acc[ai][1][m][1];
                if (srow) { const float sr = srow[row]; const float* scp = scol + u.pn * BM + wc * 32 + 8 * fq;
                    const f32x4 c0 = *(const f32x4*)(scp) * sr, c1 = *(const f32x4*)(scp + 4) * sr, c2 = *(const f32x4*)(scp + HALF) * sr, c3 = *(const f32x4*)(scp + HALF + 4) * sr;
                    lo0 = __builtin_convertvector(__builtin_bit_cast(v4i_t, lo0), f32x4) * c0; lo1 = __builtin_convertvector(__builtin_bit_cast(v4i_t, lo1), f32x4) * c1;
                    hi0 = __builtin_convertvector(__builtin_bit_cast(v4i_t, hi0), f32x4) * c2; hi1 = __builtin_convertvector(__builtin_bit_cast(v4i_t, hi1), f32x4) * c3; }
                if (t.rope) { const float* rp = rope + (size_t)row * 128 + dlo;
                    const f32x4 c0 = *(const f32x4*)(rp), c1 = *(const f32x4*)(rp + 4), s0 = *(const f32x4*)(rp + 64), s1 = *(const f32x4*)(rp + 68);
                    const f32x4 a0 = lo0 * c0 - hi0 * s0, a1 = lo1 * c1 - hi1 * s1, b0 = hi0 * c0 + lo0 * s0, b1 = hi1 * c1 + lo1 * s1;
                    lo0 = a0; lo1 = a1; hi0 = b0; hi1 = b1; }
                lo0 = lo0 * t.scale; lo1 = lo1 * t.scale; hi0 = hi0 * t.scale; hi1 = hi1 * t.scale;
                if (t.outf) { float* p = t.outf + (size_t)row * t.ldc + ncol;
                    *(f32x4*)(p) = lo0; *(f32x4*)(p + 4) = lo1; *(f32x4*)(p + 64) = hi0; *(f32x4*)(p + 68) = hi1; }
                else if (t.out8) { unsigned char* p = t.out8 + (size_t)row * t.ldc + ncol;
                    int a0 = 0, a1 = 0, b0 = 0, b1 = 0;
                    a0 = __builtin_amdgcn_cvt_pk_fp8_f32(lo0[0], lo0[1], a0, false); a0 = __builtin_amdgcn_cvt_pk_fp8_f32(lo0[2], lo0[3], a0, true); a1 = __builtin_amdgcn_cvt_pk_fp8_f32(lo1[0], lo1[1], a1, false); a1 = __builtin_amdgcn_cvt_pk_fp8_f32(lo1[2], lo1[3], a1, true);
                    b0 = __builtin_amdgcn_cvt_pk_fp8_f32(hi0[0], hi0[1], b0, false); b0 = __builtin_amdgcn_cvt_pk_fp8_f32(hi0[2], hi0[3], b0, true); b1 = __builtin_amdgcn_cvt_pk_fp8_f32(hi1[0], hi1[1], b1, false); b1 = __builtin_amdgcn_cvt_pk_fp8_f32(hi1[2], hi1[3], b1, true);
                    *(unsigned long long*)(p) = (unsigned long long)(unsigned)a0 | ((unsigned long long)(unsigned)a1 << 32); *(unsigned long long*)(p + 64) = (unsigned long long)(unsigned)b0 | ((unsigned long long)(unsigned)b1 << 32); }
                else { bf16_t* p = t.out + (size_t)row * t.ldc + ncol;
                    if (t.hm_lg >= 0) { const int s_ = row & 8191, b_ = row >> 13, pr_ = (s_ & ((1 << t.hm_lg) - 1)) * (8192 >> t.hm_lg) + (s_ >> t.hm_lg);
                        p = t.out + ((size_t)((wc >> 1) * 2 + b_) * 8192 + pr_) * 128 + dlo; }
                    u32x4 w; w.x = cvt_pk_bf16(lo0[0], lo0[1]); w.y = cvt_pk_bf16(lo0[2], lo0[3]); w.z = cvt_pk_bf16(lo1[0], lo1[1]); w.w = cvt_pk_bf16(lo1[2], lo1[3]);
                    *(u32x4*)(p) = w;
                    w.x = cvt_pk_bf16(hi0[0], hi0[1]); w.y = cvt_pk_bf16(hi0[2], hi0[3]); w.z = cvt_pk_bf16(hi1[0], hi1[1]); w.w = cvt_pk_bf16(hi1[2], hi1[3]);
                    *(u32x4*)(p + 64) = w; } }
    }
};

__device__ __forceinline__ v8i_t pg8_cat(bf16x8 a, bf16x8 b) { return __builtin_shufflevector(__builtin_bit_cast(v4i_t, a), __builtin_bit_cast(v4i_t, b), 0, 1, 2, 3, 4, 5, 6, 7); }
template <class Epi, class Sched, bool ALIGN_EPI = false, bool SP2 = false, int MODE = 0>
__device__ __forceinline__ void gemm_phase(PG8_LAS unsigned char* lds, const Gemm g, const Sched& S, const Epi& E) {
    const int tid = threadIdx.x, wid = __builtin_amdgcn_readfirstlane(tid >> 6), lane = tid & 63, wr = wid >> 2, wc = wid & 3, fr = lane & 15, fq = lane >> 4;
    const int K = g.K, nt = K / BK;
    unsigned voffA[2], voffB[2];
#pragma unroll
    for (int i = 0; i < 2; ++i) { int R, C; stage_rc(tid * 16 + i * 8192, R, C); const int Rb = Epi::PERM ? ((R & ~31) + perm32(R & 31)) : R;
        voffA[i] = (unsigned)(R * K + C) * 2u; voffB[i] = (unsigned)(Rb * K + C) * 2u; }
    const size_t kstep = (size_t)(BK * 2);
    const size_t hstep = (size_t)HALF * K * 2;
    const size_t tstep = 2 * hstep;
    const unsigned ldsw = (unsigned)wid * 1024u;
    const int aoff = lds_byte(wr * 64 + fr, fq * 8), boff = lds_byte(wc * 32 + fr, fq * 8);
#define PG8_SA(b, h) (((b) * 2 + (h)) * HTB)
#define PG8_SB(b, h) ((4 + (b) * 2 + (h)) * HTB)
#define PG8_STAGE(bufoff, gbase, voff) do { _Pragma("unroll") for (int _i = 0; _i < 2; ++_i) { \
        if ((bufoff) >= 4 * HTB && PG8_B_NT) __builtin_amdgcn_global_load_lds((const unsigned*)((const char*)(gbase) + (voff)[_i]), (PG8_LAS unsigned*)(lds + (bufoff) + ldsw + _i * 8192), 16, 0, 2); \
        else __builtin_amdgcn_global_load_lds((const unsigned*)((const char*)(gbase) + (voff)[_i]), (PG8_LAS unsigned*)(lds + (bufoff) + ldsw + _i * 8192), 16, 0, 0); } } while (0)
#define PG8_LDA(dst, b, h) do { _Pragma("unroll") for (int m = 0; m < 4; ++m) _Pragma("unroll") for (int k = 0; k < 2; ++k) dst[m][k] = *(const PG8_LAS bf16x8*)(lds + PG8_SA(b, h) + aoff + m * 2048 + k * 1024); } while (0)
#define PG8_LDB(dst, b, h) do { _Pragma("unroll") for (int n = 0; n < 2; ++n) _Pragma("unroll") for (int k = 0; k < 2; ++k) dst[n][k] = *(const PG8_LAS bf16x8*)(lds + PG8_SB(b, h) + boff + n * 2048 + k * 1024); } while (0)
#define PG8_MMA(ai, bj, At, Bt) do { __builtin_amdgcn_s_setprio(1); \
        if constexpr (MODE == 2 && I8_KOUTER) { _Pragma("unroll") for (int k = 0; k < 2; ++k) _Pragma("unroll") for (int m = 0; m < 4; ++m) _Pragma("unroll") for (int n = 0; n < 2; ++n) \
            acc[ai][bj][m][n] = __builtin_bit_cast(f32x4, __builtin_amdgcn_mfma_i32_16x16x64_i8(__builtin_bit_cast(v4i_t, Bt[n][k]), __builtin_bit_cast(v4i_t, At[m][k]), __builtin_bit_cast(v4i_t, acc[ai][bj][m][n]), 0, 0, 0)); } \
        else _Pragma("unroll") for (int m = 0; m < 4; ++m) _Pragma("unroll") for (int n = 0; n < 2; ++n) { \
        if constexpr (MODE == 1) { const v8i_t b8_ = pg8_cat(Bt[n][0], Bt[n][1]), a8_ = pg8_cat(At[m][0], At[m][1]); asm volatile("v_mfma_f32_16x16x128_f8f6f4 %0, %1, %2, %0" : "+v"(acc[ai][bj][m][n]) : "v"(b8_), "v"(a8_)); } \
        else if constexpr (MODE == 2) { _Pragma("unroll") for (int k = 0; k < 2; ++k) acc[ai][bj][m][n] = __builtin_bit_cast(f32x4, __builtin_amdgcn_mfma_i32_16x16x64_i8(__builtin_bit_cast(v4i_t, Bt[n][k]), __builtin_bit_cast(v4i_t, At[m][k]), __builtin_bit_cast(v4i_t, acc[ai][bj][m][n]), 0, 0, 0)); } \
        else { _Pragma("unroll") for (int k = 0; k < 2; ++k) acc[ai][bj][m][n] = __builtin_amdgcn_mfma_f32_16x16x32_bf16(Bt[n][k], At[m][k], acc[ai][bj][m][n], 0, 0, 0); } } __builtin_amdgcn_s_setprio(0); } while (0)
#define PG8_WAIT_V(n) asm volatile("s_waitcnt vmcnt(" #n ")" ::: "memory")
#define PG8_WAIT_L(n) asm volatile("s_waitcnt lgkmcnt(" #n ")" ::: "memory")
#define PG8_BAR __builtin_amdgcn_s_barrier()
#define PG8_SCHED __builtin_amdgcn_sched_barrier(0)
    Unit cur, nxt; int ui = 0;
    if (!S.next(0, cur)) return;
    f32x4 acc[2][2][4][2];
#pragma unroll
    for (int a = 0; a < 2; ++a)
#pragma unroll
        for (int b = 0; b < 2; ++b)
#pragma unroll
            for (int m = 0; m < 4; ++m)
#pragma unroll
                for (int n = 0; n < 2; ++n) acc[a][b][m][n] = (f32x4){0.f, 0.f, 0.f, 0.f};
    bf16x8 At[4][2], B0[2][2], B1[2][2];
    const char* cA = (const char*)g.A + (size_t)cur.pm * tstep; const char* cB = (const char*)g.Bt + (size_t)cur.pn * tstep;
    S.a_ready(cur);
    if constexpr (SP2) {
        PG8_STAGE(PG8_SB(0, 0), cB, voffB); PG8_STAGE(PG8_SB(0, 1), cB + hstep, voffB); PG8_STAGE(PG8_SA(0, 0), cA, voffA); PG8_STAGE(PG8_SA(0, 1), cA + hstep, voffA);
        if (wr == 1) PG8_BAR;
        PG8_WAIT_V(2); PG8_BAR;
        PG8_STAGE(PG8_SB(1, 0), cB + kstep, voffB); PG8_STAGE(PG8_SA(1, 0), cA + kstep, voffA); PG8_STAGE(PG8_SB(1, 1), cB + hstep + kstep, voffB);
        PG8_WAIT_V(6); PG8_BAR;
    } else {
        PG8_STAGE(PG8_SB(0, 0), cB, voffB); PG8_STAGE(PG8_SA(0, 0), cA, voffA); PG8_STAGE(PG8_SB(0, 1), cB + hstep, voffB); PG8_STAGE(PG8_SA(0, 1), cA + hstep, voffA);
        if (wr == 1) PG8_BAR;
        PG8_WAIT_V(4); PG8_BAR;
        PG8_STAGE(PG8_SB(1, 0), cB + kstep, voffB); PG8_STAGE(PG8_SA(1, 0), cA + kstep, voffA); PG8_STAGE(PG8_SB(1, 1), cB + hstep + kstep, voffB);
        PG8_WAIT_V(6); PG8_BAR;
    }
    for (;;) {
        const bool has_next = S.next(ui + 1, nxt);
        const char* nA = has_next ? (const char*)g.A + (size_t)nxt.pm * tstep : cA; const char* nB = has_next ? (const char*)g.Bt + (size_t)nxt.pn * tstep : cB;
        for (int t = 0; t < nt; t += 2) {
            const bool last = (t == nt - 2);
            const char* a1 = cA + (size_t)(t + 1) * kstep;
            const char* a2 = last ? nA : cA + (size_t)(t + 2) * kstep; const char* b2 = last ? nB : cB + (size_t)(t + 2) * kstep;
            const char* a3 = a2 + kstep; const char* b3 = b2 + kstep;
            if (last && has_next) S.a_ready(nxt);
            if constexpr (SP2) {
            PG8_LDB(B0, 0, 0); PG8_LDB(B1, 0, 1); PG8_SCHED; PG8_LDA(At, 0, 0); PG8_STAGE(PG8_SA(1, 1), a1 + hstep, voffA);
            PG8_WAIT_V(8); PG8_WAIT_L(0); PG8_BAR; PG8_MMA(0, 0, At, B0); PG8_MMA(0, 1, At, B1); PG8_BAR; PG8_SCHED;
            PG8_LDA(At, 0, 1); PG8_STAGE(PG8_SB(0, 0), b2, voffB); PG8_STAGE(PG8_SB(0, 1), b2 + hstep, voffB); PG8_STAGE(PG8_SA(0, 0), a2, voffA);
            PG8_WAIT_V(8); PG8_WAIT_L(0); PG8_BAR; PG8_MMA(1, 0, At, B0); PG8_MMA(1, 1, At, B1); PG8_BAR; PG8_SCHED;
            PG8_LDB(B0, 1, 0); PG8_LDB(B1, 1, 1); PG8_SCHED; PG8_LDA(At, 1, 0); PG8_STAGE(PG8_SA(0, 1), a2 + hstep, voffA);
            PG8_WAIT_V(8); PG8_WAIT_L(0); PG8_BAR; PG8_MMA(0, 0, At, B0); PG8_MMA(0, 1, At, B1); PG8_BAR; PG8_SCHED;
            PG8_LDA(At, 1, 1); PG8_STAGE(PG8_SB(1, 0), b3, voffB); PG8_STAGE(PG8_SB(1, 1), b3 + hstep, voffB); PG8_STAGE(PG8_SA(1, 0), a3, voffA);
            PG8_WAIT_V(8); PG8_WAIT_L(0); PG8_BAR; PG8_MMA(1, 0, At, B0); PG8_MMA(1, 1, At, B1); PG8_BAR; PG8_SCHED;
            } else {
            PG8_LDB(B0, 0, 0); PG8_SCHED; PG8_LDA(At, 0, 0); PG8_STAGE(PG8_SA(1, 1), a1 + hstep, voffA);
            PG8_WAIT_L(8); PG8_BAR; PG8_WAIT_L(0); PG8_MMA(0, 0, At, B0); PG8_BAR; PG8_SCHED;
            PG8_LDB(B1, 0, 1); PG8_STAGE(PG8_SB(0, 0), b2, voffB);
            PG8_BAR; PG8_WAIT_L(0); PG8_MMA(0, 1, At, B1); PG8_BAR;
            PG8_LDA(At, 0, 1); PG8_STAGE(PG8_SA(0, 0), a2, voffA);
            PG8_BAR; PG8_WAIT_L(0); PG8_MMA(1, 0, At, B0); PG8_BAR; PG8_SCHED;
            PG8_STAGE(PG8_SB(0, 1), b2 + hstep, voffB);
            PG8_WAIT_V(6); PG8_BAR; PG8_MMA(1, 1, At, B1); PG8_BAR;
            PG8_LDB(B0, 1, 0); PG8_SCHED; PG8_LDA(At, 1, 0); PG8_STAGE(PG8_SA(0, 1), a2 + hstep, voffA);
            PG8_WAIT_L(8); PG8_BAR; PG8_WAIT_L(0); PG8_MMA(0, 0, At, B0); PG8_BAR; PG8_SCHED;
            PG8_LDB(B1, 1, 1); PG8_STAGE(PG8_SB(1, 0), b3, voffB);
            PG8_BAR; PG8_WAIT_L(0); PG8_MMA(0, 1, At, B1); PG8_BAR;
            PG8_LDA(At, 1, 1); PG8_STAGE(PG8_SA(1, 0), a3, voffA);
            PG8_BAR; PG8_WAIT_L(0); PG8_MMA(1, 0, At, B0); PG8_BAR; PG8_SCHED;
            PG8_STAGE(PG8_SB(1, 1), b3 + hstep, voffB);
            PG8_WAIT_V(6); PG8_BAR; PG8_MMA(1, 1, At, B1); PG8_BAR;
            }
        }
        if constexpr (ALIGN_EPI) { if (wr == 0) PG8_BAR; }
        if constexpr (!Epi::AFTER_DRAIN) { E(acc, cur, wr, wc, fr, fq); S.done(cur); }
        if (!has_next) break;
#pragma unroll
        for (int a = 0; a < 2; ++a)
#pragma unroll
            for (int b = 0; b < 2; ++b)
#pragma unroll
                for (int m = 0; m < 4; ++m)
#pragma unroll
                    for (int n = 0; n < 2; ++n) acc[a][b][m][n] = (f32x4){0.f, 0.f, 0.f, 0.f};
        cur = nxt; cA = nA; cB = nB; ++ui;
        if constexpr (ALIGN_EPI) { if (wr == 1) PG8_BAR; }
    }
    PG8_WAIT_V(0);
    if constexpr (!ALIGN_EPI) { if (wr == 0) PG8_BAR; }
    PG8_BAR;
    if constexpr (Epi::AFTER_DRAIN) { E.fused(acc, cur, wr, wc, fr, fq, lds, wid, lane); S.done(cur); }
#undef PG8_SA
#undef PG8_SB
#undef PG8_STAGE
#undef PG8_LDA
#undef PG8_LDB
#undef PG8_MMA
#undef PG8_WAIT_V
#undef PG8_WAIT_L
#undef PG8_BAR
#undef PG8_SCHED
}
}
#define GAS __attribute__((address_space(1)))
#define LAS __attribute__((address_space(3)))
#define CAS __attribute__((address_space(4)))
typedef unsigned short bf16;
typedef unsigned v4u __attribute__((ext_vector_type(4)));
typedef float f32x4 __attribute__((ext_vector_type(4)));
typedef short bf16x8 __attribute__((ext_vector_type(8)));
typedef GAS unsigned gu32;
typedef GAS unsigned long long gu64;
#define RLX_AGENT __ATOMIC_RELAXED, __HIP_MEMORY_SCOPE_AGENT
#define LDS_WAIT() asm volatile("s_waitcnt lgkmcnt(0)" ::: "memory")
#define VM_WAIT() asm volatile("s_waitcnt vmcnt(0)" ::: "memory")
__device__ __forceinline__ unsigned long long rt() { return __builtin_amdgcn_s_memrealtime(); }
__device__ __forceinline__ unsigned f2bf(float f) { unsigned u = __builtin_bit_cast(unsigned, f); return (u + 0x7fffu + ((u >> 16) & 1u)) >> 16; }
__device__ __forceinline__ unsigned pk2(float lo, float hi) { return f2bf(lo) | (f2bf(hi) << 16); }
#define XB_TMO      128
#define XB_XCNT(j)  (256  + 64 * (j))
#define XB_XSUB(j)  (1280 + 64 * (j))
#define XB_XGEN(j)  (2304 + 64 * (j))
#define XB_TOP      3328
#define XB_TOPGEN   3392
#define XCD_BAR_WORDS 3456
#define XB_SPIN_CAP (1u << 18)

__device__ __forceinline__ unsigned xb_ld(unsigned* p)              { return __hip_atomic_load(p, __ATOMIC_RELAXED, __HIP_MEMORY_SCOPE_AGENT); }
__device__ __forceinline__ unsigned xb_add(unsigned* p, unsigned v) { return __hip_atomic_fetch_add(p, v, __ATOMIC_RELAXED, __HIP_MEMORY_SCOPE_AGENT); }
__device__ __forceinline__ unsigned xb_xcc_id() { return (unsigned)__builtin_amdgcn_s_getreg((3 << 11) | 20) & 0xFu; }
#define XB_SPIN(cond, bar) do { unsigned _sp = 0; while (cond) { __builtin_amdgcn_s_sleep(1); \
    if ((++_sp & 255u) == 0u) { if (xb_ld(&(bar)[XB_TMO])) break; if (_sp > XB_SPIN_CAP) { atomicAdd(&(bar)[XB_TMO], 1u); break; } } } } while (0)

struct XcdBarrier {
    unsigned* bar; unsigned x;
    volatile LAS unsigned* st;
};

__device__ __forceinline__ XcdBarrier xcd_barrier_post(unsigned* bar, volatile LAS unsigned* st) {
    XcdBarrier b; b.bar = bar; b.x = xb_xcc_id(); b.st = st;
    if (threadIdx.x == 0) (void)xb_add(&bar[XB_XCNT(b.x)], 1u);
    return b;
}
__device__ __forceinline__ void xcd_barrier_complete(unsigned* bar, unsigned x, unsigned& nloc, unsigned& nx) {
    const unsigned G = gridDim.x * gridDim.y * gridDim.z;
    unsigned sum, cnt, mine, sp = 0u;
    for (;;) {
        sum = 0u; cnt = 0u; mine = 0u;
#pragma unroll
        for (unsigned j = 0; j < 16; ++j) { const unsigned c = xb_ld(&bar[XB_XCNT(j)]); sum += c; cnt += (c > 0u) ? 1u : 0u; mine = (j == x) ? c : mine; }
        if (sum == G) break;
        __builtin_amdgcn_s_sleep(1);
        if ((++sp & 255u) == 0u) { if (xb_ld(&bar[XB_TMO])) break; if (sp > XB_SPIN_CAP) { atomicAdd(&bar[XB_TMO], 1u); break; } }
    }
    nloc = mine > 0u ? mine : 1u; nx = cnt > 0u ? cnt : 1u;
}

__device__ __forceinline__ void xcd_barrier(const XcdBarrier& b) {
    asm volatile("s_waitcnt vmcnt(0)" ::: "memory");
    __syncthreads();
    if (threadIdx.x == 0) {
        unsigned* bar = b.bar;
        __builtin_amdgcn_s_waitcnt(0);
        unsigned nloc = b.st[0], nx = b.st[1];
        if (nloc == 0u) { xcd_barrier_complete(bar, b.x, nloc, nx); b.st[0] = nloc; b.st[1] = nx; }
        const unsigned old = xb_add(&bar[XB_XSUB(b.x)], 1u);
        const unsigned gen = old / nloc;
        if (old + 1u == (gen + 1u) * nloc) {
            __builtin_amdgcn_fence(__ATOMIC_RELEASE, "agent");
            asm volatile("s_waitcnt vmcnt(0)" ::: "memory");
            const unsigned og = xb_add(&bar[XB_TOP], 1u);
            const unsigned tg = og / nx;
            if (og + 1u == (tg + 1u) * nx) xb_add(&bar[XB_TOPGEN], 1u);
            else XB_SPIN(xb_ld(&bar[XB_TOPGEN]) == tg, bar);
            __builtin_amdgcn_fence(__ATOMIC_ACQUIRE, "agent");
            xb_add(&bar[XB_XGEN(b.x)], 1u);
            asm volatile("s_waitcnt vmcnt(0)" ::: "memory");
        } else {
            XB_SPIN(xb_ld(&bar[XB_XGEN(b.x)]) == gen, bar);
            __builtin_amdgcn_fence(__ATOMIC_ACQUIRE, "agent");
            asm volatile("s_waitcnt vmcnt(0)" ::: "memory");
        }
    }
    __syncthreads();
}
constexpr int NWAVES = 8;
constexpr int BATCH = 2, SEQ = 8192, DM = 4096, M = BATCH * SEQ, HD = 128;
constexpr int A_IN = 18432, A_OUT = 2048, A_HEADS = 16;
constexpr int B_IN = 7328, B_IN_PAD = 7424, B_QW = 4096, B_KVW = 1024, IDX_RANK = 1024, IDX_HEADS = 32, TOPK = 256;
constexpr int DFF = 16384;
constexpr float NORM_EPS = 1e-6f;
constexpr float QSCALE = 0.08838834764831845f;
constexpr float IWSCALE = 0.015625f;
constexpr float HID_SCALE = 4.0f, WDOWN_SCALE = 128.0f, WUP_SCALE = 64.0f, OB_SCALE = 32.0f, WOUTB_SCALE = 64.0f, WINB_SCALE = 64.0f;
constexpr float VF8_SCALE = 4.0f, PF8_SCALE = 256.0f;
#ifndef QKVA_F8
#define QKVA_F8 0
#endif
#ifndef QKVA_I8
#define QKVA_I8 1
#endif
#ifndef UP0_I8
#define UP0_I8 1
#endif
#ifndef SP_ASM
#define SP_ASM 1
#endif
#ifndef P9_FILL
#define P9_FILL 0
#endif
#ifndef MERGE2
#define MERGE2 0
#endif
#ifndef SP_LATE
#define SP_LATE 0
#endif
#ifndef TOPK_SPLIT
#define TOPK_SPLIT 1
#endif
#ifndef THIN_PF
#define THIN_PF 2
#endif
#ifndef P0_NT
#define P0_NT 1
#endif
#ifndef DIL_RUN
#define DIL_RUN 0
#endif
#ifndef DIL_STAGGER
#define DIL_STAGGER 1
#endif
#ifndef DIL_PIPE
#define DIL_PIPE 0
#endif
#ifndef XN_LATE
#define XN_LATE 1
#endif
#ifndef I8_ST_CACHED
#define I8_ST_CACHED 1
#endif
#ifndef P0_ORDER
#define P0_ORDER 1
#endif
#ifndef BASE_NT
#define BASE_NT 0
#endif
#ifndef HB_NT
#define HB_NT 1
#endif
#ifndef XCD_ROWS
#define XCD_ROWS 0
#endif
#ifndef WGM_K16K
#define WGM_K16K 4
#define WGM_K2K 4
#define WGM_K1K 4
#endif
#ifndef SP_VSPLIT
#define SP_VSPLIT 0
#endif
#ifndef SP_ASM2
#define SP_ASM2 1
#endif
#ifndef LATE_BATCH
#define LATE_BATCH 0
#endif
#ifndef IDX_PIPE
#define IDX_PIPE 1
#endif
#ifndef IDX_VPM
#define IDX_VPM 6
#endif
#ifndef IDX_I8
#define IDX_I8 1
#endif
#ifndef IDX_F8
#define IDX_F8 0
#endif
#ifndef LATE_CONV
#define LATE_CONV (!L1_I8)
#endif
#ifndef WOUTA_I8
#define WOUTA_I8 1
#endif
#ifndef IDXG_I8
#define IDXG_I8 1
#endif
#ifndef L1_I8
#define L1_I8 0
#endif
#ifndef DOWN0_F8
#define DOWN0_F8 1
#endif
constexpr float WINA_SCALE = 64.0f;
constexpr int B_QKV = 6144;

constexpr size_t MiB = 1u << 20;
constexpr size_t WS_CTL = 0, CTL_ZERO_BYTES = 1 * MiB;
constexpr size_t WS_SROW = 1 * MiB;
constexpr size_t WS_SCOL_INA = 1 * MiB + 128 * 1024, WS_SCOL_UP0 = 1 * MiB + 256 * 1024;
constexpr size_t WS_SCOL_INB = 1 * MiB + 384 * 1024, WS_SCOL_UP1 = 1 * MiB + 512 * 1024;
constexpr size_t WS_SROW_OM = 1 * MiB + 64 * 1024;
constexpr size_t WS_SCOL_OUTA = 1 * MiB + 576 * 1024, WS_SCOL_INB2 = 1 * MiB + 592 * 1024, WS_SCOL_IDX = 1 * MiB + 600 * 1024, WS_SROW_IQ = 1 * MiB + 640 * 1024;
constexpr size_t WS_SK = 1 * MiB + 704 * 1024;
constexpr size_t WS_ROPE = 2 * MiB;
constexpr size_t WS_W_INA = 16 * MiB;
constexpr size_t WS_W_OUTA = WS_W_INA + 144 * MiB;
constexpr size_t WS_W_INB = WS_W_OUTA + 16 * MiB;
constexpr size_t WS_W_IDX = WS_W_INB + 58 * MiB;
constexpr size_t WS_W_OUTB = WS_W_IDX + 8 * MiB;
constexpr size_t WS_W_UP = WS_W_OUTB + 32 * MiB;
constexpr size_t WS_W_DOWN = WS_W_UP + 256 * MiB;
constexpr size_t WS_W_UP1 = WS_W_UP + 128 * MiB;
constexpr size_t WS_W_DOWN1 = WS_W_DOWN + 128 * MiB;
constexpr size_t WS_W_INB2 = WS_W_INB + 24 * MiB;
constexpr size_t WS_HB = WS_W_INA;
constexpr size_t WS_XN = 800 * MiB;
constexpr size_t WS_MIX = 928 * MiB;
constexpr size_t WS_R1 = 1056 * MiB;
constexpr size_t WS_HID = WS_R1;
constexpr size_t WS_QKVA = WS_R1;
constexpr size_t WS_OG = WS_QKVA + 576 * MiB;
constexpr size_t WS_LSE = WS_OG + 192 * MiB;
constexpr size_t WS_OMERGE = WS_LSE + 4 * MiB;
constexpr size_t WS_QB = WS_R1;
constexpr size_t WS_KB = WS_QB + 128 * MiB;
constexpr size_t WS_VB = WS_KB + 32 * MiB;
constexpr size_t WS_IQL = WS_VB + 32 * MiB;
constexpr size_t WS_IKW = WS_IQL + 32 * MiB;
constexpr size_t WS_IQLN = WS_IKW + 16 * MiB;
constexpr size_t WS_IKB = WS_IQLN + 32 * MiB;
constexpr size_t WS_IWS = WS_IKB + 4 * MiB;
constexpr size_t WS_IQ = WS_IWS + 2 * MiB;
constexpr size_t WS_SEL = WS_IQ + 128 * MiB;
constexpr size_t WS_SCORE = WS_SEL + 16 * MiB;
constexpr size_t WS_XN8 = WS_SCORE;
constexpr size_t WS_OB = WS_IQL;
constexpr size_t WS_END = 1992 * MiB;
static_assert(WS_W_DOWN + 256 * MiB <= WS_XN && WS_OMERGE + 64 * MiB <= WS_END && WS_SCORE + 512 * MiB <= WS_END && WS_OB + 128 * MiB <= WS_SEL && WS_HID + 512 * MiB <= WS_END, "d_ws map");
constexpr int CW_SPQ = 2048;
constexpr int CW_CMAX_INA = 131072, CW_CMAX_UP0 = CW_CMAX_INA + 18432;
constexpr int CW_CMAX_INB = CW_CMAX_UP0 + 16384, CW_CMAX_UP1 = CW_CMAX_INB + 6144;
constexpr int CW_CMAX_OUTA = CW_CMAX_UP1 + 16384, CW_CMAX_INB2 = CW_CMAX_OUTA + 4096, CW_CMAX_IDX = CW_CMAX_INB2 + 1280;
static_assert((CW_CMAX_IDX + 4096) * 4 <= (int)CTL_ZERO_BYTES, "column maxima inside the per-call memset");
constexpr int CW_BAR = 4096;
constexpr int N_PHASES = 20;

constexpr int RING_OFF = 0, RING_BYTES = 131072;
constexpr int LDSCTL_OFF = RING_BYTES, MISC_OFF = LDSCTL_OFF + 320;
constexpr int LDS_BYTES = 163840;
static_assert(MISC_OFF + 128 <= LDS_BYTES, "LDS map");

struct Frame {
    LAS unsigned char* lds;
    volatile LAS unsigned* MISC;
    gu32* ctl;
    int tid, lane, wave;
    int vcu, G;
    unsigned char* ws;
};
__device__ __forceinline__ float wave_sum(float v) {
#pragma unroll
    for (int o = 1; o < 64; o <<= 1) v += __shfl_xor(v, o);
    return v;
}
__device__ __forceinline__ float wave_max(float v) {
#pragma unroll
    for (int o = 1; o < 64; o <<= 1) v = fmaxf(v, __shfl_xor(v, o));
    return v;
}
__device__ __forceinline__ float bf_lo(unsigned u) { return __builtin_bit_cast(float, u << 16); }
__device__ __forceinline__ float bf_hi(unsigned u) { return __builtin_bit_cast(float, u & 0xffff0000u); }

__device__ __forceinline__ void p0_transpose_item(const float* W, int K, int N, bf16* WT, int perm, LAS float* scr, int item, int lane, int drow = 0) {
    const int nblk = N / 32, kb = item / nblk, nb = item % nblk, k0 = 64 * kb, n0 = 32 * nb;
    { float tv[32];
#pragma unroll
      for (int i = 0; i < 32; ++i) tv[i] = W[(size_t)(k0 + 2 * i + (lane >> 5)) * N + n0 + (lane & 31)];
      __builtin_amdgcn_sched_barrier(0);
#pragma unroll
      for (int i = 0; i < 32; ++i) scr[(2 * i + (lane >> 5)) * 33 + (lane & 31)] = tv[i]; }
    LDS_WAIT(); asm volatile("" ::: "memory");
    int d0 = n0;
    if (perm) { const int blk = (n0 >> 6) & 3, sb = (blk == 1) ? 2 : (blk == 2) ? 1 : blk; d0 = (n0 & ~255) + 64 * sb + (n0 & 63); }
    const int c = lane & 7;
#pragma unroll
    for (int j = 0; j < 4; ++j) { const int n = (lane >> 3) + 8 * j; const LAS float* s = scr + (8 * c) * 33 + n;
        v4u o; o.x = pk2(s[0 * 33], s[1 * 33]); o.y = pk2(s[2 * 33], s[3 * 33]); o.z = pk2(s[4 * 33], s[5 * 33]); o.w = pk2(s[6 * 33], s[7 * 33]);
        *(GAS v4u*)(WT + (size_t)(d0 + n - drow) * K + k0 + 8 * c) = o; }
    LDS_WAIT(); asm volatile("" ::: "memory");
}
__device__ __forceinline__ void p0_transpose_item_f8(const float* W, int K, int N, unsigned char* WT, float scale, LAS float* scr, int item, int lane, int perm = 0) {
    const int nblk = N / 32, kb = item / nblk, nb = item % nblk, k0 = 64 * kb, n0 = 32 * nb;
    { float tv[32];
#pragma unroll
      for (int i = 0; i < 32; ++i) tv[i] = P0_NT ? __builtin_nontemporal_load(W + (size_t)(k0 + 2 * i + (lane >> 5)) * N + n0 + (lane & 31)) : W[(size_t)(k0 + 2 * i + (lane >> 5)) * N + n0 + (lane & 31)];
      __builtin_amdgcn_sched_barrier(0);
#pragma unroll
      for (int i = 0; i < 32; ++i) scr[(2 * i + (lane >> 5)) * 33 + (lane & 31)] = tv[i]; }
    LDS_WAIT(); asm volatile("" ::: "memory");
    int d0 = n0;
    if (perm) { const int blk = (n0 >> 6) & 3, sb = (blk == 1) ? 2 : (blk == 2) ? 1 : blk; d0 = (n0 & ~255) + 64 * sb + (n0 & 63); }
    const int c = lane & 7;
#pragma unroll
    for (int j = 0; j < 4; ++j) { const int n = (lane >> 3) + 8 * j; const LAS float* s = scr + (8 * c) * 33 + n;
        int p0 = 0, p1 = 0;
        p0 = __builtin_amdgcn_cvt_pk_fp8_f32(s[0 * 33] * scale, s[1 * 33] * scale, p0, false); p0 = __builtin_amdgcn_cvt_pk_fp8_f32(s[2 * 33] * scale, s[3 * 33] * scale, p0, true);
        p1 = __builtin_amdgcn_cvt_pk_fp8_f32(s[4 * 33] * scale, s[5 * 33] * scale, p1, false); p1 = __builtin_amdgcn_cvt_pk_fp8_f32(s[6 * 33] * scale, s[7 * 33] * scale, p1, true);
        { const unsigned long long pv_ = (unsigned long long)(unsigned)p0 | ((unsigned long long)(unsigned)p1 << 32); unsigned long long* pp_ = (unsigned long long*)(WT + (size_t)(d0 + n) * K + k0 + 8 * c);
          if (P0_NT) __builtin_nontemporal_store(pv_, pp_); else *(GAS unsigned long long*)pp_ = pv_; } }
    LDS_WAIT(); asm volatile("" ::: "memory");
}
__device__ __forceinline__ unsigned pk_i8x4(float a, float b, float c, float d) {
    const int ia = (int)__builtin_rintf(a), ib = (int)__builtin_rintf(b), ic = (int)__builtin_rintf(c), id = (int)__builtin_rintf(d);
    return (unsigned)(ia & 255) | ((unsigned)(ib & 255) << 8) | ((unsigned)(ic & 255) << 16) | ((unsigned)id << 24);
}
__device__ __forceinline__ void p0_colmax_item(const float* W, int K, int N, unsigned* cmax, int item, int lane, int dcol = 0) {
    const int nblk = N / 32, kb = item / nblk, nb = item % nblk, k0 = 64 * kb, n0 = 32 * nb;
    float mx = 0.f;
#pragma unroll
    for (int i = 0; i < 32; ++i) { const int kk = 2 * i + (lane >> 5); mx = fmaxf(mx, __builtin_fabsf(W[(size_t)(k0 + kk) * N + n0 + (lane & 31)])); }
    mx = fmaxf(mx, __shfl_xor(mx, 32));
    if (lane < 32) __hip_atomic_fetch_max(cmax + n0 + lane - dcol, __builtin_bit_cast(unsigned, mx), __ATOMIC_RELAXED, __HIP_MEMORY_SCOPE_AGENT);
}
__device__ __forceinline__ void p0_transpose_item_i8(const float* W, int K, int N, unsigned char* WT, const unsigned* cmax, float* scol, LAS float* scr, int item, int lane, int perm, int drow = 0) {
    const int nblk = N / 32, kb = item / nblk, nb = item % nblk, k0 = 64 * kb, n0 = 32 * nb;
    { float tv[32];
#pragma unroll
      for (int i = 0; i < 32; ++i) tv[i] = P0_NT ? __builtin_nontemporal_load(W + (size_t)(k0 + 2 * i + (lane >> 5)) * N + n0 + (lane & 31)) : W[(size_t)(k0 + 2 * i + (lane >> 5)) * N + n0 + (lane & 31)];
      __builtin_amdgcn_sched_barrier(0);
#pragma unroll
      for (int i = 0; i < 32; ++i) scr[(2 * i + (lane >> 5)) * 33 + (lane & 31)] = tv[i]; }
    LDS_WAIT(); asm volatile("" ::: "memory");
    int d0 = n0;
    if (perm) { const int blk = (n0 >> 6) & 3, sb = (blk == 1) ? 2 : (blk == 2) ? 1 : blk; d0 = (n0 & ~255) + 64 * sb + (n0 & 63); }
    const int c = lane & 7;
#pragma unroll
    for (int j = 0; j < 4; ++j) { const int n = (lane >> 3) + 8 * j; const LAS float* s = scr + (8 * c) * 33 + n;
        const float amax = __builtin_bit_cast(float, cmax[n0 + n - drow]); const float inv = amax > 0.f ? 127.0f / amax : 0.f;
        const unsigned p0 = pk_i8x4(s[0 * 33] * inv, s[1 * 33] * inv, s[2 * 33] * inv, s[3 * 33] * inv), p1 = pk_i8x4(s[4 * 33] * inv, s[5 * 33] * inv, s[6 * 33] * inv, s[7 * 33] * inv);
        { const unsigned long long pv_ = (unsigned long long)p0 | ((unsigned long long)p1 << 32); unsigned long long* pp_ = (unsigned long long*)(WT + (size_t)(d0 + n - drow) * K + k0 + 8 * c);
          if (P0_NT && !I8_ST_CACHED) __builtin_nontemporal_store(pv_, pp_); else *(GAS unsigned long long*)pp_ = pv_; }
        if (kb == 0 && c == 0) scol[d0 + n - drow] = amax * (1.0f / 127.0f); }
    LDS_WAIT(); asm volatile("" ::: "memory");
}
template <int XF8> __device__ __forceinline__ void rms_row_to_bf16(const float* xrow, const float* g, bf16* orow, float* srow_m, int lane) {
    const GAS f32x4* xr = (const GAS f32x4*)xrow + lane; const CAS f32x4* gr = (const CAS f32x4*)g + lane;
    f32x4 v[16]; float s = 0.f;
#pragma unroll
    for (int j = 0; j < 16; ++j) { v[j] = XN_LATE ? __builtin_nontemporal_load((const f32x4*)xrow + lane + 64 * j) : xr[64 * j]; s += (v[j].x * v[j].x + v[j].y * v[j].y) + (v[j].z * v[j].z + v[j].w * v[j].w); }
    const float rs = 1.0f / sqrtf(wave_sum(s) * (1.f / DM) + NORM_EPS);
    GAS unsigned long long* o8 = (GAS unsigned long long*)orow + lane;
    if (XF8 == 2) { float am = 0.f;
#pragma unroll
        for (int j = 0; j < 16; ++j) { const f32x4 gg = gr[64 * j]; v[j] = v[j] * rs * gg; am = fmaxf(fmaxf(am, fmaxf(__builtin_fabsf(v[j].x), __builtin_fabsf(v[j].y))), fmaxf(__builtin_fabsf(v[j].z), __builtin_fabsf(v[j].w))); }
        am = wave_max(am); const float inv = am > 0.f ? 127.0f / am : 0.f;
#pragma unroll
        for (int j = 0; j < 16; ++j) ((GAS unsigned*)orow)[lane + 64 * j] = pk_i8x4(v[j].x * inv, v[j].y * inv, v[j].z * inv, v[j].w * inv);
        if (lane == 0) *srow_m = am * (1.0f / 127.0f);
        return; }
#pragma unroll
    for (int j = 0; j < 16; ++j) { const f32x4 gg = gr[64 * j];
        if (XF8 == 1) { int p = 0; p = __builtin_amdgcn_cvt_pk_fp8_f32(v[j].x * rs * gg.x, v[j].y * rs * gg.y, p, false); p = __builtin_amdgcn_cvt_pk_fp8_f32(v[j].z * rs * gg.z, v[j].w * rs * gg.w, p, true); ((GAS unsigned*)orow)[lane + 64 * j] = (unsigned)p; }
        else o8[64 * j] = (unsigned long long)pk2(v[j].x * rs * gg.x, v[j].y * rs * gg.y) | ((unsigned long long)pk2(v[j].z * rs * gg.z, v[j].w * rs * gg.w) << 32); }
}
template <int XF8, bool BB, bool OB> __device__ __forceinline__ void resid_norm_row(const bf16* mixrow, const void* baserow, const float* gpost, void* outrow, const float* gnext, bf16* xnrow, unsigned char* xn8row, float* srow_m, int lane, const void* pf_mix = nullptr, const void* pf_base = nullptr, LAS unsigned* pf_lds = nullptr) {
    const GAS unsigned long long* mr = (const GAS unsigned long long*)mixrow + lane; const CAS f32x4* gp = (const CAS f32x4*)gpost + lane;
    f32x4 v[16]; float s = 0.f;
#pragma unroll
    for (int j = 0; j < 16; ++j) { const unsigned long long q = P0_NT ? __builtin_nontemporal_load((const unsigned long long*)mixrow + lane + 64 * j) : mr[64 * j]; const unsigned ql = (unsigned)q, qh = (unsigned)(q >> 32); v[j] = (f32x4){bf_lo(ql), bf_hi(ql), bf_lo(qh), bf_hi(qh)};
        s += (v[j].x * v[j].x + v[j].y * v[j].y) + (v[j].z * v[j].z + v[j].w * v[j].w); }
    const float rs = 1.0f / sqrtf(wave_sum(s) * (1.f / DM) + NORM_EPS);
    float s2 = 0.f;
    unsigned long long bq[BB ? 16 : 1]; f32x4 bf[BB ? 1 : 16];
#pragma unroll
    for (int j = 0; j < 16; ++j) { if (BB) bq[j] = BASE_NT ? __builtin_nontemporal_load((const unsigned long long*)baserow + lane + 64 * j) : ((const GAS unsigned long long*)baserow)[lane + 64 * j];
                                   else bf[j] = BASE_NT ? __builtin_nontemporal_load((const f32x4*)baserow + lane + 64 * j) : ((const GAS f32x4*)baserow)[lane + 64 * j]; }
#pragma unroll
    for (int j = 0; j < 16; ++j) { const f32x4 gg = gp[64 * j]; f32x4 bb;
        if (BB) { const unsigned long long q = bq[j]; const unsigned ql = (unsigned)q, qh = (unsigned)(q >> 32); bb = (f32x4){bf_lo(ql), bf_hi(ql), bf_lo(qh), bf_hi(qh)}; }
        else bb = bf[j];
        v[j] = bb + v[j] * rs * gg;
        if (OB) { const unsigned long long hv_ = (unsigned long long)pk2(v[j].x, v[j].y) | ((unsigned long long)pk2(v[j].z, v[j].w) << 32);
                  if (HB_NT) __builtin_nontemporal_store(hv_, (unsigned long long*)outrow + lane + 64 * j); else ((GAS unsigned long long*)outrow)[lane + 64 * j] = hv_; }
        else ((GAS f32x4*)outrow)[lane + 64 * j] = v[j];
        s2 += (v[j].x * v[j].x + v[j].y * v[j].y) + (v[j].z * v[j].z + v[j].w * v[j].w); }
#if THIN_PF == 1
    if (pf_mix) { __builtin_amdgcn_global_load_lds((const unsigned*)((const unsigned char*)pf_mix + 128 * lane), pf_lds, 4, 0, 0);
        __builtin_amdgcn_global_load_lds((const unsigned*)((const unsigned char*)pf_base + 128 * lane), pf_lds, 4, 0, 0);
        if (!BB) __builtin_amdgcn_global_load_lds((const unsigned*)((const unsigned char*)pf_base + 8192 + 128 * lane), pf_lds, 4, 0, 0); }
#endif
    if (xnrow) {
        const float rs2 = 1.0f / sqrtf(wave_sum(s2) * (1.f / DM) + NORM_EPS);
        const CAS f32x4* gn = (const CAS f32x4*)gnext + lane;
#if THIN_PF
        asm volatile("" : "+v"(gn));
#endif
        GAS unsigned long long* o8 = (GAS unsigned long long*)xnrow + lane;
        if (XF8 == 3 || XF8 == 4 || XF8 == 5) { float am = 0.f;
#pragma unroll
            for (int j = 0; j < 16; ++j) { const f32x4 gg = gn[64 * j]; v[j] = v[j] * rs2 * gg; am = fmaxf(fmaxf(am, fmaxf(__builtin_fabsf(v[j].x), __builtin_fabsf(v[j].y))), fmaxf(__builtin_fabsf(v[j].z), __builtin_fabsf(v[j].w))); }
            am = wave_max(am); const float inv = am > 0.f ? 127.0f / am : 0.f;
#pragma unroll
            for (int j = 0; j < 16; ++j) {
                if (XF8 == 5) { int p = 0; p = __builtin_amdgcn_cvt_pk_fp8_f32(v[j].x, v[j].y, p, false); p = __builtin_amdgcn_cvt_pk_fp8_f32(v[j].z, v[j].w, p, true); ((GAS unsigned*)xn8row)[lane + 64 * j] = (unsigned)p;
                                ((GAS unsigned*)xnrow)[lane + 64 * j] = pk_i8x4(v[j].x * inv, v[j].y * inv, v[j].z * inv, v[j].w * inv); continue; }
                ((GAS unsigned*)xn8row)[lane + 64 * j] = pk_i8x4(v[j].x * inv, v[j].y * inv, v[j].z * inv, v[j].w * inv);
                if (XF8 == 4) o8[64 * j] = (unsigned long long)pk2(v[j].x, v[j].y) | ((unsigned long long)pk2(v[j].z, v[j].w) << 32); }
            if (lane == 0) *srow_m = am * (1.0f / 127.0f);
            return; }
#pragma unroll
        for (int j = 0; j < 16; ++j) { const f32x4 gg = gn[64 * j];
            if (XF8 >= 1) { int p = 0; p = __builtin_amdgcn_cvt_pk_fp8_f32(v[j].x * rs2 * gg.x, v[j].y * rs2 * gg.y, p, false); p = __builtin_amdgcn_cvt_pk_fp8_f32(v[j].z * rs2 * gg.z, v[j].w * rs2 * gg.w, p, true);
                       ((GAS unsigned*)xn8row)[lane + 64 * j] = (unsigned)p; }
            if (XF8 != 1) o8[64 * j] = (unsigned long long)pk2(v[j].x * rs2 * gg.x, v[j].y * rs2 * gg.y) | ((unsigned long long)pk2(v[j].z * rs2 * gg.z, v[j].w * rs2 * gg.w) << 32); }
    }
}
struct Args { const void* in[16]; float* out; unsigned char* ws; int ph_lo, ph_hi, li, pad; };

typedef float f32x16 __attribute__((ext_vector_type(16)));
__device__ __forceinline__ int xrow(int gw, int NGW, int G, int i) {
    if (XCD_ROWS && G % 8 == 0) { const int wpx = NGW / 8, l = gw % wpx + wpx * i; return l < M / 8 ? (gw / wpx) * (M / 8) + l : -1; }
    const int m = gw + NGW * i; return m < M ? m : -1;
}
#define MFMA32(a, b, c) __builtin_amdgcn_mfma_f32_32x32x16_bf16((a), (b), (c), 0, 0, 0)

__device__ __forceinline__ void p0_prologue(Frame& F, const Args& a) {
    LAS float* scr = (LAS float*)(F.lds + RING_OFF + F.wave * 16384);
    const int gw = F.vcu * NWAVES + F.wave, NGW = F.G * NWAVES;
    unsigned char* ws = F.ws;
    constexpr int I_INA = (DM / 64) * (A_IN / 32), I_OUTA = (A_OUT / 64) * (DM / 32), I_INB = (DM / 64) * (B_IN / 32), I_IDX = (IDX_RANK / 64) * (4096 / 32),
                  I_OUTB = (4096 / 64) * (DM / 32), I_UP = (DM / 64) * (DFF / 32), I_DOWN = (DFF / 64) * (DM / 32);
    constexpr int NITEMS = I_INA + I_OUTA + I_INB + I_IDX + I_OUTB + 2 * I_UP + 2 * I_DOWN;
#if !P0_ORDER
    for (int it = gw; it < NITEMS; it += NGW) {
        int r = it;
#if QKVA_I8
        if (r < I_INA) { p0_colmax_item((const float*)a.in[6], DM, A_IN, (unsigned*)(F.ctl + CW_CMAX_INA), r, F.lane); continue; } r -= I_INA;
#elif QKVA_F8
        if (r < I_INA) { p0_transpose_item_f8((const float*)a.in[6], DM, A_IN, (unsigned char*)(ws + WS_W_INA), WINA_SCALE, scr, r, F.lane, 1); continue; } r -= I_INA;
#else
        if (r < I_INA) { p0_transpose_item((const float*)a.in[6], DM, A_IN, (bf16*)(ws + WS_W_INA), 1, scr, r, F.lane); continue; } r -= I_INA;
#endif
        if (r < I_OUTA) { if (WOUTA_I8) p0_colmax_item((const float*)a.in[7], A_OUT, DM, (unsigned*)(F.ctl + CW_CMAX_OUTA), r, F.lane);
                          else p0_transpose_item((const float*)a.in[7], A_OUT, DM, (bf16*)(ws + WS_W_OUTA), 0, scr, r, F.lane); continue; } r -= I_OUTA;
        if (r < I_INB) { const int n0 = 32 * (r % (B_IN / 32));
            if (n0 < B_QKV) { if (L1_I8) p0_colmax_item((const float*)a.in[8], DM, B_IN, (unsigned*)(F.ctl + CW_CMAX_INB), r, F.lane);
                              else p0_transpose_item_f8((const float*)a.in[8], DM, B_IN, (unsigned char*)(ws + WS_W_INB), WINB_SCALE, scr, r, F.lane, 1); }
            else if (IDXG_I8) p0_colmax_item((const float*)a.in[8], DM, B_IN, (unsigned*)(F.ctl + CW_CMAX_INB2), r, F.lane, B_QKV);
            else p0_transpose_item((const float*)a.in[8], DM, B_IN, (bf16*)(ws + WS_W_INB2), 1, scr, r, F.lane, B_QKV);
            continue; } r -= I_INB;
        if (r < I_IDX) { if (IDXG_I8) p0_colmax_item((const float*)a.in[10], IDX_RANK, 4096, (unsigned*)(F.ctl + CW_CMAX_IDX), r, F.lane);
                         else p0_transpose_item((const float*)a.in[10], IDX_RANK, 4096, (bf16*)(ws + WS_W_IDX), 1, scr, r, F.lane); continue; } r -= I_IDX;
        if (r < I_OUTB) { if (!LATE_CONV) p0_transpose_item_f8((const float*)a.in[13], 4096, DM, (unsigned char*)(ws + WS_W_OUTB), WOUTB_SCALE, scr, r, F.lane); continue; } r -= I_OUTB;
#if UP0_I8
        if (r < I_UP) { p0_colmax_item((const float*)a.in[14], DM, DFF, (unsigned*)(F.ctl + CW_CMAX_UP0), r, F.lane); continue; } r -= I_UP;
#else
        if (r < I_UP) { p0_transpose_item((const float*)a.in[14], DM, DFF, (bf16*)(ws + WS_W_UP), 0, scr, r, F.lane); continue; } r -= I_UP;
#endif
        if (r < I_UP) { if (L1_I8) p0_colmax_item((const float*)a.in[14] + (size_t)DM * DFF, DM, DFF, (unsigned*)(F.ctl + CW_CMAX_UP1), r, F.lane);
                        else if (!LATE_CONV) p0_transpose_item_f8((const float*)a.in[14] + (size_t)DM * DFF, DM, DFF, (unsigned char*)(ws + WS_W_UP1), WUP_SCALE, scr, r, F.lane); continue; } r -= I_UP;
#if DOWN0_F8
        if (r < I_DOWN) { p0_transpose_item_f8((const float*)a.in[15], DFF, DM, (unsigned char*)(ws + WS_W_DOWN), WDOWN_SCALE, scr, r, F.lane); continue; } r -= I_DOWN;
#else
        if (r < I_DOWN) { p0_transpose_item((const float*)a.in[15], DFF, DM, (bf16*)(ws + WS_W_DOWN), 0, scr, r, F.lane); continue; } r -= I_DOWN;
#endif
        if (!LATE_CONV) p0_transpose_item_f8((const float*)a.in[15] + (size_t)DM * DFF, DFF, DM, (unsigned char*)(ws + WS_W_DOWN1), WDOWN_SCALE, scr, r, F.lane);
    }
#endif
    const int gt = F.vcu * (NWAVES * 64) + F.tid, NGT = F.G * NWAVES * 64;
    { unsigned char* wt = (unsigned char*)(ws + WS_W_INB2); constexpr int RB = IDXG_I8 ? DM : 2 * DM;
      for (int i = gt; i < 96 * (RB / 16); i += NGT) { const int rr = i / (RB / 16), row = (rr < 32 ? 7264 + rr : 7360 + (rr - 32)) - B_QKV; *(GAS v4u*)(wt + (size_t)row * RB + (i % (RB / 16)) * 16) = (v4u){0u, 0u, 0u, 0u}; }
      if (IDXG_I8) { float* sc = (float*)(ws + WS_SCOL_INB2); for (int i = gt; i < 96; i += NGT) sc[(i < 32 ? 7264 + i : 7360 + (i - 32)) - B_QKV] = 0.f; } }
    { const int* pos = (const int*)a.in[1]; float* rope = (float*)(ws + WS_ROPE);
      for (int idx = gt; idx < M * 64; idx += NGT) { const int m = idx >> 6, i = idx & 63;
          double f = 1.0, bs = 0.8659643233600653; int e = i;
#pragma unroll
          for (int s = 0; s < 6; ++s) { if (e & 1) f *= bs; bs *= bs; e >>= 1; }
          const double th = (double)pos[m] * f;
          const double nn = __builtin_rint(th * 0.15915494309189535);
          double rr = __builtin_fma(-nn, 6.283185307179586, th); rr = __builtin_fma(-nn, 2.4492935982947064e-16, rr);
          const double kq = __builtin_rint(rr * 0.6366197723675814);
          double y = __builtin_fma(-kq, 1.5707963267948966, rr); y = __builtin_fma(-kq, 6.123233995736766e-17, y);
          const double y2 = y * y;
          double sp = 1.6059043836821613e-10; sp = sp * y2 - 2.505210838544172e-08; sp = sp * y2 + 2.7557319223985893e-06; sp = sp * y2 - 1.984126984126984e-04; sp = sp * y2 + 8.333333333333333e-03; sp = sp * y2 - 1.6666666666666666e-01; sp = sp * y2 + 1.0;
          const double sy = sp * y;
          double cp = -1.1470745597729725e-11; cp = cp * y2 + 2.08767569878681e-09; cp = cp * y2 - 2.755731922398589e-07; cp = cp * y2 + 2.48015873015873e-05; cp = cp * y2 - 1.388888888888889e-03; cp = cp * y2 + 4.1666666666666664e-02; cp = cp * y2 - 0.5; cp = cp * y2 + 1.0;
          const int q = ((int)kq) & 3;
          const double cs = (q == 0) ? cp : (q == 1) ? -sy : (q == 2) ? -cp : sy;
          const double sn = (q == 0) ? sy : (q == 1) ? cp : (q == 2) ? -sy : -cp;
          rope[(size_t)m * 128 + i] = (float)cs; rope[(size_t)m * 128 + 64 + i] = (float)sn; } }
    if (!XN_LATE)
    { const float* x = (const float*)a.in[0]; const float* g = (const float*)a.in[2]; bf16* xn = (bf16*)(ws + WS_XN);
      for (int i_ = 0, m; (m = xrow(gw, NGW, F.G, i_)) >= 0; ++i_) rms_row_to_bf16<(QKVA_I8 ? 2 : (QKVA_F8 ? 1 : 0))>(x + (size_t)m * DM, g, (QKVA_I8 || QKVA_F8) ? (bf16*)((unsigned char*)xn + (size_t)m * DM) : xn + (size_t)m * DM, (float*)(ws + WS_SROW) + m, F.lane); }
#if P0_ORDER
    for (int it = gw; it < NITEMS; it += NGW) {
        int r = it + (P0_ORDER ? I_INA + I_OUTA + I_INB + I_IDX + I_OUTB + I_UP : 0); if (r >= NITEMS) r -= NITEMS;
#if QKVA_I8
        if (r < I_INA) { p0_colmax_item((const float*)a.in[6], DM, A_IN, (unsigned*)(F.ctl + CW_CMAX_INA), r, F.lane); continue; } r -= I_INA;
#elif QKVA_F8
        if (r < I_INA) { p0_transpose_item_f8((const float*)a.in[6], DM, A_IN, (unsigned char*)(ws + WS_W_INA), WINA_SCALE, scr, r, F.lane, 1); continue; } r -= I_INA;
#else
        if (r < I_INA) { p0_transpose_item((const float*)a.in[6], DM, A_IN, (bf16*)(ws + WS_W_INA), 1, scr, r, F.lane); continue; } r -= I_INA;
#endif
        if (r < I_OUTA) { if (WOUTA_I8) p0_colmax_item((const float*)a.in[7], A_OUT, DM, (unsigned*)(F.ctl + CW_CMAX_OUTA), r, F.lane);
                          else p0_transpose_item((const float*)a.in[7], A_OUT, DM, (bf16*)(ws + WS_W_OUTA), 0, scr, r, F.lane); continue; } r -= I_OUTA;
        if (r < I_INB) { const int n0 = 32 * (r % (B_IN / 32));
            if (n0 < B_QKV) { if (L1_I8) p0_colmax_item((const float*)a.in[8], DM, B_IN, (unsigned*)(F.ctl + CW_CMAX_INB), r, F.lane);
                              else p0_transpose_item_f8((const float*)a.in[8], DM, B_IN, (unsigned char*)(ws + WS_W_INB), WINB_SCALE, scr, r, F.lane, 1); }
            else if (IDXG_I8) p0_colmax_item((const float*)a.in[8], DM, B_IN, (unsigned*)(F.ctl + CW_CMAX_INB2), r, F.lane, B_QKV);
            else p0_transpose_item((const float*)a.in[8], DM, B_IN, (bf16*)(ws + WS_W_INB2), 1, scr, r, F.lane, B_QKV);
            continue; } r -= I_INB;
        if (r < I_IDX) { if (IDXG_I8) p0_colmax_item((const float*)a.in[10], IDX_RANK, 4096, (unsigned*)(F.ctl + CW_CMAX_IDX), r, F.lane);
                         else p0_transpose_item((const float*)a.in[10], IDX_RANK, 4096, (bf16*)(ws + WS_W_IDX), 1, scr, r, F.lane); continue; } r -= I_IDX;
        if (r < I_OUTB) { if (!LATE_CONV) p0_transpose_item_f8((const float*)a.in[13], 4096, DM, (unsigned char*)(ws + WS_W_OUTB), WOUTB_SCALE, scr, r, F.lane); continue; } r -= I_OUTB;
#if UP0_I8
        if (r < I_UP) { p0_colmax_item((const float*)a.in[14], DM, DFF, (unsigned*)(F.ctl + CW_CMAX_UP0), r, F.lane); continue; } r -= I_UP;
#else
        if (r < I_UP) { p0_transpose_item((const float*)a.in[14], DM, DFF, (bf16*)(ws + WS_W_UP), 0, scr, r, F.lane); continue; } r -= I_UP;
#endif
        if (r < I_UP) { if (L1_I8) p0_colmax_item((const float*)a.in[14] + (size_t)DM * DFF, DM, DFF, (unsigned*)(F.ctl + CW_CMAX_UP1), r, F.lane);
                        else if (!LATE_CONV) p0_transpose_item_f8((const float*)a.in[14] + (size_t)DM * DFF, DM, DFF, (unsigned char*)(ws + WS_W_UP1), WUP_SCALE, scr, r, F.lane); continue; } r -= I_UP;
#if DOWN0_F8
        if (r < I_DOWN) { p0_transpose_item_f8((const float*)a.in[15], DFF, DM, (unsigned char*)(ws + WS_W_DOWN), WDOWN_SCALE, scr, r, F.lane); continue; } r -= I_DOWN;
#else
        if (r < I_DOWN) { p0_transpose_item((const float*)a.in[15], DFF, DM, (bf16*)(ws + WS_W_DOWN), 0, scr, r, F.lane); continue; } r -= I_DOWN;
#endif
        if (!LATE_CONV) p0_transpose_item_f8((const float*)a.in[15] + (size_t)DM * DFF, DFF, DM, (unsigned char*)(ws + WS_W_DOWN1), WDOWN_SCALE, scr, r, F.lane);
    }
#endif
}

__device__ __forceinline__ void p0b_quantize(Frame& F, const Args& a) {
    LAS float* scr = (LAS float*)(F.lds + RING_OFF + F.wave * 16384);
    const int gw = F.vcu * NWAVES + F.wave, NGW = F.G * NWAVES;
    unsigned char* ws = F.ws;
    constexpr int I_INA = QKVA_I8 ? (DM / 64) * (A_IN / 32) : 0, I_UP = UP0_I8 ? (DM / 64) * (DFF / 32) : 0, I_INB = (L1_I8 || IDXG_I8) ? (DM / 64) * (B_IN / 32) : 0, I_UP1 = L1_I8 ? (DM / 64) * (DFF / 32) : 0,
                  I_OUTA = WOUTA_I8 ? (A_OUT / 64) * (DM / 32) : 0, I_IDX = IDXG_I8 ? (IDX_RANK / 64) * (4096 / 32) : 0;
    for (int it = gw; it < I_INA + I_UP + I_INB + I_UP1 + I_OUTA + I_IDX; it += NGW) {
        int r = it + (P0_ORDER ? I_INA : 0); if (r >= I_INA + I_UP + I_INB + I_UP1 + I_OUTA + I_IDX) r -= I_INA + I_UP + I_INB + I_UP1 + I_OUTA + I_IDX;
        if (r >= I_INA + I_UP + I_INB + I_UP1) { r -= I_INA + I_UP + I_INB + I_UP1;
            if (r < I_OUTA) p0_transpose_item_i8((const float*)a.in[7], A_OUT, DM, (unsigned char*)(ws + WS_W_OUTA), (const unsigned*)(F.ctl + CW_CMAX_OUTA), (float*)(ws + WS_SCOL_OUTA), scr, r, F.lane, 0);
            else p0_transpose_item_i8((const float*)a.in[10], IDX_RANK, 4096, (unsigned char*)(ws + WS_W_IDX), (const unsigned*)(F.ctl + CW_CMAX_IDX), (float*)(ws + WS_SCOL_IDX), scr, r - I_OUTA, F.lane, 1);
            continue; }
        if (r < I_INA) { p0_transpose_item_i8((const float*)a.in[6], DM, A_IN, (unsigned char*)(ws + WS_W_INA), (const unsigned*)(F.ctl + CW_CMAX_INA), (float*)(ws + WS_SCOL_INA), scr, r, F.lane, 1); continue; } r -= I_INA;
        if (r < I_UP) { p0_transpose_item_i8((const float*)a.in[14], DM, DFF, (unsigned char*)(ws + WS_W_UP), (const unsigned*)(F.ctl + CW_CMAX_UP0), (float*)(ws + WS_SCOL_UP0), scr, r, F.lane, 0); continue; } r -= I_UP;
        if (r < I_INB) { const bool qkv = 32 * (r % (B_IN / 32)) < B_QKV;
            if (qkv && L1_I8) p0_transpose_item_i8((const float*)a.in[8], DM, B_IN, (unsigned char*)(ws + WS_W_INB), (const unsigned*)(F.ctl + CW_CMAX_INB), (float*)(ws + WS_SCOL_INB), scr, r, F.lane, 1);
            if (!qkv && IDXG_I8) p0_transpose_item_i8((const float*)a.in[8], DM, B_IN, (unsigned char*)(ws + WS_W_INB2), (const unsigned*)(F.ctl + CW_CMAX_INB2), (float*)(ws + WS_SCOL_INB2), scr, r, F.lane, 1, B_QKV);
            continue; } r -= I_INB;
        p0_transpose_item_i8((const float*)a.in[14] + (size_t)DM * DFF, DM, DFF, (unsigned char*)(ws + WS_W_UP1), (const unsigned*)(F.ctl + CW_CMAX_UP1), (float*)(ws + WS_SCOL_UP1), scr, r, F.lane, 0);
    }
    if (XN_LATE)
    { const float* x = (const float*)a.in[0]; const float* g = (const float*)a.in[2]; bf16* xn = (bf16*)(ws + WS_XN);
      for (int i_ = 0, m; (m = xrow(gw, NGW, F.G, i_)) >= 0; ++i_) rms_row_to_bf16<(QKVA_I8 ? 2 : (QKVA_F8 ? 1 : 0))>(x + (size_t)m * DM, g, (QKVA_I8 || QKVA_F8) ? (bf16*)((unsigned char*)xn + (size_t)m * DM) : xn + (size_t)m * DM, (float*)(ws + WS_SROW) + m, F.lane); }
}
template <int XF8, bool BB, bool OB> __device__ __forceinline__ void thin_resid(Frame& F, const bf16* mix, const void* base, const float* gpost, void* out, const float* gnext, bf16* xn, unsigned char* xn8, float* srow = nullptr) {
    const int gw = F.vcu * NWAVES + F.wave, NGW = F.G * NWAVES;
    LAS unsigned* pfl = (LAS unsigned*)(F.lds + RING_OFF + F.wave * 256);
    for (int i_ = 0, m; (m = xrow(gw, NGW, F.G, i_)) >= 0; ++i_) { const int mn = xrow(gw, NGW, F.G, i_ + 1);
        resid_norm_row<XF8, BB, OB>(mix + (size_t)m * DM, (const unsigned char*)base + (size_t)m * DM * (BB ? 2 : 4), gpost, (unsigned char*)out + (size_t)m * DM * (OB ? 2 : 4), gnext,
                                    xn ? (XF8 == 5 ? (bf16*)((unsigned char*)xn + (size_t)m * DM) : xn + (size_t)m * DM) : nullptr, xn8 ? xn8 + (size_t)m * DM : nullptr, srow ? srow + m : nullptr, F.lane,
                                    mn >= 0 ? (const void*)(mix + (size_t)mn * DM) : nullptr, (const unsigned char*)base + (size_t)(mn >= 0 ? mn : m) * DM * (BB ? 2 : 4), pfl); }
    asm volatile("s_waitcnt vmcnt(0)" ::: "memory");
}

typedef short s16x4b __attribute__((ext_vector_type(4)));
typedef short v4i16b_t __attribute__((ext_vector_type(4)));
__device__ __forceinline__ s16x4b vtr16(const LAS unsigned char* p) { return __builtin_bit_cast(s16x4b, __builtin_amdgcn_ds_read_tr16_b64_v4i16((LAS v4i16b_t*)p)); }
#if DIL_PIPE
__device__ __forceinline__ void dil_attn_phase(Frame& F) {
    const bf16* QKV = (const bf16*)(F.ws + WS_QKVA); bf16* OG = (bf16*)(F.ws + WS_OG); float* LSE = (float*)(F.ws + WS_LSE);
    const int hb = F.wave >> 2, w = F.wave & 3, lane = F.lane, l31 = lane & 31, half = lane >> 5;
    LAS unsigned char* vt = F.lds + RING_OFF + hb * 65536;
#ifndef DIL_REP
#define DIL_REP 1
#endif
#define DIL_PARAMS(p_, Qp_, nblk_, g_, b_, head_, r_, c_) \
        const int idx_##Qp_ = 2 * (p_) + hb; const int blk_##Qp_ = idx_##Qp_ & 63, head_ = (idx_##Qp_ >> 6) & 15, bg_##Qp_ = idx_##Qp_ >> 10, g_ = bg_##Qp_ % 3, b_ = bg_##Qp_ / 3; \
        const int r_ = (g_ == 0) ? 1 : (g_ == 1) ? 4 : 16, nbk_##Qp_ = 64 / r_, c_ = blk_##Qp_ / nbk_##Qp_, nblk_ = blk_##Qp_ % nbk_##Qp_; \
        const bf16* Qp_ = QKV + ((size_t)(((g_ * 3 + 0) * 16 + head_) * 2 + b_) * SEQ + c_ * (SEQ / r_)) * 128
#define DIL_KLOADP(dst, Kp_, nblk_, k5_) do { const int kj_ = 32 * (w + (k5_)) + l31; int j_ = 128 * ((nblk_) - 1) + kj_; j_ = j_ < 0 ? 0 : j_; \
            const bf16* krow_ = (Kp_) + (size_t)j_ * 128 + 8 * half; \
            _Pragma("unroll") for (int ks = 0; ks < 8; ++ks) dst[ks] = *(const GAS bf16x8*)(krow_ + 16 * ks); } while (0)
#define DIL_QLOADP(Qp_, nblk_) do { const bf16* qrow_ = (Qp_) + (size_t)(128 * (nblk_) + 32 * w + l31) * 128 + 8 * half; \
            _Pragma("unroll") for (int ks = 0; ks < 8; ++ks) qf[ks] = *(const GAS bf16x8*)(qrow_ + 16 * ks); } while (0)
    for (int rep_ = 0; rep_ < DIL_REP; ++rep_) {
    bf16x8 qf[8], ka[8], kb[8], kc[8];
    if (F.vcu < 3072) { DIL_PARAMS(F.vcu, Qp0, nblk0, g0, b0, head0, r0, c0); const bf16* Kp0 = Qp0 + (size_t)16 * 2 * SEQ * 128;
        DIL_QLOADP(Qp0, nblk0); DIL_KLOADP(ka, Kp0, nblk0, 0); }
    for (int p = F.vcu; p < 3072; p += F.G) {
        DIL_PARAMS(p, Qp, nblk, g, b, head, r, c);
        const bf16* Kp = Qp + (size_t)16 * 2 * SEQ * 128; const bf16* Vp = Qp + (size_t)32 * 2 * SEQ * 128;
        const int qi = 32 * w + l31;
        f32x16 S[5];
#define DIL_QK(src, k5_) do { f32x16 acc_; _Pragma("unroll") for (int e = 0; e < 16; ++e) acc_[e] = 0.f; \
            _Pragma("unroll") for (int ks = 0; ks < 8; ++ks) acc_ = MFMA32(src[ks], qf[ks], acc_); S[k5_] = acc_; } while (0)
        DIL_KLOADP(kb, Kp, nblk, 1); DIL_KLOADP(kc, Kp, nblk, 2);
        DIL_QK(ka, 0);
        __builtin_amdgcn_sched_barrier(0);
        DIL_KLOADP(ka, Kp, nblk, 3);
        __builtin_amdgcn_sched_barrier(0);
        asm volatile("" ::: "memory");
        __builtin_amdgcn_s_barrier();
        asm volatile("" ::: "memory");
        DIL_QK(kb, 1); DIL_QK(kc, 2); DIL_QK(ka, 3); DIL_KLOADP(kb, Kp, nblk, 4); DIL_QK(kb, 4);
        __builtin_amdgcn_sched_barrier(0);
#undef DIL_QK
        { const int rl = lane >> 4, sl = lane & 15;
#pragma unroll
          for (int i = 0; i < 16; ++i) { const int kj = 64 * w + 4 * i + rl; int j = 128 * (nblk - 1) + kj; j = j < 0 ? 0 : j;
              const int ch = sl ^ (2 * (kj & 7));
              __builtin_amdgcn_global_load_lds((const unsigned*)(Vp + (size_t)j * 128 + 8 * ch), (LAS unsigned*)(vt + (64 * w + 4 * i) * 256), 16, 0, 0); } }
        __builtin_amdgcn_sched_barrier(0);
        const bool has_next = p + F.G < 3072;
        DIL_PARAMS((has_next ? p + F.G : p), Qpn, nblkn, gn, bn, headn, rn, cn); const bf16* Kpn = Qpn + (size_t)16 * 2 * SEQ * 128;
        if (has_next) { DIL_QLOADP(Qpn, nblkn); DIL_KLOADP(ka, Kpn, nblkn, 0); }
        __builtin_amdgcn_sched_barrier(0);
        float mx = -1e30f;
        {
            float fl = (float)(4 * half - l31);
            asm volatile("" : "+v"(fl));
            const float fk = (nblk == 0) ? (float)(32 * w + 4 * half - 128) : 1e9f;
#pragma unroll
            for (int k5 = 0; k5 < 5; ++k5)
#pragma unroll
                for (int e = 0; e < 16; ++e) { const float C = (float)(32 * k5 + (e & 3) + 8 * (e >> 2));
                    const float tt = fl + C; float bb = fminf(fminf(tt, 128.f - tt), fk + C); bb = fminf(bb, 0.f) * 1e30f;
                    const float x = S[k5][e] + bb; S[k5][e] = x; mx = fmaxf(mx, x); }
        }
        mx = fmaxf(mx, __shfl_xor(mx, 32));
        float sum = 0.f;
#pragma unroll
        for (int k5 = 0; k5 < 5; ++k5)
#pragma unroll
            for (int e = 0; e < 16; ++e) { const float pv = __expf(S[k5][e] - mx); S[k5][e] = pv; sum += pv; }
        sum += __shfl_xor(sum, 32);
        const float inv = 1.0f / sum, lse = mx + __logf(sum);
        v4u Pp[5][2];
#pragma unroll
        for (int k5 = 0; k5 < 5; ++k5)
#pragma unroll
            for (int s = 0; s < 2; ++s) Pp[k5][s] = (v4u){pk2(S[k5][8 * s + 0] * inv, S[k5][8 * s + 1] * inv), pk2(S[k5][8 * s + 2] * inv, S[k5][8 * s + 3] * inv),
                                                           pk2(S[k5][8 * s + 4] * inv, S[k5][8 * s + 5] * inv), pk2(S[k5][8 * s + 6] * inv, S[k5][8 * s + 7] * inv)};
        if (has_next) asm volatile("s_waitcnt vmcnt(16)" ::: "memory"); else asm volatile("s_waitcnt vmcnt(0)" ::: "memory");
        __builtin_amdgcn_s_barrier();
        asm volatile("" ::: "memory");
        const int gI = lane >> 4, q4 = (lane & 15) >> 2, p4 = lane & 3;
        const int lc = (2 * (gI & 1) + (p4 >> 1)) ^ (2 * ((4 * half + q4) & 7));
        const LAS unsigned char* vrow = vt + (32 * w + 4 * half + q4) * 256 + 8 * (p4 & 1);
        const size_t mrow = (size_t)b * SEQ + c + r * (128 * nblk + qi);
        bf16* op = OG + ((size_t)g * M + mrow) * A_OUT + head * 128;
#pragma unroll
        for (int dp = 0; dp < 2; ++dp) {
            f32x16 O[2];
#pragma unroll
            for (int dt = 0; dt < 2; ++dt)
#pragma unroll
                for (int e = 0; e < 16; ++e) O[dt][e] = 0.f;
            const LAS unsigned char* vb2[2];
#pragma unroll
            for (int dt = 0; dt < 2; ++dt) vb2[dt] = vrow + 16 * (lc ^ (4 * (2 * dp + dt)));
#pragma unroll
            for (int k5 = 0; k5 < 5; ++k5)
#pragma unroll
                for (int s = 0; s < 2; ++s) {
                    const bf16x8 pb = __builtin_bit_cast(bf16x8, Pp[k5][s]);
#pragma unroll
                    for (int dt = 0; dt < 2; ++dt) {
                        const s16x4b a0 = vtr16(vb2[dt] + (32 * k5 + 16 * s) * 256), a1 = vtr16(vb2[dt] + (32 * k5 + 16 * s + 8) * 256);
                        const bf16x8 av = {a0[0], a0[1], a0[2], a0[3], a1[0], a1[1], a1[2], a1[3]};
                        O[dt] = MFMA32(av, pb, O[dt]); }
                }
#pragma unroll
            for (int dt = 0; dt < 2; ++dt)
#pragma unroll
                for (int k = 0; k < 4; ++k) { const unsigned long long v = (unsigned long long)pk2(O[dt][4 * k], O[dt][4 * k + 1]) | ((unsigned long long)pk2(O[dt][4 * k + 2], O[dt][4 * k + 3]) << 32);
                    *(GAS unsigned long long*)(op + 32 * (2 * dp + dt) + 8 * k + 4 * half) = v; }
            __builtin_amdgcn_sched_barrier(0);
        }
        if (half == 0) LSE[((size_t)g * M + mrow) * 16 + head] = lse;
    }
    asm volatile("s_waitcnt vmcnt(0)" ::: "memory");
    __syncthreads();
    }
#undef DIL_PARAMS
#undef DIL_KLOADP
#undef DIL_QLOADP
}
#else
__device__ __forceinline__ void dil_attn_phase(Frame& F) {
    const bf16* QKV = (const bf16*)(F.ws + WS_QKVA); bf16* OG = (bf16*)(F.ws + WS_OG); float* LSE = (float*)(F.ws + WS_LSE);
    const int hb = F.wave >> 2, w = F.wave & 3, lane = F.lane, l31 = lane & 31, half = lane >> 5;
    LAS unsigned char* vt = F.lds + RING_OFF + hb * 65536;
#ifndef DIL_REP
#define DIL_REP 1
#endif
#if DIL_STAGGER
    if (hb == 1) __syncthreads();
#endif
    for (int rep_ = 0; rep_ < DIL_REP; ++rep_)
#if DIL_RUN
    for (int p = F.vcu * ((3072 + F.G - 1) / F.G), pe = (p + (3072 + F.G - 1) / F.G < 3072 ? p + (3072 + F.G - 1) / F.G : 3072); p < pe; ++p) {
#else
    for (int p = F.vcu; p < 3072; p += F.G) {
#endif
        const int idx = 2 * p + hb;
        const int blk = idx & 63, head = (idx >> 6) & 15, bg = idx >> 10, g = bg % 3, b = bg / 3;
        const int r = (g == 0) ? 1 : (g == 1) ? 4 : 16, nbk = 64 / r, c = blk / nbk, nblk = blk % nbk;
        const int nsub = SEQ / r;
        const bf16* Qp = QKV + ((size_t)(((g * 3 + 0) * 16 + head) * 2 + b) * SEQ + c * nsub) * 128;
        const bf16* Kp = Qp + (size_t)16 * 2 * SEQ * 128; const bf16* Vp = Qp + (size_t)32 * 2 * SEQ * 128;
        __syncthreads();
        { const int rl = lane >> 4, sl = lane & 15;
#pragma unroll
          for (int i = 0; i < 16; ++i) { const int kj = 64 * w + 4 * i + rl; int j = 128 * (nblk - 1) + kj; j = j < 0 ? 0 : j;
              const int ch = sl ^ (2 * (kj & 7));
              __builtin_amdgcn_global_load_lds((const unsigned*)(Vp + (size_t)j * 128 + 8 * ch), (LAS unsigned*)(vt + (64 * w + 4 * i) * 256), 16, 0, 0); } }
        const int qi = 32 * w + l31;
        bf16x8 qf[8];
        { const bf16* qrow = Qp + (size_t)(128 * nblk + qi) * 128 + 8 * half;
#pragma unroll
          for (int ks = 0; ks < 8; ++ks) qf[ks] = *(const GAS bf16x8*)(qrow + 16 * ks); }
        f32x16 S[5];
#define DIL_KLOAD(dst, k5_) do { const int kj_ = 32 * (w + (k5_)) + l31; int j_ = 128 * (nblk - 1) + kj_; j_ = j_ < 0 ? 0 : j_; \
            const bf16* krow_ = Kp + (size_t)j_ * 128 + 8 * half; \
            _Pragma("unroll") for (int ks = 0; ks < 8; ++ks) dst[ks] = *(const GAS bf16x8*)(krow_ + 16 * ks); } while (0)
#define DIL_QK(src, k5_) do { f32x16 acc_; _Pragma("unroll") for (int e = 0; e < 16; ++e) acc_[e] = 0.f; \
            _Pragma("unroll") for (int ks = 0; ks < 8; ++ks) acc_ = MFMA32(src[ks], qf[ks], acc_); S[k5_] = acc_; } while (0)
        {
            bf16x8 ka[8], kb[8], kc[8];
            DIL_KLOAD(ka, 0); DIL_KLOAD(kb, 1); DIL_KLOAD(kc, 2);
            __builtin_amdgcn_sched_barrier(0);
            DIL_QK(ka, 0); DIL_QK(kb, 1); DIL_QK(kc, 2);
            __builtin_amdgcn_sched_barrier(0);
            DIL_KLOAD(ka, 3); DIL_KLOAD(kb, 4);
            __builtin_amdgcn_sched_barrier(0);
            DIL_QK(ka, 3); DIL_QK(kb, 4);
        }
#undef DIL_KLOAD
#undef DIL_QK
#if DIL_STAGGER
        asm volatile("s_waitcnt vmcnt(0)" ::: "memory");
        __syncthreads();
#endif
        float mx = -1e30f;
        {
            float fl = (float)(4 * half - l31);
            asm volatile("" : "+v"(fl));
            const float fk = (nblk == 0) ? (float)(32 * w + 4 * half - 128) : 1e9f;
#pragma unroll
            for (int k5 = 0; k5 < 5; ++k5)
#pragma unroll
                for (int e = 0; e < 16; ++e) { const float C = (float)(32 * k5 + (e & 3) + 8 * (e >> 2));
                    const float tt = fl + C; float bb = fminf(fminf(tt, 128.f - tt), fk + C); bb = fminf(bb, 0.f) * 1e30f;
                    const float x = S[k5][e] + bb; S[k5][e] = x; mx = fmaxf(mx, x); }
        }
        mx = fmaxf(mx, __shfl_xor(mx, 32));
        float sum = 0.f;
#pragma unroll
        for (int k5 = 0; k5 < 5; ++k5)
#pragma unroll
            for (int e = 0; e < 16; ++e) { const float pv = __expf(S[k5][e] - mx); S[k5][e] = pv; sum += pv; }
        sum += __shfl_xor(sum, 32);
        const float inv = 1.0f / sum, lse = mx + __logf(sum);
#if !DIL_STAGGER
        asm volatile("s_waitcnt vmcnt(0)" ::: "memory");
        __syncthreads();
#endif
        f32x16 O[4];
#pragma unroll
        for (int dt = 0; dt < 4; ++dt)
#pragma unroll
            for (int e = 0; e < 16; ++e) O[dt][e] = 0.f;
        const int gI = lane >> 4, q4 = (lane & 15) >> 2, p4 = lane & 3;
        const int lc = (2 * (gI & 1) + (p4 >> 1)) ^ (2 * ((4 * half + q4) & 7));
        const LAS unsigned char* vrow = vt + (32 * w + 4 * half + q4) * 256 + 8 * (p4 & 1);
        const LAS unsigned char* vb4[4];
#pragma unroll
        for (int dt = 0; dt < 4; ++dt) vb4[dt] = vrow + 16 * (lc ^ (4 * dt));
#pragma unroll
        for (int k5 = 0; k5 < 5; ++k5)
#pragma unroll
            for (int s = 0; s < 2; ++s) {
                bf16x8 pb;
                { const unsigned u0 = pk2(S[k5][8 * s + 0] * inv, S[k5][8 * s + 1] * inv), u1 = pk2(S[k5][8 * s + 2] * inv, S[k5][8 * s + 3] * inv),
                                 u2 = pk2(S[k5][8 * s + 4] * inv, S[k5][8 * s + 5] * inv), u3 = pk2(S[k5][8 * s + 6] * inv, S[k5][8 * s + 7] * inv);
                  const v4u uu = (v4u){u0, u1, u2, u3}; pb = __builtin_bit_cast(bf16x8, uu); }
#pragma unroll
                for (int dt = 0; dt < 4; ++dt) {
                    const s16x4b a0 = vtr16(vb4[dt] + (32 * k5 + 16 * s) * 256), a1 = vtr16(vb4[dt] + (32 * k5 + 16 * s + 8) * 256);
                    const bf16x8 av = {a0[0], a0[1], a0[2], a0[3], a1[0], a1[1], a1[2], a1[3]};
                    O[dt] = MFMA32(av, pb, O[dt]); }
            }
        const size_t mrow = (size_t)b * SEQ + c + r * (128 * nblk + qi);
        bf16* op = OG + ((size_t)g * M + mrow) * A_OUT + head * 128;
#pragma unroll
        for (int dt = 0; dt < 4; ++dt)
#pragma unroll
            for (int k = 0; k < 4; ++k) { const unsigned long long v = (unsigned long long)pk2(O[dt][4 * k], O[dt][4 * k + 1]) | ((unsigned long long)pk2(O[dt][4 * k + 2], O[dt][4 * k + 3]) << 32);
                *(GAS unsigned long long*)(op + 32 * dt + 8 * k + 4 * half) = v; }
        if (half == 0) LSE[((size_t)g * M + mrow) * 16 + head] = lse;
    }
#if DIL_STAGGER
    if (hb == 0) __syncthreads();
#endif
    __syncthreads();
}
#endif
#if MERGE2
__device__ __forceinline__ void merge_phase(Frame& F) {
    const bf16* OG = (const bf16*)(F.ws + WS_OG); const float* LSE = (const float*)(F.ws + WS_LSE); bf16* OM = (bf16*)(F.ws + WS_OMERGE);
    const int gw = F.vcu * NWAVES + F.wave, NGW = F.G * NWAVES, lane = F.lane, h16 = lane & 15;
    static_assert(WOUTA_I8, "MERGE2 writes the int8 row");
    for (int i_ = 0, m; (m = xrow(gw, NGW, F.G, i_)) >= 0; ++i_) {
        const float l0 = LSE[((size_t)0 * M + m) * 16 + h16], l1 = LSE[((size_t)1 * M + m) * 16 + h16], l2 = LSE[((size_t)2 * M + m) * 16 + h16];
        const size_t off = (size_t)m * A_OUT + 8 * lane;
        v4u va[4], vb[4], vc[4];
#pragma unroll
        for (int c4 = 0; c4 < 4; ++c4) { va[c4] = *(const GAS v4u*)(OG + off + 512 * c4); vb[c4] = *(const GAS v4u*)(OG + (size_t)M * A_OUT + off + 512 * c4); vc[c4] = *(const GAS v4u*)(OG + (size_t)2 * M * A_OUT + off + 512 * c4); }
        __builtin_amdgcn_sched_barrier(0);
        const float mx = fmaxf(l0, fmaxf(l1, l2)); float e0 = __expf(l0 - mx), e1 = __expf(l1 - mx), e2 = __expf(l2 - mx); const float inv0 = 1.0f / (e0 + e1 + e2); e0 *= inv0; e1 *= inv0; e2 *= inv0;
        float ov[32]; float am = 0.f;
#pragma unroll
        for (int c4 = 0; c4 < 4; ++c4) { const int hd = 4 * c4 + (lane >> 4);
            const float f0 = __shfl(e0, hd), f1 = __shfl(e1, hd), f2 = __shfl(e2, hd);
#pragma unroll
            for (int k = 0; k < 4; ++k) { const float lo = f0 * bf_lo(va[c4][k]) + f1 * bf_lo(vb[c4][k]) + f2 * bf_lo(vc[c4][k]), hi = f0 * bf_hi(va[c4][k]) + f1 * bf_hi(vb[c4][k]) + f2 * bf_hi(vc[c4][k]);
                ov[8 * c4 + 2 * k] = lo; ov[8 * c4 + 2 * k + 1] = hi; am = fmaxf(am, fmaxf(__builtin_fabsf(lo), __builtin_fabsf(hi))); } }
        am = wave_max(am); const float inv = am > 0.f ? 127.0f / am : 0.f;
        unsigned char* o8 = (unsigned char*)OM + (size_t)m * A_OUT + 8 * lane;
#pragma unroll
        for (int c4 = 0; c4 < 4; ++c4) { const unsigned long long o = (unsigned long long)pk_i8x4(ov[8 * c4] * inv, ov[8 * c4 + 1] * inv, ov[8 * c4 + 2] * inv, ov[8 * c4 + 3] * inv)
                | ((unsigned long long)pk_i8x4(ov[8 * c4 + 4] * inv, ov[8 * c4 + 5] * inv, ov[8 * c4 + 6] * inv, ov[8 * c4 + 7] * inv) << 32);
            *(GAS unsigned long long*)(o8 + 512 * c4) = o; }
        if (lane == 0) ((float*)(F.ws + WS_SROW_OM))[m] = am * (1.0f / 127.0f);
    }
}
#else
__device__ __forceinline__ void merge_phase(Frame& F) {
    const bf16* OG = (const bf16*)(F.ws + WS_OG); const float* LSE = (const float*)(F.ws + WS_LSE); bf16* OM = (bf16*)(F.ws + WS_OMERGE);
    const int gw = F.vcu * NWAVES + F.wave, NGW = F.G * NWAVES, lane = F.lane, head = lane >> 2, d0 = (lane & 3) * 32;
    for (int i_ = 0, m; (m = xrow(gw, NGW, F.G, i_)) >= 0; ++i_) {
        const float l0 = LSE[((size_t)0 * M + m) * 16 + head], l1 = LSE[((size_t)1 * M + m) * 16 + head], l2 = LSE[((size_t)2 * M + m) * 16 + head];
        const float mx = fmaxf(l0, fmaxf(l1, l2)); float e0 = __expf(l0 - mx), e1 = __expf(l1 - mx), e2 = __expf(l2 - mx); const float inv = 1.0f / (e0 + e1 + e2); e0 *= inv; e1 *= inv; e2 *= inv;
        const size_t off = (size_t)m * A_OUT + head * 128 + d0;
        v4u va[4], vb[4], vc[4];
#pragma unroll
        for (int c4 = 0; c4 < 4; ++c4) { va[c4] = *(const GAS v4u*)(OG + off + 8 * c4); vb[c4] = *(const GAS v4u*)(OG + (size_t)M * A_OUT + off + 8 * c4); vc[c4] = *(const GAS v4u*)(OG + (size_t)2 * M * A_OUT + off + 8 * c4); }
        if (WOUTA_I8) {
            float ov[32]; float am = 0.f;
#pragma unroll
            for (int c4 = 0; c4 < 4; ++c4)
#pragma unroll
                for (int k = 0; k < 4; ++k) { const float lo = e0 * bf_lo(va[c4][k]) + e1 * bf_lo(vb[c4][k]) + e2 * bf_lo(vc[c4][k]), hi = e0 * bf_hi(va[c4][k]) + e1 * bf_hi(vb[c4][k]) + e2 * bf_hi(vc[c4][k]);
                    ov[8 * c4 + 2 * k] = lo; ov[8 * c4 + 2 * k + 1] = hi; am = fmaxf(am, fmaxf(__builtin_fabsf(lo), __builtin_fabsf(hi))); }
            am = wave_max(am); const float inv = am > 0.f ? 127.0f / am : 0.f;
            unsigned char* o8 = (unsigned char*)OM + (size_t)m * A_OUT + head * 128 + d0;
#pragma unroll
            for (int h2 = 0; h2 < 2; ++h2) { v4u o;
#pragma unroll
                for (int k = 0; k < 4; ++k) o[k] = pk_i8x4(ov[16 * h2 + 4 * k] * inv, ov[16 * h2 + 4 * k + 1] * inv, ov[16 * h2 + 4 * k + 2] * inv, ov[16 * h2 + 4 * k + 3] * inv);
                *(GAS v4u*)(o8 + 16 * h2) = o; }
            if (lane == 0) ((float*)(F.ws + WS_SROW_OM))[m] = am * (1.0f / 127.0f);
        } else {
#pragma unroll
        for (int c4 = 0; c4 < 4; ++c4) {
            const v4u a = va[c4], bq = vb[c4], cq = vc[c4];
            v4u o;
#pragma unroll
            for (int k = 0; k < 4; ++k) { const float lo = e0 * bf_lo(a[k]) + e1 * bf_lo(bq[k]) + e2 * bf_lo(cq[k]), hi = e0 * bf_hi(a[k]) + e1 * bf_hi(bq[k]) + e2 * bf_hi(cq[k]); o[k] = pk2(lo, hi); }
            *(GAS v4u*)(OM + off + 8 * c4) = o; } }
    }
}
#endif
__device__ __forceinline__ void idx_prep_phase(Frame& F, const Args& a) {
    const bf16* IQL = (const bf16*)(F.ws + WS_IQL); const float* IKW = (const float*)(F.ws + WS_IKW); bf16* IQLN = (bf16*)(F.ws + WS_IQLN); bf16* IKB = (bf16*)(F.ws + WS_IKB); float* IWS = (float*)(F.ws + WS_IWS);
    const float* rope = (const float*)(F.ws + WS_ROPE); const float* gq = (const float*)a.in[9]; const float* kw = (const float*)a.in[11]; const float* kb = (const float*)a.in[12];
    const int gw = F.vcu * NWAVES + F.wave, NGW = F.G * NWAVES, lane = F.lane;
    for (int i_ = 0, m; (m = xrow(gw, NGW, F.G, i_)) >= 0; ++i_) {
        const v4u x0 = *(const GAS v4u*)(IQL + (size_t)m * 1024 + 8 * lane), x1 = *(const GAS v4u*)(IQL + (size_t)m * 1024 + 512 + 8 * lane);
        float xv[16];
#pragma unroll
        for (int k = 0; k < 4; ++k) { xv[2 * k] = bf_lo(x0[k]); xv[2 * k + 1] = bf_hi(x0[k]); xv[8 + 2 * k] = bf_lo(x1[k]); xv[8 + 2 * k + 1] = bf_hi(x1[k]); }
        float ss = 0.f;
#pragma unroll
        for (int k = 0; k < 16; ++k) ss += xv[k] * xv[k];
        const float rs = 1.0f / sqrtf(wave_sum(ss) * (1.f / 1024.f) + NORM_EPS);
        v4u o0, o1;
#pragma unroll
        for (int k = 0; k < 4; ++k) { o0[k] = pk2(xv[2 * k] * rs * gq[8 * lane + 2 * k], xv[2 * k + 1] * rs * gq[8 * lane + 2 * k + 1]);
                                      o1[k] = pk2(xv[8 + 2 * k] * rs * gq[512 + 8 * lane + 2 * k], xv[8 + 2 * k + 1] * rs * gq[512 + 8 * lane + 2 * k + 1]); }
        if (IDXG_I8) {
            float nv[16]; float am = 0.f;
#pragma unroll
            for (int k = 0; k < 8; ++k) { nv[k] = xv[k] * rs * gq[8 * lane + k]; nv[8 + k] = xv[8 + k] * rs * gq[512 + 8 * lane + k]; am = fmaxf(am, fmaxf(__builtin_fabsf(nv[k]), __builtin_fabsf(nv[8 + k]))); }
            am = wave_max(am); const float inv = am > 0.f ? 127.0f / am : 0.f;
            unsigned char* q8 = (unsigned char*)IQLN + (size_t)m * 1024;
            *(GAS unsigned long long*)(q8 + 8 * lane) = (unsigned long long)pk_i8x4(nv[0] * inv, nv[1] * inv, nv[2] * inv, nv[3] * inv) | ((unsigned long long)pk_i8x4(nv[4] * inv, nv[5] * inv, nv[6] * inv, nv[7] * inv) << 32);
            *(GAS unsigned long long*)(q8 + 512 + 8 * lane) = (unsigned long long)pk_i8x4(nv[8] * inv, nv[9] * inv, nv[10] * inv, nv[11] * inv) | ((unsigned long long)pk_i8x4(nv[12] * inv, nv[13] * inv, nv[14] * inv, nv[15] * inv) << 32);
            if (lane == 0) ((float*)(F.ws + WS_SROW_IQ))[m] = am * (1.0f / 127.0f);
        } else { *(GAS v4u*)(IQLN + (size_t)m * 1024 + 8 * lane) = o0; *(GAS v4u*)(IQLN + (size_t)m * 1024 + 512 + 8 * lane) = o1; }
        const float k1 = IKW[(size_t)m * 256 + lane], k2 = IKW[(size_t)m * 256 + 64 + lane];
        const float mu = wave_sum(k1 + k2) * (1.f / 128.f); const float c1 = k1 - mu, c2 = k2 - mu;
        const float rv = 1.0f / sqrtf(wave_sum(c1 * c1 + c2 * c2) * (1.f / 128.f) + NORM_EPS);
        const float y1 = c1 * rv * kw[lane] + kb[lane], y2 = c2 * rv * kw[64 + lane] + kb[64 + lane];
        const float cs = rope[(size_t)m * 128 + lane], sn = rope[(size_t)m * 128 + 64 + lane];
        if (IDX_I8) { const float o1 = y1 * cs - y2 * sn, o2 = y2 * cs + y1 * sn; const float am = wave_max(fmaxf(__builtin_fabsf(o1), __builtin_fabsf(o2))); const float inv = am > 0.f ? 127.0f / am : 0.f;
            unsigned char* k8 = (unsigned char*)IKB + (size_t)m * 128;
            k8[lane] = (unsigned char)((int)__builtin_rintf(o1 * inv) & 255); k8[64 + lane] = (unsigned char)((int)__builtin_rintf(o2 * inv) & 255);
            if (lane == 0) ((float*)(F.ws + WS_SK))[m] = am * (1.0f / 127.0f); }
        else if (IDX_F8) { unsigned char* k8 = (unsigned char*)IKB + (size_t)m * 128;
            k8[lane] = (unsigned char)__builtin_amdgcn_cvt_pk_fp8_f32(y1 * cs - y2 * sn, 0.f, 0, false); k8[64 + lane] = (unsigned char)__builtin_amdgcn_cvt_pk_fp8_f32(y2 * cs + y1 * sn, 0.f, 0, false); }
        else { IKB[(size_t)m * 128 + lane] = (bf16)f2bf(y1 * cs - y2 * sn); IKB[(size_t)m * 128 + 64 + lane] = (bf16)f2bf(y2 * cs + y1 * sn); }
        if (lane < 32) IWS[(size_t)m * 32 + lane] = IKW[(size_t)m * 256 + 128 + lane] * IWSCALE;
    }
}
typedef short s16x2_t __attribute__((ext_vector_type(2)));
__device__ __forceinline__ unsigned pkmax0(unsigned x) { const s16x2_t z = {0, 0}; return __builtin_bit_cast(unsigned, __builtin_elementwise_max(__builtin_bit_cast(s16x2_t, x), z)); }
typedef int v8i_idx __attribute__((ext_vector_type(8)));
__device__ __forceinline__ void idx_score_phase_f8(Frame& F) {
    const unsigned char* IQ8 = (const unsigned char*)(F.ws + WS_IQ); const unsigned char* IK8 = (const unsigned char*)(F.ws + WS_IKB); const float* IWS = (const float*)(F.ws + WS_IWS); float* SC = (float*)(F.ws + WS_SCORE);
    const int w = F.wave, lane = F.lane, l31 = lane & 31, half = lane >> 5;
    constexpr int NB = 4, NQ = 4;
    LAS unsigned char* ring = F.lds + RING_OFF;
    const int dmaR = 8 * w + (lane >> 3), dmaCh = (lane & 7) ^ ((dmaR >> 1) & 7);
    const int fsw = (l31 >> 1) & 7;
    for (int i = blockIdx.x; i < 512; i += F.G) {
        const int b = i >> 8, jj = i & 255, qb = (b == 0) ? jj : 255 - jj;
        const int t0 = 32 * qb + NQ * w;
        v8i_idx af[NQ][2]; bf16x8 wf[NQ][2];
#pragma unroll
        for (int q = 0; q < NQ; ++q) { const size_t m = (size_t)b * SEQ + t0 + q; const unsigned char* arow = IQ8 + m * 4096 + l31 * 128 + 32 * half;
#pragma unroll
            for (int ks = 0; ks < 2; ++ks) { const v4u a0 = *(const GAS v4u*)(arow + 64 * ks), a1 = *(const GAS v4u*)(arow + 64 * ks + 16);
                af[q][ks] = (v8i_idx){(int)a0.x, (int)a0.y, (int)a0.z, (int)a0.w, (int)a1.x, (int)a1.y, (int)a1.z, (int)a1.w}; }
#pragma unroll
            for (int s2 = 0; s2 < 2; ++s2) { const f32x4 w0 = *(const GAS f32x4*)(IWS + m * 32 + 16 * s2 + 4 * half), w1 = *(const GAS f32x4*)(IWS + m * 32 + 16 * s2 + 8 + 4 * half);
                const v4u uu = (v4u){pk2(w0.x, w0.y), pk2(w0.z, w0.w), pk2(w1.x, w1.y), pk2(w1.z, w1.w)}; wf[q][s2] = __builtin_bit_cast(bf16x8, uu); } }
        const int ntrip = (qb >> 1) + 1;
        const unsigned char* ksrc = IK8 + ((size_t)b * SEQ + dmaR) * 128 + 16 * dmaCh;
        float* scb = SC + ((size_t)b * SEQ + t0) * 8192 + l31;
#define IDX_DMA(dt_) do { const int dtc_ = (dt_) < 127 ? (dt_) : 127; \
            __builtin_amdgcn_global_load_lds((const unsigned*)(ksrc + (size_t)(64 * dtc_) * 128), (LAS unsigned*)(ring + ((dt_) & (NB - 1)) * 8192 + w * 1024), 16, 0, 0); } while (0)
        __syncthreads();
#pragma unroll
        for (int j = 0; j < NB - 1; ++j) IDX_DMA(j);
        for (int t = 0; t < ntrip; ++t) {
            if (t >= 3) asm volatile("s_waitcnt vmcnt(26)" ::: "memory");
            else if (t == 0) asm volatile("s_waitcnt vmcnt(2)" ::: "memory"); else if (t == 1) asm volatile("s_waitcnt vmcnt(10)" ::: "memory"); else asm volatile("s_waitcnt vmcnt(18)" ::: "memory");
            __builtin_amdgcn_s_barrier();
            asm volatile("" ::: "memory");
            IDX_DMA(t + NB - 1);
#pragma unroll
            for (int tt = 0; tt < 2; ++tt) {
                const LAS unsigned char* rb = ring + (t & (NB - 1)) * 8192 + (32 * tt + l31) * 128;
                v8i_idx bfr[2];
#pragma unroll
                for (int ks = 0; ks < 2; ++ks) { const v4u b0 = *(const LAS v4u*)(rb + 16 * ((4 * ks + 2 * half) ^ fsw)), b1 = *(const LAS v4u*)(rb + 16 * ((4 * ks + 2 * half + 1) ^ fsw));
                    bfr[ks] = (v8i_idx){(int)b0.x, (int)b0.y, (int)b0.z, (int)b0.w, (int)b1.x, (int)b1.y, (int)b1.z, (int)b1.w}; }
#pragma unroll
                for (int q = 0; q < NQ; ++q) { f32x16 acc;
#pragma unroll
                    for (int e = 0; e < 16; ++e) acc[e] = 0.f;
                    acc = __builtin_amdgcn_mfma_scale_f32_32x32x64_f8f6f4(af[q][0], bfr[0], acc, 0, 0, 0, 0, 0, 0);
                    acc = __builtin_amdgcn_mfma_scale_f32_32x32x64_f8f6f4(af[q][1], bfr[1], acc, 0, 0, 0, 0, 0, 0);
                    const v4u x0 = (v4u){pkmax0(pg8::cvt_pk_bf16(acc[0], acc[1])), pkmax0(pg8::cvt_pk_bf16(acc[2], acc[3])), pkmax0(pg8::cvt_pk_bf16(acc[4], acc[5])), pkmax0(pg8::cvt_pk_bf16(acc[6], acc[7]))};
                    const v4u x1 = (v4u){pkmax0(pg8::cvt_pk_bf16(acc[8], acc[9])), pkmax0(pg8::cvt_pk_bf16(acc[10], acc[11])), pkmax0(pg8::cvt_pk_bf16(acc[12], acc[13])), pkmax0(pg8::cvt_pk_bf16(acc[14], acc[15]))};
                    f32x16 y;
#pragma unroll
                    for (int e = 0; e < 16; ++e) y[e] = 0.f;
                    y = MFMA32(wf[q][0], __builtin_bit_cast(bf16x8, x0), y); y = MFMA32(wf[q][1], __builtin_bit_cast(bf16x8, x1), y);
                    scb[(size_t)q * 8192 + 64 * t + 32 * tt] = y[0]; }
            }
        }
        asm volatile("s_waitcnt vmcnt(0)" ::: "memory");
#undef IDX_DMA
    }
}
typedef int i32x16_t __attribute__((ext_vector_type(16)));
__device__ __forceinline__ void idx_score_phase_i8(Frame& F) {
    const unsigned char* IQ8 = (const unsigned char*)(F.ws + WS_IQ); const unsigned char* IK8 = (const unsigned char*)(F.ws + WS_IKB); const float* IWS = (const float*)(F.ws + WS_IWS); float* SC = (float*)(F.ws + WS_SCORE);
    const int w = F.wave, lane = F.lane, l31 = lane & 31, half = lane >> 5;
    constexpr int NB = 4, NQ = 4;
    LAS unsigned char* ring = F.lds + RING_OFF;
    const int dmaR = 8 * w + (lane >> 3), dmaCh = (lane & 7) ^ ((dmaR >> 1) & 7);
    const int fsw = (l31 >> 1) & 7;
    for (int i = blockIdx.x; i < 512; i += F.G) {
        const int b = i >> 8, jj = i & 255, qb = (b == 0) ? jj : 255 - jj;
        const int t0 = 32 * qb + NQ * w;
        pg8::v4i_t af[NQ][4]; bf16x8 wf[NQ][2];
#pragma unroll
        for (int q = 0; q < NQ; ++q) { const size_t m = (size_t)b * SEQ + t0 + q; const bf16* arow = (const bf16*)IQ8 + m * 4096 + l31 * 128 + 16 * half;
            v4u raw[4][2]; float am = 0.f;
#pragma unroll
            for (int ks = 0; ks < 4; ++ks) { raw[ks][0] = *(const GAS v4u*)(arow + 32 * ks); raw[ks][1] = *(const GAS v4u*)(arow + 32 * ks + 8);
#pragma unroll
                for (int e = 0; e < 2; ++e)
#pragma unroll
                    for (int c = 0; c < 4; ++c) am = fmaxf(am, fmaxf(__builtin_fabsf(bf_lo(raw[ks][e][c])), __builtin_fabsf(bf_hi(raw[ks][e][c])))); }
            am = fmaxf(am, __shfl_xor(am, 32));
            const float inv = am > 0.f ? 127.0f / am : 0.f, aq = am * (1.0f / 127.0f);
#pragma unroll
            for (int ks = 0; ks < 4; ++ks) { pg8::v4i_t o;
#pragma unroll
                for (int e = 0; e < 2; ++e) { o[2 * e] = (int)pk_i8x4(bf_lo(raw[ks][e][0]) * inv, bf_hi(raw[ks][e][0]) * inv, bf_lo(raw[ks][e][1]) * inv, bf_hi(raw[ks][e][1]) * inv);
                                              o[2 * e + 1] = (int)pk_i8x4(bf_lo(raw[ks][e][2]) * inv, bf_hi(raw[ks][e][2]) * inv, bf_lo(raw[ks][e][3]) * inv, bf_hi(raw[ks][e][3]) * inv); }
                af[q][ks] = o; }
#pragma unroll
            for (int s2 = 0; s2 < 2; ++s2) { float wq[8];
#pragma unroll
                for (int j = 0; j < 8; ++j) { const int hd = 16 * s2 + 8 * (j >> 2) + 4 * half + (j & 3); wq[j] = IWS[m * 32 + hd] * __shfl(aq, hd); }
                const v4u uu = (v4u){pk2(wq[0], wq[1]), pk2(wq[2], wq[3]), pk2(wq[4], wq[5]), pk2(wq[6], wq[7])}; wf[q][s2] = __builtin_bit_cast(bf16x8, uu); } }
        const int ntrip = (qb >> 1) + 1;
        const unsigned char* ksrc = IK8 + ((size_t)b * SEQ + dmaR) * 128 + 16 * dmaCh;
        float* scb = SC + ((size_t)b * SEQ + t0) * 8192 + l31;
        const float* SKp = (const float*)(F.ws + WS_SK) + (size_t)b * SEQ;
#define IDX_DMA(dt_) do { const int dtc_ = (dt_) < 127 ? (dt_) : 127; \
            __builtin_amdgcn_global_load_lds((const unsigned*)(ksrc + (size_t)(64 * dtc_) * 128), (LAS unsigned*)(ring + ((dt_) & (NB - 1)) * 8192 + w * 1024), 16, 0, 0); } while (0)
#if IDX_PIPE
        LAS unsigned char* sclw = ring + NB * 8192 + w * (NB * 256);
#define IDX_SDMA(dt_) do { const int dtc_ = (dt_) < 127 ? (dt_) : 127; \
            __builtin_amdgcn_global_load_lds((const unsigned*)(SKp + 64 * dtc_ + lane), (LAS unsigned*)(sclw + ((dt_) & (NB - 1)) * 256), 4, 0, 0); } while (0)
        __syncthreads();
#pragma unroll
        for (int j = 0; j < NB - 1; ++j) { IDX_DMA(j); IDX_SDMA(j); }
        for (int t = 0; t < ntrip; ++t) {
            if (t >= 3) asm volatile("s_waitcnt vmcnt(28)" ::: "memory");
            else if (t == 0) asm volatile("s_waitcnt vmcnt(4)" ::: "memory"); else if (t == 1) asm volatile("s_waitcnt vmcnt(12)" ::: "memory"); else asm volatile("s_waitcnt vmcnt(20)" ::: "memory");
            __builtin_amdgcn_s_barrier();
            asm volatile("" ::: "memory");
            IDX_DMA(t + NB - 1); IDX_SDMA(t + NB - 1);
            __builtin_amdgcn_sched_barrier(0);
            pg8::v4i_t bfr[2][4]; float skv[2];
#pragma unroll
            for (int tt = 0; tt < 2; ++tt) { const LAS unsigned char* rb = ring + (t & (NB - 1)) * 8192 + (32 * tt + l31) * 128;
#pragma unroll
                for (int ks = 0; ks < 4; ++ks) bfr[tt][ks] = *(const LAS pg8::v4i_t*)(rb + 16 * ((2 * ks + half) ^ fsw));
                skv[tt] = *(const LAS float*)(sclw + (t & (NB - 1)) * 256 + (32 * tt + l31) * 4); }
            i32x16_t accn;
#pragma unroll
            for (int e = 0; e < 16; ++e) accn[e] = 0;
#pragma unroll
            for (int ks = 0; ks < 4; ++ks) accn = __builtin_amdgcn_mfma_i32_32x32x32_i8(af[0][ks], bfr[0][ks], accn, 0, 0, 0);
            __builtin_amdgcn_sched_barrier(0);
            unsigned xo[8] = {0u, 0u, 0u, 0u, 0u, 0u, 0u, 0u};
#define IDX_CP(j_) xn[j_] = pkmax0(pg8::cvt_pk_bf16((float)acci[2 * (j_)], (float)acci[2 * (j_) + 1]))
#define IDX_FENCE __builtin_amdgcn_sched_barrier(0)
            float yk = 0.f;
#pragma unroll
            for (int it = 0; it < 10; ++it) {
                const i32x16_t acci = accn; f32x16 y; unsigned xn[8];
                const int qp = (it - 1) & 3, qs = (it - 2) & 3, ts = (it - 2) >> 2, q1 = (it + 1) & 3, t1 = (it + 1) >> 2;
                if (it < 7) {
#pragma unroll
                    for (int e = 0; e < 16; ++e) accn[e] = 0;
                    accn = __builtin_amdgcn_mfma_i32_32x32x32_i8(af[q1][0], bfr[t1][0], accn, 0, 0, 0); }
                if (it < 8) { IDX_CP(0); IDX_CP(1); } IDX_FENCE;
                if (it < 7) accn = __builtin_amdgcn_mfma_i32_32x32x32_i8(af[q1][1], bfr[t1][1], accn, 0, 0, 0);
                if (it < 8) { IDX_CP(2); IDX_CP(3); } IDX_FENCE;
                if (it < 7) accn = __builtin_amdgcn_mfma_i32_32x32x32_i8(af[q1][2], bfr[t1][2], accn, 0, 0, 0);
                if (it < 8) { IDX_CP(4); }
                if (it >= 2) scb[(size_t)qs * 8192 + 64 * t + 32 * ts] = yk * skv[ts];
                IDX_FENCE;
                if (it < 7) accn = __builtin_amdgcn_mfma_i32_32x32x32_i8(af[q1][3], bfr[t1][3], accn, 0, 0, 0);
                if (it < 8) { IDX_CP(5); } IDX_FENCE;
                if (it >= 1 && it < 9) {
#pragma unroll
                    for (int e = 0; e < 16; ++e) y[e] = 0.f;
                    y = MFMA32(wf[qp][0], __builtin_bit_cast(bf16x8, ((v4u){xo[0], xo[1], xo[2], xo[3]})), y); }
                if (it < 8) { IDX_CP(6); IDX_CP(7); } IDX_FENCE;
                if (it >= 1 && it < 9) { y = MFMA32(wf[qp][1], __builtin_bit_cast(bf16x8, ((v4u){xo[4], xo[5], xo[6], xo[7]})), y); yk = y[0]; }
                IDX_FENCE;
                if (it < 8) {
#pragma unroll
                    for (int j = 0; j < 8; ++j) xo[j] = xn[j]; }
            }
#undef IDX_CP
#undef IDX_FENCE
            __builtin_amdgcn_sched_barrier(0);
        }
#undef IDX_SDMA
#else
        __syncthreads();
#pragma unroll
        for (int j = 0; j < NB - 1; ++j) IDX_DMA(j);
        for (int t = 0; t < ntrip; ++t) {
            if (t >= 3) asm volatile("s_waitcnt vmcnt(32)" ::: "memory");
            else if (t == 0) asm volatile("s_waitcnt vmcnt(2)" ::: "memory"); else if (t == 1) asm volatile("s_waitcnt vmcnt(12)" ::: "memory"); else asm volatile("s_waitcnt vmcnt(22)" ::: "memory");
            __builtin_amdgcn_s_barrier();
            asm volatile("" ::: "memory");
            IDX_DMA(t + NB - 1);
            float skv[2];
#pragma unroll
            for (int tt = 0; tt < 2; ++tt) { const int kidx = 64 * t + 32 * tt + l31; skv[tt] = SKp[kidx < SEQ ? kidx : SEQ - 1]; }
            asm volatile("" ::: "memory");
#pragma unroll
            for (int tt = 0; tt < 2; ++tt) {
                const LAS unsigned char* rb = ring + (t & (NB - 1)) * 8192 + (32 * tt + l31) * 128;
                pg8::v4i_t bfr[4];
#pragma unroll
                for (int ks = 0; ks < 4; ++ks) bfr[ks] = *(const LAS pg8::v4i_t*)(rb + 16 * ((2 * ks + half) ^ fsw));
#pragma unroll
                for (int q = 0; q < NQ; ++q) { i32x16_t acci;
#pragma unroll
                    for (int e = 0; e < 16; ++e) acci[e] = 0;
#pragma unroll
                    for (int ks = 0; ks < 4; ++ks) acci = __builtin_amdgcn_mfma_i32_32x32x32_i8(af[q][ks], bfr[ks], acci, 0, 0, 0);
                    const f32x16 acc = __builtin_convertvector(acci, f32x16);
                    const v4u x0 = (v4u){pkmax0(pg8::cvt_pk_bf16(acc[0], acc[1])), pkmax0(pg8::cvt_pk_bf16(acc[2], acc[3])), pkmax0(pg8::cvt_pk_bf16(acc[4], acc[5])), pkmax0(pg8::cvt_pk_bf16(acc[6], acc[7]))};
                    const v4u x1 = (v4u){pkmax0(pg8::cvt_pk_bf16(acc[8], acc[9])), pkmax0(pg8::cvt_pk_bf16(acc[10], acc[11])), pkmax0(pg8::cvt_pk_bf16(acc[12], acc[13])), pkmax0(pg8::cvt_pk_bf16(acc[14], acc[15]))};
                    f32x16 y;
#pragma unroll
                    for (int e = 0; e < 16; ++e) y[e] = 0.f;
                    y = MFMA32(wf[q][0], __builtin_bit_cast(bf16x8, x0), y); y = MFMA32(wf[q][1], __builtin_bit_cast(bf16x8, x1), y);
                    scb[(size_t)q * 8192 + 64 * t + 32 * tt] = y[0] * skv[tt]; }
            }
        }
#endif
        asm volatile("s_waitcnt vmcnt(0)" ::: "memory");
#undef IDX_DMA
    }
}
__device__ __forceinline__ void idx_score_phase(Frame& F) {
    const bf16* IQ = (const bf16*)(F.ws + WS_IQ); const bf16* IKB = (const bf16*)(F.ws + WS_IKB); const float* IWS = (const float*)(F.ws + WS_IWS); float* SC = (float*)(F.ws + WS_SCORE);
    const int w = F.wave, lane = F.lane, l31 = lane & 31, half = lane >> 5;
    constexpr int NB = 8, NQ = 4;
    LAS unsigned char* ring = F.lds + RING_OFF;
    const int dmaR = 4 * w + (lane >> 4), dmaCh = (lane & 15) ^ (dmaR & 15);
    const int rdoff = l31 * 256;
    for (int i = blockIdx.x; i < 512; i += F.G) {
        const int b = i >> 8, jj = i & 255, qb = (b == 0) ? jj : 255 - jj;
        const int t0 = 32 * qb + NQ * w;
        bf16x8 af[NQ][8], wf[NQ][2];
#pragma unroll
        for (int q = 0; q < NQ; ++q) { const size_t m = (size_t)b * SEQ + t0 + q; const bf16* arow = IQ + m * 4096 + l31 * 128 + 8 * half;
#pragma unroll
            for (int ks = 0; ks < 8; ++ks) af[q][ks] = *(const GAS bf16x8*)(arow + 16 * ks);
#pragma unroll
            for (int s2 = 0; s2 < 2; ++s2) { const f32x4 w0 = *(const GAS f32x4*)(IWS + m * 32 + 16 * s2 + 4 * half), w1 = *(const GAS f32x4*)(IWS + m * 32 + 16 * s2 + 8 + 4 * half);
                const v4u uu = (v4u){pk2(w0.x, w0.y), pk2(w0.z, w0.w), pk2(w1.x, w1.y), pk2(w1.z, w1.w)}; wf[q][s2] = __builtin_bit_cast(bf16x8, uu); } }
        const int npair = (qb + 2) >> 1;
        const bf16* ksrc = IKB + ((size_t)b * SEQ + dmaR) * 128 + 8 * dmaCh;
        float* scb = SC + ((size_t)b * SEQ + t0) * 8192 + l31;
#define IDX_DMA(kt_) do { const int ktc_ = (kt_) < 255 ? (kt_) : 255; \
            __builtin_amdgcn_global_load_lds((const unsigned*)(ksrc + (size_t)(32 * ktc_) * 128), (LAS unsigned*)(ring + ((kt_) & (NB - 1)) * 8192 + w * 1024), 16, 0, 0); } while (0)
        __syncthreads();
#pragma unroll
        for (int j = 0; j < NB - 2; ++j) IDX_DMA(j);
        for (int ip = 0; ip < npair; ++ip) {
            if (ip >= 3) asm volatile("s_waitcnt vmcnt(28)" ::: "memory");
            else if (ip == 0) asm volatile("s_waitcnt vmcnt(4)" ::: "memory"); else if (ip == 1) asm volatile("s_waitcnt vmcnt(12)" ::: "memory"); else asm volatile("s_waitcnt vmcnt(20)" ::: "memory");
            __builtin_amdgcn_s_barrier();
            asm volatile("" ::: "memory");
            IDX_DMA(2 * ip + NB - 2); IDX_DMA(2 * ip + NB - 1);
#pragma unroll
            for (int tt = 0; tt < 2; ++tt) { const int kt = 2 * ip + tt;
            const LAS unsigned char* sl = ring + (kt & (NB - 1)) * 8192 + rdoff;
            bf16x8 bfr[8];
#pragma unroll
            for (int ks = 0; ks < 8; ++ks) bfr[ks] = *(const LAS bf16x8*)(sl + 16 * ((2 * ks + half) ^ (l31 & 15)));
#pragma unroll
            for (int q = 0; q < NQ; ++q) { f32x16 acc;
#pragma unroll
                for (int e = 0; e < 16; ++e) acc[e] = 0.f;
#pragma unroll
                for (int ks = 0; ks < 8; ++ks) acc = MFMA32(af[q][ks], bfr[ks], acc);
                const v4u x0 = (v4u){pkmax0(pg8::cvt_pk_bf16(acc[0], acc[1])), pkmax0(pg8::cvt_pk_bf16(acc[2], acc[3])), pkmax0(pg8::cvt_pk_bf16(acc[4], acc[5])), pkmax0(pg8::cvt_pk_bf16(acc[6], acc[7]))};
                const v4u x1 = (v4u){pkmax0(pg8::cvt_pk_bf16(acc[8], acc[9])), pkmax0(pg8::cvt_pk_bf16(acc[10], acc[11])), pkmax0(pg8::cvt_pk_bf16(acc[12], acc[13])), pkmax0(pg8::cvt_pk_bf16(acc[14], acc[15]))};
                f32x16 y;
#pragma unroll
                for (int e = 0; e < 16; ++e) y[e] = 0.f;
                y = MFMA32(wf[q][0], __builtin_bit_cast(bf16x8, x0), y); y = MFMA32(wf[q][1], __builtin_bit_cast(bf16x8, x1), y);
                const int ktc = kt < 255 ? kt : 255;
                scb[(size_t)q * 8192 + 32 * ktc] = y[0]; }
            }
        }
        asm volatile("s_waitcnt vmcnt(0)" ::: "memory");
#undef IDX_DMA
    }
}
__device__ __forceinline__ unsigned okey(float f) { const unsigned u = __builtin_bit_cast(unsigned, f); return u ^ ((unsigned)((int)u >> 31) | 0x80000000u); }
__device__ __forceinline__ int wave_sum_i(int v) {
#pragma unroll
    for (int o = 1; o < 64; o <<= 1) v += __shfl_xor(v, o);
    return v;
}
__device__ __forceinline__ int mbcnt64(unsigned long long m) { return (int)__builtin_amdgcn_mbcnt_hi((unsigned)(m >> 32), __builtin_amdgcn_mbcnt_lo((unsigned)m, 0u)); }
template <int NJ> __device__ __forceinline__ void topk_row(const float* sc, int n, int* sel, int lane_in) {
    int lane = lane_in; asm volatile("" : "+v"(lane));
    unsigned k[NJ];
    const float* p = sc + lane;
#pragma unroll
    for (int j = 0; j < NJ; ++j) { k[j] = okey(P0_NT ? __builtin_nontemporal_load(p + 64 * j) : p[64 * j]) & (unsigned)((64 * j + lane - n) >> 31); if ((j & 31) == 31) __builtin_amdgcn_sched_barrier(0); }
    unsigned Mx = 0u;
#pragma unroll
    for (int j = 0; j < NJ; ++j) Mx = k[j] > Mx ? k[j] : Mx;
#pragma unroll
    for (int o = 1; o < 64; o <<= 1) { const unsigned ot = (unsigned)__shfl_xor((int)Mx, o); Mx = ot > Mx ? ot : Mx; }
    unsigned T = 0u, pref = Mx & 0xFF800000u; bool exact = false, pmode = pref >= 0x00800000u; int bit = 31, tries = 0;
    for (;;) {
        if (!pmode && bit < 0) break;
        const unsigned cand = pmode ? pref : (T | (1u << bit)); int cnt = 0;
#pragma unroll
        for (int j = 0; j < NJ; ++j) { cnt += __builtin_popcountll(__ballot(k[j] >= cand)); if ((j & 7) == 7) __builtin_amdgcn_sched_barrier(0); }
        if (pmode) {
            if (cnt >= TOPK) { T = pref; bit = 22; pmode = false; if (cnt == TOPK) { exact = true; break; } }
            else { ++tries; if (tries >= 3 || pref < 0x01000000u) { pmode = false; T = 0u; bit = 31; } else pref -= 0x00800000u; }
        } else {
            if (cnt >= TOPK) T = cand;
            if (cnt == TOPK) { exact = true; break; }
            --bit; }
    }
    unsigned T2 = exact ? T - 1u : T; asm volatile("" : "+v"(T2));
    int cgt = 0;
#pragma unroll
    for (int j = 0; j < NJ; ++j) { const int pc = __builtin_popcountll(__ballot(k[j] > T2)); asm volatile("s_add_i32 %0, %0, %1" : "+s"(cgt) : "s"(pc) : "scc"); }
    const int need = TOPK - cgt; int cur = 0, eqb = 0;
    int lane2 = lane_in; asm volatile("" : "+v"(lane2));
    unsigned T3 = T2; asm volatile("" : "+v"(T3));
#pragma unroll
    for (int j = 0; j < NJ; ++j) { const bool gt = k[j] > T3, eq = k[j] == T3; const unsigned long long me = __ballot(eq); const bool take = gt || (eq && (eqb + mbcnt64(me)) < need);
        const unsigned long long mt = __ballot(take); if (take) sel[cur + mbcnt64(mt)] = 64 * j + lane2; cur += __builtin_popcountll(mt); eqb += __builtin_popcountll(me);
        __builtin_amdgcn_sched_barrier(0); }
}
constexpr int LATE_OUTB = (4096 / 64) * (DM / 32), LATE_UP = (DM / 64) * (DFF / 32), LATE_DOWN = (DFF / 64) * (DM / 32), NLATE = LATE_CONV ? LATE_OUTB + LATE_UP + LATE_DOWN : 0;
constexpr int LATE_P9 = (TOPK_SPLIT && P9_FILL && LATE_CONV) ? 12288 : 0;
constexpr int LATE_SPLIT = (TOPK_SPLIT && SP_LATE) ? LATE_OUTB + LATE_UP : NLATE;
__device__ __forceinline__ void late_conv_item(Frame& F, const Args& a, LAS float* scr, int r) {
    unsigned char* ws = F.ws;
    if (r < LATE_OUTB) { p0_transpose_item_f8((const float*)a.in[13], 4096, DM, (unsigned char*)(ws + WS_W_OUTB), WOUTB_SCALE, scr, r, F.lane); return; } r -= LATE_OUTB;
    if (r < LATE_UP) { p0_transpose_item_f8((const float*)a.in[14] + (size_t)DM * DFF, DM, DFF, (unsigned char*)(ws + WS_W_UP1), WUP_SCALE, scr, r, F.lane); return; } r -= LATE_UP;
    p0_transpose_item_f8((const float*)a.in[15] + (size_t)DM * DFF, DFF, DM, (unsigned char*)(ws + WS_W_DOWN1), WDOWN_SCALE, scr, r, F.lane);
}
struct LateP { const float* W; unsigned char* WT; int K, N; float scale; };
__device__ __forceinline__ LateP late_conv_params(Frame& F, const Args& a, int& r) {
    unsigned char* ws = F.ws;
    if (r < LATE_OUTB) return LateP{(const float*)a.in[13], (unsigned char*)(ws + WS_W_OUTB), 4096, DM, WOUTB_SCALE}; r -= LATE_OUTB;
    if (r < LATE_UP) return LateP{(const float*)a.in[14] + (size_t)DM * DFF, (unsigned char*)(ws + WS_W_UP1), DM, DFF, WUP_SCALE}; r -= LATE_UP;
    return LateP{(const float*)a.in[15] + (size_t)DM * DFF, (unsigned char*)(ws + WS_W_DOWN1), DFF, DM, WDOWN_SCALE};
}
template <int NBT> __device__ __forceinline__ void late_conv_batch(Frame& F, const Args& a, LAS float* scr, int li, int stride) {
    const int lane = F.lane;
    float tv[NBT][32]; LateP P[NBT]; int k0[NBT], n0[NBT];
#pragma unroll
    for (int b = 0; b < NBT; ++b) { int r = li + b * stride; P[b] = late_conv_params(F, a, r); const int nblk = P[b].N / 32; k0[b] = 64 * (r / nblk); n0[b] = 32 * (r % nblk);
        const float* src = P[b].W + (size_t)(k0[b] + (lane >> 5)) * P[b].N + n0[b] + (lane & 31);
#pragma unroll
        for (int i = 0; i < 32; ++i) tv[b][i] = src[(size_t)(2 * i) * P[b].N]; }
    __builtin_amdgcn_sched_barrier(0);
#pragma unroll
    for (int b = 0; b < NBT; ++b) {
#pragma unroll
        for (int i = 0; i < 32; ++i) scr[(2 * i + (lane >> 5)) * 33 + (lane & 31)] = tv[b][i];
        LDS_WAIT(); asm volatile("" ::: "memory");
        const int c = lane & 7; const float scale = P[b].scale;
#pragma unroll
        for (int j = 0; j < 4; ++j) { const int n = (lane >> 3) + 8 * j; const LAS float* s = scr + (8 * c) * 33 + n;
            int p0 = 0, p1 = 0;
            p0 = __builtin_amdgcn_cvt_pk_fp8_f32(s[0 * 33] * scale, s[1 * 33] * scale, p0, false); p0 = __builtin_amdgcn_cvt_pk_fp8_f32(s[2 * 33] * scale, s[3 * 33] * scale, p0, true);
            p1 = __builtin_amdgcn_cvt_pk_fp8_f32(s[4 * 33] * scale, s[5 * 33] * scale, p1, false); p1 = __builtin_amdgcn_cvt_pk_fp8_f32(s[6 * 33] * scale, s[7 * 33] * scale, p1, true);
            *(GAS unsigned long long*)(P[b].WT + (size_t)(n0[b] + n) * P[b].K + k0[b] + 8 * c) = (unsigned long long)(unsigned)p0 | ((unsigned long long)(unsigned)p1 << 32); }
        LDS_WAIT(); asm volatile("" ::: "memory");
        __builtin_amdgcn_sched_barrier(0); }
}
#if TOPK_SPLIT
__device__ __forceinline__ void topk_phase(Frame& F, const Args& a) {
    const float* SC = (const float*)(F.ws + WS_SCORE); int* SEL = (int*)(F.ws + WS_SEL);
    LAS float* scr = (LAS float*)(F.lds + RING_OFF + F.wave * 16384);
    LAS unsigned* ctr = (LAS unsigned*)(F.lds + RING_OFF + 16000);
    if (F.tid == 0) *ctr = 0u;
    __syncthreads();
    if (LATE_CONV && F.wave >= 4) { const int cw = F.vcu * 4 + (F.wave - 4), NCW = F.G * 4;
        int li = LATE_P9 + cw;
        for (; li + 4 * NCW < LATE_SPLIT; li += 5 * NCW) late_conv_batch<5>(F, a, scr, li, NCW);
#pragma unroll 1
        for (; li < LATE_SPLIT; li += NCW) late_conv_item(F, a, scr, li); }
    const int nrows = (M - F.vcu + F.G - 1) / F.G;
    for (;;) {
        unsigned i_ = 0u; if (F.lane == 0) i_ = __hip_atomic_fetch_add(ctr, 1u, __ATOMIC_RELAXED, __HIP_MEMORY_SCOPE_WORKGROUP);
        const int i = __builtin_amdgcn_readfirstlane((int)i_);
        if (i >= nrows) break;
        const int m = F.vcu + F.G * i;
        const int t = m & (SEQ - 1), n = t + 1; int* sel = SEL + (size_t)m * 256; const float* sc = SC + (size_t)m * 8192;
        if (n <= 256) { const int lane = F.lane;
#pragma unroll
            for (int i2 = 0; i2 < 4; ++i2) sel[64 * i2 + lane] = (64 * i2 + lane < n) ? 64 * i2 + lane : 0;
        } else if (n <= 2048) topk_row<32>(sc, n, sel, F.lane);
        else if (n <= 4096) topk_row<64>(sc, n, sel, F.lane);
        else topk_row<128>(sc, n, sel, F.lane);
    }
    __syncthreads();
}
#else
__device__ __forceinline__ void topk_phase(Frame& F, const Args& a) {
    const float* SC = (const float*)(F.ws + WS_SCORE); int* SEL = (int*)(F.ws + WS_SEL);
    const int gw = F.vcu * NWAVES + F.wave, NGW = F.G * NWAVES;
    LAS float* scr = (LAS float*)(F.lds + RING_OFF + F.wave * 16384);
    int li = gw;
    for (int m = gw; m < M; m += NGW) {
        if (LATE_CONV) {
            if (LATE_BATCH && li + 4 * NGW < NLATE) { late_conv_batch<5>(F, a, scr, li, NGW); li += 5 * NGW; }
            else {
#pragma unroll 1
                for (int j = 0; j < 5 && li < NLATE; ++j, li += NGW) late_conv_item(F, a, scr, li); } }
        const int t = m & (SEQ - 1), n = t + 1; int* sel = SEL + (size_t)m * 256; const float* sc = SC + (size_t)m * 8192;
        if (n <= 256) { const int lane = F.lane;
#pragma unroll
            for (int i = 0; i < 4; ++i) sel[64 * i + lane] = (64 * i + lane < n) ? 64 * i + lane : 0;
        } else if (n <= 2048) topk_row<32>(sc, n, sel, F.lane);
        else if (n <= 4096) topk_row<64>(sc, n, sel, F.lane);
        else topk_row<128>(sc, n, sel, F.lane);
    }
    if (LATE_CONV) {
#pragma unroll 1
        for (; li < NLATE; li += NGW) late_conv_item(F, a, scr, li); }
}
#endif
#define MFMA16(a, b, c) __builtin_amdgcn_mfma_f32_16x16x32_bf16((a), (b), (c), 0, 0, 0)
#define MFMA16F8(a, b, c) __builtin_amdgcn_mfma_f32_16x16x32_fp8_fp8((a), (b), (c), 0, 0, 0)
constexpr float QF8_SCALE = 16.0f;
constexpr float OSC = OB_SCALE / (PF8_SCALE * VF8_SCALE);
typedef int v2i_t __attribute__((ext_vector_type(2)));
typedef short s16x4 __attribute__((ext_vector_type(4)));
typedef short v4i16_t __attribute__((ext_vector_type(4)));
__device__ __forceinline__ s16x4 vtr(const LAS unsigned char* p) { return __builtin_bit_cast(s16x4, __builtin_amdgcn_ds_read_tr16_b64_v4i16((LAS v4i16_t*)p)); }
__device__ __forceinline__ void sparse_attn_phase(Frame& F, const Args& a) {
    const bf16* QB = (const bf16*)(F.ws + WS_QB); const unsigned char* KB8 = (const unsigned char*)(F.ws + WS_KB); const unsigned char* VB8 = (const unsigned char*)(F.ws + WS_VB); const int* SEL = (const int*)(F.ws + WS_SEL); unsigned char* OB = (unsigned char*)(F.ws + WS_OB);
    const int w = F.wave, lane = F.lane, r16 = lane & 15, c4 = lane >> 4;
    LAS unsigned char* ring = F.lds + RING_OFF + w * 16384;
    LAS int* selb = (LAS int*)(F.lds + RING_BYTES + 1024 + w * 2048);
    unsigned* qctr = (unsigned*)(F.ctl + CW_SPQ);
    const unsigned xcc = xb_xcc_id() & 7u;
    unsigned qx = xcc; int tries = 0;
#define SP_POP_BLOCKING(vout) do { unsigned x2_ = 0u; if (lane == 0) x2_ = xb_add(qctr + 64 * qx, 1u); vout = (unsigned)__builtin_amdgcn_readfirstlane((int)x2_); \
        while (vout >= 16384u && tries < 8) { ++tries; qx = (qx + 1u) & 7u; x2_ = 0u; if (lane == 0) x2_ = xb_add(qctr + 64 * qx, 1u); vout = (unsigned)__builtin_amdgcn_readfirstlane((int)x2_); } } while (0)
#define SP_PREFETCH(v_, g_, selv_, qv_) do { const size_t m_ = (size_t)((v_) >> 13) * SEQ + ((v_) & 8191u); selv_ = *(const GAS v4u*)(SEL + m_ * 256 + 4 * lane); \
        const bf16* qrow_ = QB + m_ * 4096 + ((g_) * 4 + (r16 & 3)) * 128 + 32 * c4; \
        _Pragma("unroll") for (int ks = 0; ks < 4; ++ks) qv_[ks] = *(const GAS v4u*)(qrow_ + 8 * ks); } while (0)
#define SP_VSWZ(R) ((((R) >> 1) & 3) | ((((R) >> 4) & 1) << 2))
    const int selo = lane >> 3;
    const unsigned kslot = 16u * (unsigned)(lane & 7);
    const unsigned vslot0 = 16u * (unsigned)((lane & 7) ^ ((lane >> 4) & 3)), vslot1 = 16u * (unsigned)((lane & 7) ^ (((lane >> 4) & 3) | 4));
#define SP_ROWS(rows_, sel_, cnt_, chunk_) do { \
        _Pragma("unroll") for (int i4 = 0; i4 < 4; ++i4) rows_[i4] = (sel_)[selo + 32 * (chunk_) + 8 * i4]; } while (0)
#define SP_ISSUE(base_, rows_, slot_, isv_) do { \
        _Pragma("unroll") for (int i4 = 0; i4 < 4; ++i4) { const unsigned off_ = ((unsigned)rows_[i4] << 10) + ((isv_) ? ((i4 & 2) ? vslot1 : vslot0) : kslot); \
        __builtin_amdgcn_global_load_lds((const unsigned*)((base_) + off_), (LAS unsigned*)(ring + (slot_) * 4096 + i4 * 1024), 16, 0, 0); } } while (0)
#define SP_CHUNK_DMA(base_, sel_, cnt_, chunk_, slot_, isv_) do { int rws_[4]; SP_ROWS(rws_, sel_, cnt_, chunk_); SP_ISSUE(base_, rws_, slot_, isv_); } while (0)
#if TOPK_SPLIT && SP_LATE
    if (LATE_CONV && w >= 4) {
        LAS float* scr_ = (LAS float*)(F.lds + RING_OFF + w * 16384); const int NCW = F.G * 4; int li = LATE_SPLIT + F.vcu * 4 + (w - 4);
        for (; li + 4 * NCW < NLATE; li += 5 * NCW) late_conv_batch<5>(F, a, scr_, li, NCW);
#pragma unroll 1
        for (; li < NLATE; li += NCW) late_conv_item(F, a, scr_, li); }
#endif
    unsigned v; SP_POP_BLOCKING(v);
    if (v < 16384u) {
    int g = (int)qx, cur = 0;
    v4u selv, qv[4];
    SP_PREFETCH(v, g, selv, qv);
    unsigned nxt = 0u;
#if SP_ASM2
    LAS unsigned char* qbuf = F.lds + RING_BYTES + 1024 + NWAVES * 2048 + w * 1024;
    { const size_t m0_ = (size_t)(v >> 13) * SEQ + (v & 8191u);
      __builtin_amdgcn_global_load_lds((const unsigned*)((const unsigned char*)(QB + m0_ * 4096 + g * 512) + 16 * lane), (LAS unsigned*)qbuf, 16, 0, 0); }
    bool first = true;
#endif
    if (lane == 0) nxt = xb_add(qctr + 64 * qx, 1u);
    *(LAS v4u*)(selb + 4 * lane) = selv;
    LDS_WAIT();
#if SP_ASM2
    asm volatile("s_waitcnt vmcnt(0)" ::: "memory");
#endif
    { const int b0 = (int)(v >> 13), t0 = (int)(v & 8191u), cnt0 = (t0 + 1 < TOPK) ? t0 + 1 : TOPK;
      const unsigned char* KB0 = KB8 + (size_t)b0 * SEQ * 1024 + g * 128;
      SP_CHUNK_DMA(KB0, selb, cnt0, 0, 0, 0); SP_CHUNK_DMA(KB0, selb, cnt0, 1, 1, 0); SP_CHUNK_DMA(KB0, selb, cnt0, 2, 2, 0); }
    for (;;) {
        const int b = (int)(v >> 13), t = (int)(v & 8191u), cnt = (t + 1 < TOPK) ? t + 1 : TOPK;
        const size_t m = (size_t)b * SEQ + t;
        LAS int* sel_l = selb + cur * 256;
        const unsigned char* KBg = KB8 + (size_t)b * SEQ * 1024 + g * 128;
        const unsigned char* VBg = VB8 + (size_t)b * SEQ * 1024 + g * 128;
        long long qf[4];
#pragma unroll
        for (int ks = 0; ks < 4; ++ks) {
#if SP_ASM2
            const v4u qq4 = *(const LAS v4u*)(qbuf + (r16 & 3) * 256 + (32 * c4 + 8 * ks) * 2);
#else
            const v4u qq4 = qv[ks];
#endif
            int lo = 0, hi = 0;
            lo = __builtin_amdgcn_cvt_pk_fp8_f32(bf_lo(qq4.x) * QF8_SCALE, bf_hi(qq4.x) * QF8_SCALE, lo, false); lo = __builtin_amdgcn_cvt_pk_fp8_f32(bf_lo(qq4.y) * QF8_SCALE, bf_hi(qq4.y) * QF8_SCALE, lo, true);
            hi = __builtin_amdgcn_cvt_pk_fp8_f32(bf_lo(qq4.z) * QF8_SCALE, bf_hi(qq4.z) * QF8_SCALE, hi, false); hi = __builtin_amdgcn_cvt_pk_fp8_f32(bf_lo(qq4.w) * QF8_SCALE, bf_hi(qq4.w) * QF8_SCALE, hi, true);
            const long long qq = (long long)((unsigned long long)(unsigned)lo | ((unsigned long long)(unsigned)hi << 32));
            qf[ks] = (r16 < 4) ? qq : 0ll; }
        unsigned vn = (unsigned)__builtin_amdgcn_readfirstlane((int)nxt);
        if (vn >= 16384u && tries < 8) { ++tries; qx = (qx + 1u) & 7u; SP_POP_BLOCKING(vn); }
        const bool have_next = vn < 16384u; const int gn = (int)qx;
        v4u selv_n = selv, qv_n[4] = {qv[0], qv[1], qv[2], qv[3]};
#if SP_ASM2
        if (have_next) {
            const size_t mn_ = (size_t)(vn >> 13) * SEQ + (vn & 8191u);
            __builtin_amdgcn_global_load_lds((const unsigned*)(SEL + mn_ * 256 + 4 * lane), (LAS unsigned*)(selb + (cur ^ 1) * 256), 16, 0, 0);
            asm volatile("s_waitcnt lgkmcnt(0)" ::: "memory");
            __builtin_amdgcn_global_load_lds((const unsigned*)((const unsigned char*)(QB + mn_ * 4096 + gn * 512) + 16 * lane), (LAS unsigned*)qbuf, 16, 0, 0);
            if (lane == 0) { const unsigned long long ap_ = (unsigned long long)(qctr + 64 * qx); const unsigned one_ = 1u;
                asm volatile("global_atomic_add %0, %1, %2, off sc0" : "+v"(nxt) : "v"(ap_), "v"(one_) : "memory"); } }
#elif SP_ASM
        if (have_next) {
            const size_t mn_ = (size_t)(vn >> 13) * SEQ + (vn & 8191u);
            __builtin_amdgcn_global_load_lds((const unsigned*)(SEL + mn_ * 256 + 4 * lane), (LAS unsigned*)(selb + (cur ^ 1) * 256), 16, 0, 0);
            const bf16* qrow_ = QB + mn_ * 4096 + (gn * 4 + (r16 & 3)) * 128 + 32 * c4;
#pragma unroll
            for (int ks = 0; ks < 4; ++ks) qv_n[ks] = *(const GAS v4u*)(qrow_ + 8 * ks);
            if (lane == 0) nxt = xb_add(qctr + 64 * qx, 1u); }
#else
        if (have_next) { SP_PREFETCH(vn, gn, selv_n, qv_n); if (lane == 0) nxt = xb_add(qctr + 64 * qx, 1u); }
#endif
        f32x4 S[16];
#pragma unroll
        for (int c = 0; c < 8; ++c) {
            int rw[4]; SP_ROWS(rw, sel_l, cnt, (c + 3) & 7);
#if SP_ASM2
            if (c < 3) { if (have_next) { if (first) asm volatile("s_waitcnt vmcnt(11)" ::: "memory"); else asm volatile("s_waitcnt vmcnt(19)" ::: "memory"); }
                         else { if (first) asm volatile("s_waitcnt vmcnt(8)" ::: "memory"); else asm volatile("s_waitcnt vmcnt(16)" ::: "memory"); } }
            else asm volatile("s_waitcnt vmcnt(8)" ::: "memory");
#else
            asm volatile("s_waitcnt vmcnt(8)" ::: "memory");
#endif
            if (c + 3 < 8) SP_ISSUE(KBg, rw, (c + 3) & 3, 0); else SP_ISSUE(VBg, rw, (c + 3) & 3, 1);
            const LAS unsigned char* kb = ring + (c & 3) * 4096 + r16 * 128 + 32 * c4;
#pragma unroll
            for (int tl = 0; tl < 2; ++tl) { const v4u k0 = *(const LAS v4u*)(kb + tl * 2048), k1 = *(const LAS v4u*)(kb + tl * 2048 + 16);
                f32x4 acc = {0.f, 0.f, 0.f, 0.f};
                acc = MFMA16F8((long long)((unsigned long long)k0.x | ((unsigned long long)k0.y << 32)), qf[0], acc);
                acc = MFMA16F8((long long)((unsigned long long)k0.z | ((unsigned long long)k0.w << 32)), qf[1], acc);
                acc = MFMA16F8((long long)((unsigned long long)k1.x | ((unsigned long long)k1.y << 32)), qf[2], acc);
                acc = MFMA16F8((long long)((unsigned long long)k1.z | ((unsigned long long)k1.w << 32)), qf[3], acc);
                S[2 * c + tl] = acc; }
            __builtin_amdgcn_sched_barrier(0);
        }
        if (cnt < TOPK) {
            const float fb = (float)(cnt - 1 - 4 * c4);
#pragma unroll
            for (int tau = 0; tau < 16; ++tau)
#pragma unroll
                for (int i = 0; i < 4; ++i) S[tau][i] += fminf(fb - (float)(16 * tau + i), 0.f) * 1e30f; }
        float mx = -1e30f;
#pragma unroll
        for (int tau = 0; tau < 16; ++tau) mx = fmaxf(fmaxf(mx, fmaxf(S[tau][0], S[tau][1])), fmaxf(S[tau][2], S[tau][3]));
        mx = fmaxf(mx, __shfl_xor(mx, 16)); mx = fmaxf(mx, __shfl_xor(mx, 32));
        float sum = 0.f;
#pragma unroll
        for (int tau = 0; tau < 16; ++tau)
#pragma unroll
            for (int i = 0; i < 4; ++i) { const float pv = __builtin_amdgcn_exp2f((S[tau][i] - mx) * (1.4426950408889634f / QF8_SCALE)); S[tau][i] = pv; sum += pv; }
        sum += __shfl_xor(sum, 16); sum += __shfl_xor(sum, 32);
        const float inv = 1.0f / sum;
        LAS int* sel_n = selb + (cur ^ 1) * 256;
        const int bn = (int)(vn >> 13), tn = (int)(vn & 8191u), cntn = (tn + 1 < TOPK) ? tn + 1 : TOPK;
        const unsigned char* KBn = KB8 + (size_t)bn * SEQ * 1024 + gn * 128;
#if !SP_ASM
        if (have_next) { *(LAS v4u*)(sel_n + 4 * lane) = selv_n; }
#endif
        f32x4 O[8];
#pragma unroll
        for (int dt = 0; dt < 8; ++dt) O[dt] = (f32x4){0.f, 0.f, 0.f, 0.f};
        const int q8 = r16 >> 1, p8 = r16 & 1;
        const int Rr = (q8 < 4) ? 4 * c4 + q8 : 16 + 4 * c4 + (q8 - 4);
        const int rbase = Rr * 128 + 8 * p8, rsw = SP_VSWZ(Rr);
        const float pscale = inv * PF8_SCALE;
#if SP_ASM
        unsigned vaddr[8];
#pragma unroll
        for (int dt = 0; dt < 8; ++dt) vaddr[dt] = (unsigned)(size_t)ring + (unsigned)(rbase + 16 * (dt ^ rsw));
#endif
#pragma unroll
        for (int s = 0; s < 8; ++s) {
            int rw[4];
            if (s + 3 < 8) SP_ROWS(rw, sel_l, cnt, s + 3); else SP_ROWS(rw, sel_n, cntn, s + 3 - 8);
            if (have_next || s < 6) asm volatile("s_waitcnt vmcnt(8)" ::: "memory"); else asm volatile("s_waitcnt vmcnt(0)" ::: "memory");
            if (s + 3 < 8) SP_ISSUE(VBg, rw, (s + 3) & 3, 1);
            else if (have_next) SP_ISSUE(KBn, rw, (s + 3) & 3, 0);
            long long pb;
            { int lo = 0, hi = 0;
              lo = __builtin_amdgcn_cvt_pk_fp8_f32(S[2 * s][0] * pscale, S[2 * s][1] * pscale, lo, false); lo = __builtin_amdgcn_cvt_pk_fp8_f32(S[2 * s][2] * pscale, S[2 * s][3] * pscale, lo, true);
              hi = __builtin_amdgcn_cvt_pk_fp8_f32(S[2 * s + 1][0] * pscale, S[2 * s + 1][1] * pscale, hi, false); hi = __builtin_amdgcn_cvt_pk_fp8_f32(S[2 * s + 1][2] * pscale, S[2 * s + 1][3] * pscale, hi, true);
              pb = (long long)((unsigned long long)(unsigned)lo | ((unsigned long long)(unsigned)hi << 32)); }
#if SP_ASM
            v2i_t a8[8];
#if SP_VSPLIT
            asm volatile("ds_read_b64_tr_b8 %0, %8 offset:%16\n\tds_read_b64_tr_b8 %1, %9 offset:%16\n\tds_read_b64_tr_b8 %2, %10 offset:%16\n\tds_read_b64_tr_b8 %3, %11 offset:%16\n\t"
                         "ds_read_b64_tr_b8 %4, %12 offset:%16\n\tds_read_b64_tr_b8 %5, %13 offset:%16\n\tds_read_b64_tr_b8 %6, %14 offset:%16\n\tds_read_b64_tr_b8 %7, %15 offset:%16\n\ts_waitcnt lgkmcnt(4)"
                         : "=&v"(a8[0]), "=&v"(a8[1]), "=&v"(a8[2]), "=&v"(a8[3]), "=&v"(a8[4]), "=&v"(a8[5]), "=&v"(a8[6]), "=&v"(a8[7])
                         : "v"(vaddr[0]), "v"(vaddr[1]), "v"(vaddr[2]), "v"(vaddr[3]), "v"(vaddr[4]), "v"(vaddr[5]), "v"(vaddr[6]), "v"(vaddr[7]), "n"((s & 3) * 4096) : "memory");
#pragma unroll
            for (int dt = 0; dt < 4; ++dt) { const long long av = (long long)((unsigned long long)(unsigned)a8[dt].x | ((unsigned long long)(unsigned)a8[dt].y << 32));
                O[dt] = MFMA16F8(av, pb, O[dt]); }
            __builtin_amdgcn_sched_barrier(0);
            asm volatile("s_waitcnt lgkmcnt(0)" : "+v"(a8[4]), "+v"(a8[5]), "+v"(a8[6]), "+v"(a8[7]) :: "memory");
#pragma unroll
            for (int dt = 4; dt < 8; ++dt) { const long long av = (long long)((unsigned long long)(unsigned)a8[dt].x | ((unsigned long long)(unsigned)a8[dt].y << 32));
                O[dt] = MFMA16F8(av, pb, O[dt]); }
#else
            asm volatile("ds_read_b64_tr_b8 %0, %8 offset:%16\n\tds_read_b64_tr_b8 %1, %9 offset:%16\n\tds_read_b64_tr_b8 %2, %10 offset:%16\n\tds_read_b64_tr_b8 %3, %11 offset:%16\n\t"
                         "ds_read_b64_tr_b8 %4, %12 offset:%16\n\tds_read_b64_tr_b8 %5, %13 offset:%16\n\tds_read_b64_tr_b8 %6, %14 offset:%16\n\tds_read_b64_tr_b8 %7, %15 offset:%16\n\ts_waitcnt lgkmcnt(0)"
                         : "=&v"(a8[0]), "=&v"(a8[1]), "=&v"(a8[2]), "=&v"(a8[3]), "=&v"(a8[4]), "=&v"(a8[5]), "=&v"(a8[6]), "=&v"(a8[7])
                         : "v"(vaddr[0]), "v"(vaddr[1]), "v"(vaddr[2]), "v"(vaddr[3]), "v"(vaddr[4]), "v"(vaddr[5]), "v"(vaddr[6]), "v"(vaddr[7]), "n"((s & 3) * 4096) : "memory");
#pragma unroll
            for (int dt = 0; dt < 8; ++dt) { const long long av = (long long)((unsigned long long)(unsigned)a8[dt].x | ((unsigned long long)(unsigned)a8[dt].y << 32));
                O[dt] = MFMA16F8(av, pb, O[dt]); }
#endif
#else
            const LAS unsigned char* vb = ring + (s & 3) * 4096 + rbase;
#pragma unroll
            for (int dt = 0; dt < 8; ++dt) { const v2i_t a8 = __builtin_amdgcn_ds_read_tr8_b64_v2i32((LAS v2i_t*)(vb + 16 * (dt ^ rsw)));
                const long long av = (long long)((unsigned long long)(unsigned)a8.x | ((unsigned long long)(unsigned)a8.y << 32));
                O[dt] = MFMA16F8(av, pb, O[dt]); }
#endif
            __builtin_amdgcn_sched_barrier(0);
        }
        if (r16 < 4) { unsigned char* op = OB + m * 4096 + (g * 4 + r16) * 128 + 4 * c4;
#pragma unroll
            for (int dt = 0; dt < 8; ++dt) { int pq = 0; pq = __builtin_amdgcn_cvt_pk_fp8_f32(fminf(fmaxf(O[dt][0] * OSC, -448.f), 448.f), fminf(fmaxf(O[dt][1] * OSC, -448.f), 448.f), pq, false);
                pq = __builtin_amdgcn_cvt_pk_fp8_f32(fminf(fmaxf(O[dt][2] * OSC, -448.f), 448.f), fminf(fmaxf(O[dt][3] * OSC, -448.f), 448.f), pq, true); *(GAS unsigned*)(op + 16 * dt) = (unsigned)pq; } }
        if (!have_next) break;
#if SP_ASM2
        v = vn; g = gn; cur ^= 1; first = false;
#else
        v = vn; g = gn; cur ^= 1; selv = selv_n; qv[0] = qv_n[0]; qv[1] = qv_n[1]; qv[2] = qv_n[2]; qv[3] = qv_n[3];
#endif
    }
    }
    asm volatile("s_waitcnt vmcnt(0)" ::: "memory");
#undef SP_POP_BLOCKING
#undef SP_PREFETCH
#undef SP_CHUNK_DMA
#undef SP_ROWS
#undef SP_ISSUE
#undef SP_VSWZ
}
struct TileQKVA { bf16* out; float s8;
    __device__ __forceinline__ pg8::HeadTile operator()(int pn) const { const int gw = pn >> 3, which = gw % 3, g = gw / 3;
        return pg8::HeadTile{out + ((size_t)(gw * 16 + 2 * (pn & 7)) * 2) * 8192 * 128, nullptr, A_IN, pn * 256, which < 2 ? 1 : 0, (which == 0 ? QSCALE : 1.f) * s8, nullptr, 2 * g}; } };
struct TileINB { bf16 *qb, *kb, *vb, *iql; float* ikw; int pn0; float s8;
    __device__ __forceinline__ pg8::HeadTile operator()(int pnl) const { const int pn = pnl + pn0;
        if (pn < 16) return pg8::HeadTile{qb, nullptr, 4096, pn * 256, 1, QSCALE * s8, nullptr, -1};
        if (pn < 20) return pg8::HeadTile{nullptr, nullptr, 1024, (pn - 16) * 256, 1, s8, (unsigned char*)kb, -1};
        if (pn < 24) return pg8::HeadTile{nullptr, nullptr, 1024, (pn - 20) * 256, 0, s8 * VF8_SCALE, (unsigned char*)vb, -1};
        if (pn < 28) return pg8::HeadTile{iql, nullptr, 1024, (pn - 24) * 256, 0, 1.f, nullptr, -1};
        return pg8::HeadTile{nullptr, ikw, 256, 0, 0, 1.f, nullptr, -1}; } };
struct TileIQ { bf16* out; __device__ __forceinline__ pg8::HeadTile operator()(int pn) const { return (IDX_F8 && !IDX_I8) ? pg8::HeadTile{nullptr, nullptr, 4096, pn * 256, 1, 1.f, (unsigned char*)out, -1} : pg8::HeadTile{out, nullptr, 4096, pn * 256, 1, 1.f, nullptr, -1}; } };

#ifndef SP2_I8
#define SP2_I8 true
#endif
#ifndef MK_PER_PHASE
#define MK_PER_PHASE 0
#endif
__global__ void __launch_bounds__(NWAVES * 64, 2) fwd(Args args) {
    extern __shared__ __attribute__((aligned(16))) unsigned char lds[];
    Frame F;
    F.lds = (LAS unsigned char*)lds;
    F.MISC = (volatile LAS unsigned*)(F.lds + MISC_OFF);
    F.tid = threadIdx.x; F.lane = F.tid & 63; F.wave = __builtin_amdgcn_readfirstlane(F.tid >> 6);
    F.G = gridDim.x; { const int bx = blockIdx.x; F.vcu = (F.G % 8 == 0) ? (bx % 8) * (F.G / 8) + bx / 8 : bx; }
    F.ws = args.ws; unsigned char* ws = args.ws;
    F.ctl = (gu32*)(ws + WS_CTL);
    for (int u = F.tid; u < (LDS_BYTES - LDSCTL_OFF) / 4; u += NWAVES * 64) ((LAS unsigned*)(F.lds + LDSCTL_OFF))[u] = 0u;
    __syncthreads();
    const int lo = args.ph_lo, hi = args.ph_hi;
    XcdBarrier bar; bar.bar = (unsigned*)(F.ctl + CW_BAR) + args.li * XCD_BAR_WORDS; bar.x = 0; bar.st = nullptr;
    if (hi - lo > 1) bar = xcd_barrier_post((unsigned*)(F.ctl + CW_BAR) + args.li * XCD_BAR_WORDS, F.MISC + 8);
#ifdef ONLY_PHASE
#define IN(k) ((k) == ONLY_PHASE && lo <= (k) && (k) < hi)
#else
#define IN(k) (lo <= (k) && (k) < hi)
#endif
#ifndef REPEAT_MASK
#define REPEAT_MASK 0
#endif
#define REP(k) ((((REPEAT_MASK) >> (k)) & 1) ? 2 : 1)
#ifdef BAR2
#define SEAM(k) do { if (IN(k) && IN((k) + 1)) { xcd_barrier(bar); xcd_barrier(bar); } } while (0)
#else
#define SEAM(k) do { if (IN(k) && IN((k) + 1)) xcd_barrier(bar); } while (0)
#endif
    const float* x = (const float*)args.in[0];
    const float* g_attn_pre = (const float*)args.in[2]; const float* g_attn_post = (const float*)args.in[3];
    const float* g_mlp_pre = (const float*)args.in[4]; const float* g_mlp_post = (const float*)args.in[5];
    bf16* XN = (bf16*)(ws + WS_XN); bf16* MIX = (bf16*)(ws + WS_MIX); unsigned char* HID = (unsigned char*)(ws + WS_HID);
    const float* rope = (const float*)(ws + WS_ROPE);
    float* out = args.out;
    bf16* HB = (bf16*)(ws + WS_HB);

    if (IN(0)) { { p0_prologue(F, args); } if (REP(0) == 2) { p0_prologue(F, args); } } SEAM(0);
#if QKVA_I8 || UP0_I8 || L1_I8 || WOUTA_I8 || IDXG_I8
    if (IN(0) && IN(1)) { p0b_quantize(F, args); xcd_barrier(bar); }
#endif
    if (IN(1)) { { pg8::Gemm g{XN, (const bf16*)(ws + WS_W_INA), M, A_IN, (QKVA_F8 || QKVA_I8) ? DM / 2 : DM}; pg8::StaticOrder S; S.init(M, A_IN, F.G, (int)blockIdx.x);
        pg8::EpiHead<TileQKVA> E{TileQKVA{(bf16*)(ws + WS_QKVA), QKVA_F8 ? 1.0f / WINA_SCALE : 1.0f}, rope, QKVA_I8 ? (const float*)(ws + WS_SROW) : nullptr, QKVA_I8 ? (const float*)(ws + WS_SCOL_INA) : nullptr};
        pg8::gemm_phase<pg8::EpiHead<TileQKVA>, pg8::StaticOrder, true, SP2_I8, (QKVA_I8 ? 2 : (QKVA_F8 ? 1 : 0))>(F.lds + RING_OFF, g, S, E); } if (REP(1) == 2) { pg8::Gemm g{XN, (const bf16*)(ws + WS_W_INA), M, A_IN, (QKVA_F8 || QKVA_I8) ? DM / 2 : DM}; pg8::StaticOrder S; S.init(M, A_IN, F.G, (int)blockIdx.x);
        pg8::EpiHead<TileQKVA> E{TileQKVA{(bf16*)(ws + WS_QKVA), QKVA_F8 ? 1.0f / WINA_SCALE : 1.0f}, rope, QKVA_I8 ? (const float*)(ws + WS_SROW) : nullptr, QKVA_I8 ? (const float*)(ws + WS_SCOL_INA) : nullptr};
        pg8::gemm_phase<pg8::EpiHead<TileQKVA>, pg8::StaticOrder, true, SP2_I8, (QKVA_I8 ? 2 : (QKVA_F8 ? 1 : 0))>(F.lds + RING_OFF, g, S, E); } } SEAM(1);
    if (IN(2)) { { dil_attn_phase(F); } if (REP(2) == 2) { dil_attn_phase(F); } } SEAM(2);
    if (IN(3)) { { merge_phase(F); } if (REP(3) == 2) { merge_phase(F); } } SEAM(3);
    if (IN(4)) { { pg8::Gemm g{(const bf16*)(ws + WS_OMERGE), (const bf16*)(ws + WS_W_OUTA), M, DM, WOUTA_I8 ? A_OUT / 2 : A_OUT}; pg8::StaticOrder S; S.init(M, DM, F.G, (int)blockIdx.x, WGM_K2K);
        pg8::EpiBf16<0> E{MIX, DM, 1.0f, WOUTA_I8 ? (const float*)(ws + WS_SROW_OM) : nullptr, WOUTA_I8 ? (const float*)(ws + WS_SCOL_OUTA) : nullptr};
        pg8::gemm_phase<pg8::EpiBf16<0>, pg8::StaticOrder, true, true, (WOUTA_I8 ? 2 : 0)>(F.lds + RING_OFF, g, S, E); } if (REP(4) == 2) { pg8::Gemm g{(const bf16*)(ws + WS_OMERGE), (const bf16*)(ws + WS_W_OUTA), M, DM, WOUTA_I8 ? A_OUT / 2 : A_OUT}; pg8::StaticOrder S; S.init(M, DM, F.G, (int)blockIdx.x, WGM_K2K);
        pg8::EpiBf16<0> E{MIX, DM, 1.0f, WOUTA_I8 ? (const float*)(ws + WS_SROW_OM) : nullptr, WOUTA_I8 ? (const float*)(ws + WS_SCOL_OUTA) : nullptr};
        pg8::gemm_phase<pg8::EpiBf16<0>, pg8::StaticOrder, true, true, (WOUTA_I8 ? 2 : 0)>(F.lds + RING_OFF, g, S, E); } } SEAM(4);
    if (IN(5)) { { thin_resid<(UP0_I8 ? 3 : 0), false, true>(F, MIX, x, g_attn_post, HB, g_mlp_pre, XN, (unsigned char*)XN, (float*)(ws + WS_SROW)); } if (REP(5) == 2) { thin_resid<(UP0_I8 ? 3 : 0), false, true>(F, MIX, x, g_attn_post, HB, g_mlp_pre, XN, (unsigned char*)XN, (float*)(ws + WS_SROW)); } } SEAM(5);
    if (IN(6)) { { pg8::Gemm g{XN, (const bf16*)(ws + WS_W_UP), M, DFF, UP0_I8 ? DM / 2 : DM}; pg8::StaticOrder S; S.init(M, DFF, F.G, (int)blockIdx.x);
        const float* sr6 = UP0_I8 ? (const float*)(ws + WS_SROW) : nullptr; const float* sc6 = UP0_I8 ? (const float*)(ws + WS_SCOL_UP0) : nullptr;
#if DOWN0_F8
        pg8::EpiSqReluF8 E{HID, DFF, 1.0f, HID_SCALE, sr6, sc6};
        pg8::gemm_phase<pg8::EpiSqReluF8, pg8::StaticOrder, true, SP2_I8, (UP0_I8 ? 2 : 0)>(F.lds + RING_OFF, g, S, E);
#else
        pg8::EpiBf16<1> E{(bf16*)HID, DFF, 1.0f, sr6, sc6};
        pg8::gemm_phase<pg8::EpiBf16<1>, pg8::StaticOrder, true, SP2_I8, (UP0_I8 ? 2 : 0)>(F.lds + RING_OFF, g, S, E);
#endif
 } if (REP(6) == 2) { pg8::Gemm g{XN, (const bf16*)(ws + WS_W_UP), M, DFF, UP0_I8 ? DM / 2 : DM}; pg8::StaticOrder S; S.init(M, DFF, F.G, (int)blockIdx.x);
        const float* sr6 = UP0_I8 ? (const float*)(ws + WS_SROW) : nullptr; const float* sc6 = UP0_I8 ? (const float*)(ws + WS_SCOL_UP0) : nullptr;
#if DOWN0_F8
        pg8::EpiSqReluF8 E{HID, DFF, 1.0f, HID_SCALE, sr6, sc6};
        pg8::gemm_phase<pg8::EpiSqReluF8, pg8::StaticOrder, true, SP2_I8, (UP0_I8 ? 2 : 0)>(F.lds + RING_OFF, g, S, E);
#else
        pg8::EpiBf16<1> E{(bf16*)HID, DFF, 1.0f, sr6, sc6};
        pg8::gemm_phase<pg8::EpiBf16<1>, pg8::StaticOrder, true, SP2_I8, (UP0_I8 ? 2 : 0)>(F.lds + RING_OFF, g, S, E);
#endif
 } } SEAM(6);
    if (IN(7)) { {
#if DOWN0_F8
        pg8::Gemm g{(const bf16*)HID, (const bf16*)(ws + WS_W_DOWN), M, DM, DFF / 2}; pg8::StaticOrder S; S.init(M, DM, F.G, (int)blockIdx.x, WGM_K16K);
        pg8::EpiBf16<0> E{MIX, DM, 1.0f / (HID_SCALE * WDOWN_SCALE), nullptr, nullptr};
        pg8::gemm_phase<pg8::EpiBf16<0>, pg8::StaticOrder, true, true, true>(F.lds + RING_OFF, g, S, E);
#else
        pg8::Gemm g{(const bf16*)HID, (const bf16*)(ws + WS_W_DOWN), M, DM, DFF}; pg8::StaticOrder S; S.init(M, DM, F.G, (int)blockIdx.x, WGM_K16K);
        pg8::EpiBf16<0> E{MIX, DM, 1.0f, nullptr, nullptr};
        pg8::gemm_phase<pg8::EpiBf16<0>, pg8::StaticOrder, true, true>(F.lds + RING_OFF, g, S, E);
#endif
 } if (REP(7) == 2) {
#if DOWN0_F8
        pg8::Gemm g{(const bf16*)HID, (const bf16*)(ws + WS_W_DOWN), M, DM, DFF / 2}; pg8::StaticOrder S; S.init(M, DM, F.G, (int)blockIdx.x, WGM_K16K);
        pg8::EpiBf16<0> E{MIX, DM, 1.0f / (HID_SCALE * WDOWN_SCALE), nullptr, nullptr};
        pg8::gemm_phase<pg8::EpiBf16<0>, pg8::StaticOrder, true, true, true>(F.lds + RING_OFF, g, S, E);
#else
        pg8::Gemm g{(const bf16*)HID, (const bf16*)(ws + WS_W_DOWN), M, DM, DFF}; pg8::StaticOrder S; S.init(M, DM, F.G, (int)blockIdx.x, WGM_K16K);
        pg8::EpiBf16<0> E{MIX, DM, 1.0f, nullptr, nullptr};
        pg8::gemm_phase<pg8::EpiBf16<0>, pg8::StaticOrder, true, true>(F.lds + RING_OFF, g, S, E);
#endif
 } } SEAM(7);
    if (IN(8)) { { thin_resid<(L1_I8 ? 4 : (IDXG_I8 ? 5 : 2)), true, true>(F, MIX, HB, g_mlp_post, HB, g_attn_pre + DM, XN, (unsigned char*)(ws + WS_XN8), (float*)(ws + WS_SROW)); } if (REP(8) == 2) { thin_resid<(L1_I8 ? 4 : (IDXG_I8 ? 5 : 2)), true, true>(F, MIX, HB, g_mlp_post, HB, g_attn_pre + DM, XN, (unsigned char*)(ws + WS_XN8), (float*)(ws + WS_SROW)); } } SEAM(8);
    if (IN(9)) { { { pg8::Gemm g{(const bf16*)(ws + WS_XN8), (const bf16*)(ws + WS_W_INB), M, B_QKV, DM / 2}; pg8::StaticOrder S; S.init(M, B_QKV, F.G, (int)blockIdx.x);
          pg8::EpiHead<TileINB> E{TileINB{(bf16*)(ws + WS_QB), (bf16*)(ws + WS_KB), (bf16*)(ws + WS_VB), (bf16*)(ws + WS_IQL), (float*)(ws + WS_IKW), 0, L1_I8 ? 1.0f : 1.0f / WINB_SCALE}, rope, L1_I8 ? (const float*)(ws + WS_SROW) : nullptr, L1_I8 ? (const float*)(ws + WS_SCOL_INB) : nullptr};
          pg8::gemm_phase<pg8::EpiHead<TileINB>, pg8::StaticOrder, true, true, (L1_I8 ? 2 : 1)>(F.lds + RING_OFF, g, S, E); }
        { pg8::Gemm g{XN, (const bf16*)(ws + WS_W_INB2), M, B_IN_PAD - B_QKV, (IDXG_I8 && !L1_I8) ? DM / 2 : DM}; pg8::StaticOrder S; S.init(M, B_IN_PAD - B_QKV, F.G, (int)blockIdx.x);
          pg8::EpiHead<TileINB> E{TileINB{(bf16*)(ws + WS_QB), (bf16*)(ws + WS_KB), (bf16*)(ws + WS_VB), (bf16*)(ws + WS_IQL), (float*)(ws + WS_IKW), 24, 1.0f}, rope, (IDXG_I8 && !L1_I8) ? (const float*)(ws + WS_SROW) : nullptr, (IDXG_I8 && !L1_I8) ? (const float*)(ws + WS_SCOL_INB2) : nullptr};
          pg8::gemm_phase<pg8::EpiHead<TileINB>, pg8::StaticOrder, true, true, ((IDXG_I8 && !L1_I8) ? 2 : 0)>(F.lds + RING_OFF, g, S, E); }
#if P9_FILL
        if (LATE_CONV) { const int nb2 = (M / 256) * ((B_IN_PAD - B_QKV) / 256) - F.G, first_idle = (nb2 > 0 && nb2 < F.G) ? nb2 : 0;
            if ((int)blockIdx.x >= first_idle) { LAS float* scr_ = (LAS float*)(F.lds + RING_OFF + F.wave * 16384); const int NCW = (F.G - first_idle) * NWAVES; int li = ((int)blockIdx.x - first_idle) * NWAVES + F.wave;
                for (; li + 3 * NCW < LATE_P9; li += 4 * NCW) late_conv_batch<4>(F, args, scr_, li, NCW);
#pragma unroll 1
                for (; li < LATE_P9; li += NCW) late_conv_item(F, args, scr_, li); } }
#endif
        } if (REP(9) == 2) { { pg8::Gemm g{(const bf16*)(ws + WS_XN8), (const bf16*)(ws + WS_W_INB), M, B_QKV, DM / 2}; pg8::StaticOrder S; S.init(M, B_QKV, F.G, (int)blockIdx.x);
          pg8::EpiHead<TileINB> E{TileINB{(bf16*)(ws + WS_QB), (bf16*)(ws + WS_KB), (bf16*)(ws + WS_VB), (bf16*)(ws + WS_IQL), (float*)(ws + WS_IKW), 0, L1_I8 ? 1.0f : 1.0f / WINB_SCALE}, rope, L1_I8 ? (const float*)(ws + WS_SROW) : nullptr, L1_I8 ? (const float*)(ws + WS_SCOL_INB) : nullptr};
          pg8::gemm_phase<pg8::EpiHead<TileINB>, pg8::StaticOrder, true, true, (L1_I8 ? 2 : 1)>(F.lds + RING_OFF, g, S, E); }
        { pg8::Gemm g{XN, (const bf16*)(ws + WS_W_INB2), M, B_IN_PAD - B_QKV, (IDXG_I8 && !L1_I8) ? DM / 2 : DM}; pg8::StaticOrder S; S.init(M, B_IN_PAD - B_QKV, F.G, (int)blockIdx.x);
          pg8::EpiHead<TileINB> E{TileINB{(bf16*)(ws + WS_QB), (bf16*)(ws + WS_KB), (bf16*)(ws + WS_VB), (bf16*)(ws + WS_IQL), (float*)(ws + WS_IKW), 24, 1.0f}, rope, (IDXG_I8 && !L1_I8) ? (const float*)(ws + WS_SROW) : nullptr, (IDXG_I8 && !L1_I8) ? (const float*)(ws + WS_SCOL_INB2) : nullptr};
          pg8::gemm_phase<pg8::EpiHead<TileINB>, pg8::StaticOrder, true, true, ((IDXG_I8 && !L1_I8) ? 2 : 0)>(F.lds + RING_OFF, g, S, E); } } } SEAM(9);
    if (IN(10)) { { idx_prep_phase(F, args); } if (REP(10) == 2) { idx_prep_phase(F, args); } } SEAM(10);
    if (IN(11)) { { pg8::Gemm g{(const bf16*)(ws + WS_IQLN), (const bf16*)(ws + WS_W_IDX), M, 4096, IDXG_I8 ? IDX_RANK / 2 : IDX_RANK}; pg8::StaticOrder S; S.init(M, 4096, F.G, (int)blockIdx.x, WGM_K1K);
        pg8::EpiHead<TileIQ> E{TileIQ{(bf16*)(ws + WS_IQ)}, rope, IDXG_I8 ? (const float*)(ws + WS_SROW_IQ) : nullptr, IDXG_I8 ? (const float*)(ws + WS_SCOL_IDX) : nullptr};
        pg8::gemm_phase<pg8::EpiHead<TileIQ>, pg8::StaticOrder, true, true, (IDXG_I8 ? 2 : 0)>(F.lds + RING_OFF, g, S, E); } if (REP(11) == 2) { pg8::Gemm g{(const bf16*)(ws + WS_IQLN), (const bf16*)(ws + WS_W_IDX), M, 4096, IDXG_I8 ? IDX_RANK / 2 : IDX_RANK}; pg8::StaticOrder S; S.init(M, 4096, F.G, (int)blockIdx.x, WGM_K1K);
        pg8::EpiHead<TileIQ> E{TileIQ{(bf16*)(ws + WS_IQ)}, rope, IDXG_I8 ? (const float*)(ws + WS_SROW_IQ) : nullptr, IDXG_I8 ? (const float*)(ws + WS_SCOL_IDX) : nullptr};
        pg8::gemm_phase<pg8::EpiHead<TileIQ>, pg8::StaticOrder, true, true, (IDXG_I8 ? 2 : 0)>(F.lds + RING_OFF, g, S, E); } } SEAM(11);
    if (IN(12)) { { if (IDX_I8) idx_score_phase_i8(F); else if (IDX_F8) idx_score_phase_f8(F); else idx_score_phase(F); } if (REP(12) == 2) { if (IDX_I8) idx_score_phase_i8(F); else if (IDX_F8) idx_score_phase_f8(F); else idx_score_phase(F); } } SEAM(12);
    if (IN(13)) { { topk_phase(F, args); } if (REP(13) == 2) { topk_phase(F, args); } } SEAM(13);
    if (IN(14)) { { sparse_attn_phase(F, args); } if (REP(14) == 2) { sparse_attn_phase(F, args); } } SEAM(14);
    if (IN(15)) { { pg8::Gemm g{(const bf16*)(ws + WS_OB), (const bf16*)(ws + WS_W_OUTB), M, DM, 4096 / 2}; pg8::StaticOrder S; S.init(M, DM, F.G, (int)blockIdx.x);
        pg8::EpiBf16<0> E{MIX, DM, 1.0f / (OB_SCALE * WOUTB_SCALE), nullptr, nullptr};
        pg8::gemm_phase<pg8::EpiBf16<0>, pg8::StaticOrder, true, true, true>(F.lds + RING_OFF, g, S, E); } if (REP(15) == 2) { pg8::Gemm g{(const bf16*)(ws + WS_OB), (const bf16*)(ws + WS_W_OUTB), M, DM, 4096 / 2}; pg8::StaticOrder S; S.init(M, DM, F.G, (int)blockIdx.x);
        pg8::EpiBf16<0> E{MIX, DM, 1.0f / (OB_SCALE * WOUTB_SCALE), nullptr, nullptr};
        pg8::gemm_phase<pg8::EpiBf16<0>, pg8::StaticOrder, true, true, true>(F.lds + RING_OFF, g, S, E); } } SEAM(15);
    if (IN(16)) { { thin_resid<(L1_I8 ? 3 : 1), true, true>(F, MIX, HB, g_attn_post + DM, HB, g_mlp_pre + DM, XN, (unsigned char*)XN, (float*)(ws + WS_SROW)); } if (REP(16) == 2) { thin_resid<(L1_I8 ? 3 : 1), true, true>(F, MIX, HB, g_attn_post + DM, HB, g_mlp_pre + DM, XN, (unsigned char*)XN, (float*)(ws + WS_SROW)); } } SEAM(16);
    if (IN(17)) { { pg8::Gemm g{XN, (const bf16*)(ws + WS_W_UP1), M, DFF, DM / 2}; pg8::StaticOrder S; S.init(M, DFF, F.G, (int)blockIdx.x);
        pg8::EpiSqReluF8 E{HID, DFF, L1_I8 ? 1.0f : 1.0f / WUP_SCALE, HID_SCALE, L1_I8 ? (const float*)(ws + WS_SROW) : nullptr, L1_I8 ? (const float*)(ws + WS_SCOL_UP1) : nullptr};
        pg8::gemm_phase<pg8::EpiSqReluF8, pg8::StaticOrder, true, true, (L1_I8 ? 2 : 1)>(F.lds + RING_OFF, g, S, E); } if (REP(17) == 2) { pg8::Gemm g{XN, (const bf16*)(ws + WS_W_UP1), M, DFF, DM / 2}; pg8::StaticOrder S; S.init(M, DFF, F.G, (int)blockIdx.x);
        pg8::EpiSqReluF8 E{HID, DFF, L1_I8 ? 1.0f : 1.0f / WUP_SCALE, HID_SCALE, L1_I8 ? (const float*)(ws + WS_SROW) : nullptr, L1_I8 ? (const float*)(ws + WS_SCOL_UP1) : nullptr};
        pg8::gemm_phase<pg8::EpiSqReluF8, pg8::StaticOrder, true, true, (L1_I8 ? 2 : 1)>(F.lds + RING_OFF, g, S, E); } } SEAM(17);
    if (IN(18)) { { pg8::Gemm g{(const bf16*)HID, (const bf16*)(ws + WS_W_DOWN1), M, DM, DFF / 2}; pg8::StaticOrder S; S.init(M, DM, F.G, (int)blockIdx.x, WGM_K16K);
        pg8::EpiBf16<0> E{MIX, DM, 1.0f / (HID_SCALE * WDOWN_SCALE), nullptr, nullptr};
        pg8::gemm_phase<pg8::EpiBf16<0>, pg8::StaticOrder, true, true, true>(F.lds + RING_OFF, g, S, E); } if (REP(18) == 2) { pg8::Gemm g{(const bf16*)HID, (const bf16*)(ws + WS_W_DOWN1), M, DM, DFF / 2}; pg8::StaticOrder S; S.init(M, DM, F.G, (int)blockIdx.x, WGM_K16K);
        pg8::EpiBf16<0> E{MIX, DM, 1.0f / (HID_SCALE * WDOWN_SCALE), nullptr, nullptr};
        pg8::gemm_phase<pg8::EpiBf16<0>, pg8::StaticOrder, true, true, true>(F.lds + RING_OFF, g, S, E); } } SEAM(18);
    if (IN(19)) { { thin_resid<0, true, false>(F, MIX, HB, g_mlp_post + DM, out, nullptr, nullptr, nullptr); } if (REP(19) == 2) { thin_resid<0, true, false>(F, MIX, HB, g_mlp_post + DM, out, nullptr, nullptr, nullptr); } }
#undef IN
#undef SEAM
}

extern "C" void kernel_launch(void* const* d_in, const int* in_sizes, int n_in, void* d_out, int out_size, void* d_ws, size_t ws_size, hipStream_t stream) {
    static int grid = 0;
    if (grid == 0) {
        if (n_in != 16 || in_sizes[0] != M * DM || out_size != M * DM || ws_size < WS_END) { fprintf(stderr, "kernel_launch: unexpected shapes (n_in %d, in0 %d, out %d, ws %zu)\n", n_in, n_in > 0 ? in_sizes[0] : -1, out_size, ws_size); grid = -1; return; }
        int dev = 0, cus = 0, per_cu = 0;
        if (hipGetDevice(&dev) != hipSuccess || hipDeviceGetAttribute(&cus, hipDeviceAttributeMultiprocessorCount, dev) != hipSuccess) { grid = -1; return; }
        if (hipFuncSetAttribute((const void*)fwd, hipFuncAttributeMaxDynamicSharedMemorySize, LDS_BYTES) != hipSuccess) { fprintf(stderr, "kernel_launch: hipFuncSetAttribute failed\n"); grid = -1; return; }
        if (hipOccupancyMaxActiveBlocksPerMultiprocessor(&per_cu, (const void*)fwd, NWAVES * 64, LDS_BYTES) != hipSuccess || per_cu < 1) fprintf(stderr, "kernel_launch: occupancy query reports %d\n", per_cu);
        (void)hipGetLastError();
        grid = cus;
    }
    if (grid < 0) return;
    if (hipMemsetAsync((char*)d_ws + WS_CTL, 0, CTL_ZERO_BYTES, stream) != hipSuccess) return;
    Args a{};
    for (int i = 0; i < 16; ++i) a.in[i] = d_in[i];
    a.out = (float*)d_out; a.ws = (unsigned char*)d_ws; a.pad = 0;
#if MK_PER_PHASE
#ifndef LAST_PHASE
#define LAST_PHASE N_PHASES
#endif
    for (int li = 0; li < LAST_PHASE; ++li) { a.ph_lo = li; a.ph_hi = li + 1; a.li = li;
        hipLaunchKernelGGL(fwd, dim3(grid), dim3(NWAVES * 64), LDS_BYTES, stream, a); }
#else
    a.ph_lo = 0; a.ph_hi = N_PHASES; a.li = 0;
    hipLaunchKernelGGL(fwd, dim3(grid), dim3(NWAVES * 64), LDS_BYTES, stream, a);
#endif
}
```

```cpp
#include <hip/hip_runtime.h>
#include <cstdio>
#include <cstdint>
#ifndef I8_KOUTER
#define I8_KOUTER 0
#endif
#ifndef PG8_SKEW
#define PG8_SKEW 1
#endif
#ifndef PG8_B_NT
#define PG8_B_NT 0
#endif
#ifndef EPI_NT
#define EPI_NT 0
#endif
#ifndef PG8_WGM
#define PG8_WGM 4
#endif
namespace pg8 {
#define PG8_LAS __attribute__((address_space(3)))
typedef unsigned short bf16_t;
typedef short bf16x8 __attribute__((ext_vector_type(8)));
typedef float f32x4 __attribute__((ext_vector_type(4)));
typedef unsigned u32x4 __attribute__((ext_vector_type(4)));
constexpr int BM = 256, BK = 64, HALF = 128, HTB = HALF * BK * 2  , STAGE_BYTES = 8 * HTB, NXCD = 8, WGM = PG8_WGM;

__host__ __device__ __forceinline__ int lds_byte(int r, int c) { const int st = (r >> 4) * 2 + (c >> 5), rr = r & 15, cc = c & 31, ob = rr * 64 + cc * 2; return st * 1024 + (ob ^ (((ob >> 9) & 1) << 5)); }
__host__ __device__ __forceinline__ void stage_rc(int b, int& R, int& C) { const int st = b / 1024, sb = b % 1024, swz = sb ^ (((sb >> 9) & 1) << 5); R = (st >> 1) * 16 + swz / 64; C = (st & 1) * 32 + (swz % 64) / 2; }
__host__ __device__ __forceinline__ int perm32(int rho) { const int n = rho >> 4, i = rho & 15; return 8 * (i >> 2) + 4 * n + (i & 3); }

struct Unit { int pm, pn; };
struct Gemm { const bf16_t* A; const bf16_t* Bt; int M, N, K; };

struct StaticOrder {
    int nM, nN, nwg, G, c, wgm;
    __host__ __device__ void init(int M, int N, int G_, int c_, int wgm_ = WGM) { nM = M / BM; nN = N / BM; nwg = nM * nN; G = G_; c = c_; wgm = wgm_; }
    __host__ __device__ bool next(int i, Unit& u) const {
        const long L = (long)i * G + c; if (L >= nwg) return false;
        int wgid = (int)L; { const int q = nwg / NXCD, r = nwg % NXCD, xcd = wgid % NXCD, off = wgid / NXCD; wgid = (xcd < r ? xcd * (q + 1) : r * (q + 1) + (xcd - r) * q) + off; }
        const int nig = wgm * nN, gid = wgid / nig, fm = gid * wgm, gsz = (nM - fm) < wgm ? (nM - fm) : wgm;
        u.pm = fm + ((wgid % nig) % gsz); u.pn = (wgid % nig) / gsz;
        if (PG8_SKEW && nwg % NXCD == 0 && nM % NXCD == 0 && (nM / NXCD) % wgm == 0 && G % NXCD == 0) { const int xcd = (int)(L % NXCD); u.pn = (u.pn + xcd * nN / NXCD) % nN; }
        return true;
    }
    __device__ __forceinline__ void a_ready(const Unit&) const {}
    __device__ __forceinline__ void done(const Unit&) const {}
};
typedef int v4i_t __attribute__((ext_vector_type(4))); typedef int v8i_t __attribute__((ext_vector_type(8)));

typedef float f32x2_t __attribute__((ext_vector_type(2))); typedef __bf16 bf16x2_t __attribute__((ext_vector_type(2)));
__device__ __forceinline__ unsigned cvt_pk_bf16(float lo, float hi) { const f32x2_t v = {lo, hi}; const bf16x2_t b = __builtin_convertvector(v, bf16x2_t); return __builtin_bit_cast(unsigned, b); }

struct EpiF32 {
    static constexpr bool PERM = false, AFTER_DRAIN = false;
    float* C; int ldc;
    __device__ __forceinline__ void operator()(const f32x4 (&acc)[2][2][4][2], const Unit& u, int wr, int wc, int fr, int fq) const {
        const int row0 = u.pm * BM + wr * 64 + fr, col0 = u.pn * BM + wc * 32 + 4 * fq;
#pragma unroll
        for (int ai = 0; ai < 2; ++ai)
#pragma unroll
            for (int m = 0; m < 4; ++m) { float* rowp = C + (size_t)(row0 + ai * HALF + m * 16) * ldc + col0;
#pragma unroll
                for (int bj = 0; bj < 2; ++bj)
#pragma unroll
                    for (int n = 0; n < 2; ++n) *(f32x4*)(rowp + bj * HALF + n * 16) = acc[ai][bj][m][n]; }
    }
};
template <int ACT> struct EpiBf16 {
    static constexpr bool PERM = true, AFTER_DRAIN = false;
    bf16_t* O; int ldc; float scale; const float* srow; const float* scol;
    __device__ __forceinline__ void operator()(const f32x4 (&acc)[2][2][4][2], const Unit& u, int wr, int wc, int fr, int fq) const {
        const int row0 = u.pm * BM + wr * 64 + fr, col0 = u.pn * BM + wc * 32 + 8 * fq;
#pragma unroll
        for (int ai = 0; ai < 2; ++ai)
#pragma unroll
            for (int m = 0; m < 4; ++m) { bf16_t* rowp = O + (size_t)(row0 + ai * HALF + m * 16) * ldc + col0;
#pragma unroll
                for (int bj = 0; bj < 2; ++bj) { f32x4 v0 = acc[ai][bj][m][0], v1 = acc[ai][bj][m][1];
                    if (srow) { const float sr = srow[row0 + ai * HALF + m * 16]; const float* scp = scol + col0 + bj * HALF;
                        v0 = __builtin_convertvector(__builtin_bit_cast(v4i_t, v0), f32x4) * (*(const f32x4*)(scp) * sr); v1 = __builtin_convertvector(__builtin_bit_cast(v4i_t, v1), f32x4) * (*(const f32x4*)(scp + 4) * sr); }
                    v0 = v0 * scale; v1 = v1 * scale;
#pragma unroll
                    for (int j = 0; j < 4; ++j) { if (ACT == 1) { const float a = fmaxf(v0[j], 0.f), b = fmaxf(v1[j], 0.f); v0[j] = a * a; v1[j] = b * b; } }
                    u32x4 w; w.x = cvt_pk_bf16(v0[0], v0[1]); w.y = cvt_pk_bf16(v0[2], v0[3]); w.z = cvt_pk_bf16(v1[0], v1[1]); w.w = cvt_pk_bf16(v1[2], v1[3]);
                    if (EPI_NT == 1) __builtin_nontemporal_store(w, (u32x4*)(rowp + bj * HALF)); else *(u32x4*)(rowp + bj * HALF) = w; } }
    }
};
struct EpiSqReluF8 {
    static constexpr bool PERM = true, AFTER_DRAIN = false;
    unsigned char* O; int ldc; float pre, scale; const float* srow; const float* scol;
    __device__ __forceinline__ void operator()(const f32x4 (&acc)[2][2][4][2], const Unit& u, int wr, int wc, int fr, int fq) const {
        const int row0 = u.pm * BM + wr * 64 + fr, col0 = u.pn * BM + wc * 32 + 8 * fq;
#pragma unroll
        for (int ai = 0; ai < 2; ++ai)
#pragma unroll
            for (int m = 0; m < 4; ++m) { unsigned char* rowp = O + (size_t)(row0 + ai * HALF + m * 16) * ldc + col0;
#pragma unroll
                for (int bj = 0; bj < 2; ++bj) { f32x4 v0 = acc[ai][bj][m][0], v1 = acc[ai][bj][m][1];
                    if (srow) { const float sr = srow[row0 + ai * HALF + m * 16]; const float* scp = scol + col0 + bj * HALF;
                        v0 = __builtin_convertvector(__builtin_bit_cast(v4i_t, v0), f32x4) * (*(const f32x4*)(scp) * sr); v1 = __builtin_convertvector(__builtin_bit_cast(v4i_t, v1), f32x4) * (*(const f32x4*)(scp + 4) * sr); }
#pragma unroll
                    for (int j = 0; j < 4; ++j) { const float a = fmaxf(v0[j] * pre, 0.f), b = fmaxf(v1[j] * pre, 0.f); v0[j] = fminf(a * a * scale, 448.f); v1[j] = fminf(b * b * scale, 448.f); }
                    int p0 = 0, p1 = 0;
                    p0 = __builtin_amdgcn_cvt_pk_fp8_f32(v0[0], v0[1], p0, false); p0 = __builtin_amdgcn_cvt_pk_fp8_f32(v0[2], v0[3], p0, true);
                    p1 = __builtin_amdgcn_cvt_pk_fp8_f32(v1[0], v1[1], p1, false); p1 = __builtin_amdgcn_cvt_pk_fp8_f32(v1[2], v1[3], p1, true);
                    { const unsigned long long pv_ = (unsigned long long)(unsigned)p0 | ((unsigned long long)(unsigned)p1 << 32); if (EPI_NT) __builtin_nontemporal_store(pv_, (unsigned long long*)(rowp + bj * HALF)); else *(unsigned long long*)(rowp + bj * HALF) = pv_; } } }
    }
};
struct HeadTile { bf16_t* out; float* outf; int ldc; int col; int rope; float scale; unsigned char* out8; int hm_lg; };
template <class TileFn> struct EpiHead {
    static constexpr bool PERM = true, AFTER_DRAIN = false;
    TileFn fn; const float* rope; const float* srow; const float* scol;
    __device__ __forceinline__ void operator()(const f32x4 (&acc)[2][2][4][2], const Unit& u, int wr, int wc, int fr, int fq) const {
        const HeadTile t = fn(u.pn);
        const int row0 = u.pm * BM + wr * 64 + fr;
        const int dlo = 32 * (wc & 1) + 8 * fq;
        const int ncol = t.col + 128 * (wc >> 1) + dlo;
#pragma unroll
        for (int ai = 0; ai < 2; ++ai)
#pragma unroll
            for (int m = 0; m < 4; ++m) { const int row = row0 + ai * HALF + m * 16;
                f32x4 lo0 = acc[ai][0][m][0], lo1 = acc[ai][0][m][1], hi0 = acc[ai][1][m][0], hi1 = acc[ai][1][m][1];
                if (srow) { const float sr = srow[row]; const float* scp = scol + u.pn * BM + wc * 32 + 8 * fq;
                    const f32x4 c0 = *(const f32x4*)(scp) * sr, c1 = *(const f32x4*)(scp + 4) * sr, c2 = *(const f32x4*)(scp + HALF) * sr, c3 = *(const f32x4*)(scp + HALF + 4) * sr;
                    lo0 = __builtin_convertvector(__builtin_bit_cast(v4i_t, lo0), f32x4) * c0; lo1 = __builtin_convertvector(__builtin_bit_cast(v4i_t, lo1), f32x4) * c1;
                    hi0 = __builtin_convertvector(__builtin_bit_cast(v4i_t, hi0), f32x4) * c2; hi1 = __builtin_convertvector(__builtin_bit_cast(v4i_t, hi1), f32x4) * c3; }
                if (t.rope) { const float* rp = rope + (size_t)row * 128 + dlo;
                    const f32x4 c0 = *(const f32x4*)(rp), c1 = *(const f32x4*)(rp + 4), s0 = *(const f32x4*)(rp + 64), s1 = *(const f32x4*)(rp + 68);
                    const f32x4 a0 = lo0 * c0 - hi0 * s0, a1 = lo1 * c1 - hi1 * s1, b0 = hi0 * c0 + lo0 * s0, b1 = hi1 * c1 + lo1 * s1;
                    lo0 = a0; lo1 = a1; hi0 = b0; hi1 = b1; }
                lo0 = lo0 * t.scale; lo1 = lo1 * t.scale; hi0 = hi0 * t.scale; hi1 = hi1 * t.scale;
                if (t.outf) { float* p = t.outf + (size_t)row * t.ldc + ncol;
                    *(f32x4*)(p) = lo0; *(f32x4*)(p + 4) = lo1; *(f32x4*)(p + 64) = hi0; *(f32x4*)(p + 68) = hi1; }
                else if (t.out8) { unsigned char* p = t.out8 + (size_t)row * t.ldc + ncol;
                    int a0 = 0, a1 = 0, b0 = 0, b1 = 0;
                    a0 = __builtin_amdgcn_cvt_pk_fp8_f32(lo0[0], lo0[1], a0, false); a0 = __builtin_amdgcn_cvt_pk_fp8_f32(lo0[2], lo0[3], a0, true); a1 = __builtin_amdgcn_cvt_pk_fp8_f32(lo1[0], lo1[1], a1, false); a1 = __builtin_amdgcn_cvt_pk_fp8_f32(lo1[2], lo1[3], a1, true);
                    b0 = __builtin_amdgcn_cvt_pk_fp8_f32(hi0[0], hi0[1], b0, false); b0 = __builtin_amdgcn_cvt_pk_fp8_f32(hi0[2], hi0[3], b0, true); b1 = __builtin_amdgcn_cvt_pk_fp8_f32(hi1[0], hi1[1], b1, false); b1 = __builtin_amdgcn_cvt_pk_fp8_f32(hi1[2], hi1[3], b1, true);
                    *(unsigned long long*)(p) = (unsigned long long)(unsigned)a0 | ((unsigned long long)(unsigned)a1 << 32); *(unsigned long long*)(p + 64) = (unsigned long long)(unsigned)b0 | ((unsigned long long)(unsigned)b1 << 32); }
                else { bf16_t* p = t.out + (size_t)row * t.ldc + ncol;
                    if (t.hm_lg >= 0) { const int s_ = row & 8191, b_ = row >> 13, pr_ = (s_ & ((1 << t.hm_lg) - 1)) * (8192 >> t.hm_lg) + (s_ >> t.hm_lg);
                        p = t.out + ((size_t)((wc >> 1) * 2 + b_) * 8192 + pr_) * 128 + dlo; }
                    u32x4 w; w.x = cvt_pk_bf16(lo0[0], lo0[1]); w.y = cvt_pk_bf16(lo0[2], lo0[3]); w.z = cvt_pk_bf16(lo1[0], lo1[1]); w.w = cvt_pk_bf16(lo1[2], lo1[3]);
                    *(u32x4*)(p) = w;
                    w.x = cvt_pk_bf16(hi0[0], hi0[1]); w.y = cvt_pk_bf16(hi0[2], hi0[3]); w.z = cvt_pk_bf16(hi1[0], hi1[1]); w.w = cvt_pk_bf16(hi1[2], hi1[3]);
                    *(u32x4*)(p + 64) = w; } }
    }
};

__device__ __forceinline__ v8i_t pg8_cat(bf16x8 a, bf16x8 b) { return __builtin_shufflevector(__builtin_bit_cast(v4i_t, a), __builtin_bit_cast(v4i_t, b), 0, 1, 2, 3, 4, 5, 6, 7); }
template <class Epi, class Sched, bool ALIGN_EPI = false, bool SP2 = false, int MODE = 0>
__device__ __forceinline__ void gemm_phase(PG8_LAS unsigned char* lds, const Gemm g, const Sched& S, const Epi& E) {
    const int tid = threadIdx.x, wid = __builtin_amdgcn_readfirstlane(tid >> 6), lane = tid & 63, wr = wid >> 2, wc = wid & 3, fr = lane & 15, fq = lane >> 4;
    const int K = g.K, nt = K / BK;
    unsigned voffA[2], voffB[2];
#pragma unroll
    for (int i = 0; i < 2; ++i) { int R, C; stage_rc(tid * 16 + i * 8192, R, C); const int Rb = Epi::PERM ? ((R & ~31) + perm32(R & 31)) : R;
        voffA[i] = (unsigned)(R * K + C) * 2u; voffB[i] = (unsigned)(Rb * K + C) * 2u; }
    const size_t kstep = (size_t)(BK * 2);
    const size_t hstep = (size_t)HALF * K * 2;
    const size_t tstep = 2 * hstep;
    const unsigned ldsw = (unsigned)wid * 1024u;
    const int aoff = lds_byte(wr * 64 + fr, fq * 8), boff = lds_byte(wc * 32 + fr, fq * 8);
#define PG8_SA(b, h) (((b) * 2 + (h)) * HTB)
#define PG8_SB(b, h) ((4 + (b) * 2 + (h)) * HTB)
#define PG8_STAGE(bufoff, gbase, voff) do { _Pragma("unroll") for (int _i = 0; _i < 2; ++_i) { \
        if ((bufoff) >= 4 * HTB && PG8_B_NT) __builtin_amdgcn_global_load_lds((const unsigned*)((const char*)(gbase) + (voff)[_i]), (PG8_LAS unsigned*)(lds + (bufoff) + ldsw + _i * 8192), 16, 0, 2); \
        else __builtin_amdgcn_global_load_lds((const unsigned*)((const char*)(gbase) + (voff)[_i]), (PG8_LAS unsigned*)(lds + (bufoff) + ldsw + _i * 8192), 16, 0, 0); } } while (0)
#define PG8_LDA(dst, b, h) do { _Pragma("unroll") for (int m = 0; m < 4; ++m) _Pragma("unroll") for (int k = 0; k < 2; ++k) dst[m][k] = *(const PG8_LAS bf16x8*)(lds + PG8_SA(b, h) + aoff + m * 2048 + k * 1024); } while (0)
#define PG8_LDB(dst, b, h) do { _Pragma("unroll") for (int n = 0; n < 2; ++n) _Pragma("unroll") for (int k = 0; k < 2; ++k) dst[n][k] = *(const PG8_LAS bf16x8*)(lds + PG8_SB(b, h) + boff + n * 2048 + k * 1024); } while (0)
#define PG8_MMA(ai, bj, At, Bt) do { __builtin_amdgcn_s_setprio(1); \
        if constexpr (MODE == 2 && I8_KOUTER) { _Pragma("unroll") for (int k = 0; k < 2; ++k) _Pragma("unroll") for (int m = 0; m < 4; ++m) _Pragma("unroll") for (int n = 0; n < 2; ++n) \
            acc[ai][bj][m][n] = __builtin_bit_cast(f32x4, __builtin_amdgcn_mfma_i32_16x16x64_i8(__builtin_bit_cast(v4i_t, Bt[n][k]), __builtin_bit_cast(v4i_t, At[m][k]), __builtin_bit_cast(v4i_t, acc[ai][bj][m][n]), 0, 0, 0)); } \
        else _Pragma("unroll") for (int m = 0; m < 4; ++m) _Pragma("unroll") for (int n = 0; n < 2; ++n) { \
        if constexpr (MODE == 1) { const v8i_t b8_ = pg8_cat(Bt[n][0], Bt[n][1]), a8_ = pg8_cat(At[m][0], At[m][1]); asm volatile("v_mfma_f32_16x16x128_f8f6f4 %0, %1, %2, %0" : "+v"(acc[ai][bj][m][n]) : "v"(b8_), "v"(a8_)); } \
        else if constexpr (MODE == 2) { _Pragma("unroll") for (int k = 0; k < 2; ++k) acc[ai][bj][m][n] = __builtin_bit_cast(f32x4, __builtin_amdgcn_mfma_i32_16x16x64_i8(__builtin_bit_cast(v4i_t, Bt[n][k]), __builtin_bit_cast(v4i_t, At[m][k]), __builtin_bit_cast(v4i_t, acc[ai][bj][m][n]), 0, 0, 0)); } \
        else { _Pragma("unroll") for (int k = 0; k < 2; ++k) acc[ai][bj][m][n] = __builtin_amdgcn_mfma_f32_16x16x32_bf16(Bt[n][k], At[m][k], acc[ai][bj][m][n], 0, 0, 0); } } __builtin_amdgcn_s_setprio(0); } while (0)
#define PG8_WAIT_V(n) asm volatile("s_waitcnt vmcnt(" #n ")" ::: "memory")
#define PG8_WAIT_L(n) asm volatile("s_waitcnt lgkmcnt(" #n ")" ::: "memory")
#define PG8_BAR __builtin_amdgcn_s_barrier()
#define PG8_SCHED __builtin_amdgcn_sched_barrier(0)
    Unit cur, nxt; int ui = 0;
    if (!S.next(0, cur)) return;
    f32x4 acc[2][2][4][2];
#pragma unroll
    for (int a = 0; a < 2; ++a)
#pragma unroll
        for (int b = 0; b < 2; ++b)
#pragma unroll
            for (int m = 0; m < 4; ++m)
#pragma unroll
                for (int n = 0; n < 2; ++n) acc[a][b][m][n] = (f32x4){0.f, 0.f, 0.f, 0.f};
    bf16x8 At[4][2], B0[2][2], B1[2][2];
    const char* cA = (const char*)g.A + (size_t)cur.pm * tstep; const char* cB = (const char*)g.Bt + (size_t)cur.pn * tstep;
    S.a_ready(cur);
    if constexpr (SP2) {
        PG8_STAGE(PG8_SB(0, 0), cB, voffB); PG8_STAGE(PG8_SB(0, 1), cB + hstep, voffB); PG8_STAGE(PG8_SA(0, 0), cA, voffA); PG8_STAGE(PG8_SA(0, 1), cA + hstep, voffA);
        if (wr == 1) PG8_BAR;
        PG8_WAIT_V(2); PG8_BAR;
        PG8_STAGE(PG8_SB(1, 0), cB + kstep, voffB); PG8_STAGE(PG8_SA(1, 0), cA + kstep, voffA); PG8_STAGE(PG8_SB(1, 1), cB + hstep + kstep, voffB);
        PG8_WAIT_V(6); PG8_BAR;
    } else {
        PG8_STAGE(PG8_SB(0, 0), cB, voffB); PG8_STAGE(PG8_SA(0, 0), cA, voffA); PG8_STAGE(PG8_SB(0, 1), cB + hstep, voffB); PG8_STAGE(PG8_SA(0, 1), cA + hstep, voffA);
        if (wr == 1) PG8_BAR;
        PG8_WAIT_V(4); PG8_BAR;
        PG8_STAGE(PG8_SB(1, 0), cB + kstep, voffB); PG8_STAGE(PG8_SA(1, 0), cA + kstep, voffA); PG8_STAGE(PG8_SB(1, 1), cB + hstep + kstep, voffB);
        PG8_WAIT_V(6); PG8_BAR;
    }
    for (;;) {
        const bool has_next = S.next(ui + 1, nxt);
        const char* nA = has_next ? (const char*)g.A + (size_t)nxt.pm * tstep : cA; const char* nB = has_next ? (const char*)g.Bt + (size_t)nxt.pn * tstep : cB;
        for (int t = 0; t < nt; t += 2) {
            const bool last = (t == nt - 2);
            const char* a1 = cA + (size_t)(t + 1) * kstep;
            const char* a2 = last ? nA : cA + (size_t)(t + 2) * kstep; const char* b2 = last ? nB : cB + (size_t)(t + 2) * kstep;
            const char* a3 = a2 + kstep; const char* b3 = b2 + kstep;
            if (last && has_next) S.a_ready(nxt);
            if constexpr (SP2) {
            PG8_LDB(B0, 0, 0); PG8_LDB(B1, 0, 1); PG8_SCHED; PG8_LDA(At, 0, 0); PG8_STAGE(PG8_SA(1, 1), a1 + hstep, voffA);
            PG8_WAIT_V(8); PG8_WAIT_L(0); PG8_BAR; PG8_MMA(0, 0, At, B0); PG8_MMA(0, 1, At, B1); PG8_BAR; PG8_SCHED;
            PG8_LDA(At, 0, 1); PG8_STAGE(PG8_SB(0, 0), b2, voffB); PG8_STAGE(PG8_SB(0, 1), b2 + hstep, voffB); PG8_STAGE(PG8_SA(0, 0), a2, voffA);
            PG8_WAIT_V(8); PG8_WAIT_L(0); PG8_BAR; PG8_MMA(1, 0, At, B0); PG8_MMA(1, 1, At, B1); PG8_BAR; PG8_SCHED;
            PG8_LDB(B0, 1, 0); PG8_LDB(B1, 1, 1); PG8_SCHED; PG8_LDA(At, 1, 0); PG8_STAGE(PG8_SA(0, 1), a2 + hstep, voffA);
            PG8_WAIT_V(8); PG8_WAIT_L(0); PG8_BAR; PG8_MMA(0, 0, At, B0); PG8_MMA(0, 1, At, B1); PG8_BAR; PG8_SCHED;
            PG8_LDA(At, 1, 1); PG8_STAGE(PG8_SB(1, 0), b3, voffB); PG8_STAGE(PG8_SB(1, 1), b3 + hstep, voffB); PG8_STAGE(PG8_SA(1, 0), a3, voffA);
            PG8_WAIT_V(8); PG8_WAIT_L(0); PG8_BAR; PG8_MMA(1, 0, At, B0); PG8_MMA(1, 1, At, B1); PG8_BAR; PG8_SCHED;
            } else {
            PG8_LDB(B0, 0, 0); PG8_SCHED; PG8_LDA(At, 0, 0); PG8_STAGE(PG8_SA(1, 1), a1 + hstep, voffA);
            PG8_WAIT_L(8); PG8_BAR; PG8_WAIT_L(0); PG8_MMA(0, 0, At, B0); PG8_BAR; PG8_SCHED;
            PG8_LDB(B1, 0, 1); PG8_STAGE(PG8_SB(0, 0), b2, voffB);
            PG8_BAR; PG8_WAIT_L(0); PG8_MMA(0, 1, At, B1); PG8_BAR;
            PG8_LDA(At, 0, 1); PG8_STAGE(PG8_SA(0, 0), a2, voffA);
            PG8_BAR; PG8_WAIT_L(0); PG8_MMA(1, 0, At, B0); PG8_BAR; PG8_SCHED;
            PG8_STAGE(PG8_SB(0, 1), b2 + hstep, voffB);
            PG8_WAIT_V(6); PG8_BAR; PG8_MMA(1, 1, At, B1); PG8_BAR;
            PG8_LDB(B0, 1, 0); PG8_SCHED; PG8_LDA(At, 1, 0); PG8_STAGE(PG8_SA(0, 1), a2 + hstep, voffA);
            PG8_WAIT_L(8); PG8_BAR; PG8_WAIT_L(0); PG8_MMA(0, 0, At, B0); PG8_BAR; PG8_SCHED;
            PG8_LDB(B1, 1, 1); PG8_STAGE(PG8_SB(1, 0), b3, voffB);
            PG8_BAR; PG8_WAIT_L(0); PG8_MMA(0, 1, At, B1); PG8_BAR;
            PG8_LDA(At, 1, 1); PG8_STAGE(PG8_SA(1, 0), a3, voffA);
            PG8_BAR; PG8_WAIT_L(0); PG8_MMA(1, 0, At, B0); PG8_BAR; PG8_SCHED;
            PG8_STAGE(PG8_SB(1, 1), b3 + hstep, voffB);
            PG8_WAIT_V(6); PG8_BAR; PG8_MMA(1, 1, At, B1); PG8_BAR;
            }
        }
        if constexpr (ALIGN_EPI) { if (wr == 0) PG8_BAR; }
        if constexpr (!Epi::AFTER_DRAIN) { E(acc, cur, wr, wc, fr, fq); S.done(cur); }
        if (!has_next) break;
#pragma unroll
        for (int a = 0; a < 2; ++a)
#pragma unroll
            for (int b = 0; b < 2; ++b)
#pragma unroll
                for (int m = 0; m < 4; ++m)
#pragma unroll
                    for (int n = 0; n < 2; ++n) acc[a][b][m][n] = (f32x4){0.f, 0.f, 0.f, 0.f};
        cur = nxt; cA = nA; cB = nB; ++ui;
        if constexpr (ALIGN_EPI) { if (wr == 1) PG8_BAR; }
    }
    PG8_WAIT_V(0);
    if constexpr (!ALIGN_EPI) { if (wr == 0) PG8_BAR; }
    PG8_BAR;
    if constexpr (Epi::AFTER_DRAIN) { E.fused(acc, cur, wr, wc, fr, fq, lds, wid, lane); S.done(cur); }
#undef PG8_SA
#undef PG8_SB
#undef PG8_STAGE
#undef PG8_LDA
#undef PG8_LDB
#undef PG8_MMA
#undef PG8_WAIT_V
#undef PG8_WAIT_L
#undef PG8_BAR
#undef PG8_SCHED
}
}
#define GAS __attribute__((address_space(1)))
#define LAS __attribute__((address_space(3)))
#define CAS __attribute__((address_space(4)))
typedef unsigned short bf16;
typedef unsigned v4u __attribute__((ext_vector_type(4)));
typedef float f32x4 __attribute__((ext_vector_type(4)));
typedef short bf16x8 __attribute__((ext_vector_type(8)));
typedef GAS unsigned gu32;
typedef GAS unsigned long long gu64;
#define RLX_AGENT __ATOMIC_RELAXED, __HIP_MEMORY_SCOPE_AGENT
#define LDS_WAIT() asm volatile("s_waitcnt lgkmcnt(0)" ::: "memory")
#define VM_WAIT() asm volatile("s_waitcnt vmcnt(0)" ::: "memory")
__device__ __forceinline__ unsigned long long rt() { return __builtin_amdgcn_s_memrealtime(); }
__device__ __forceinline__ unsigned f2bf(float f) { unsigned u = __builtin_bit_cast(unsigned, f); return (u + 0x7fffu + ((u >> 16) & 1u)) >> 16; }
__device__ __forceinline__ unsigned pk2(float lo, float hi) { return f2bf(lo) | (f2bf(hi) << 16); }
#define XB_TMO      128
#define XB_XCNT(j)  (256  + 64 * (j))
#define XB_XSUB(j)  (1280 + 64 * (j))
#define XB_XGEN(j)  (2304 + 64 * (j))
#define XB_TOP      3328
#define XB_TOPGEN   3392
#define XCD_BAR_WORDS 3456
#define XB_SPIN_CAP (1u << 18)

__device__ __forceinline__ unsigned xb_ld(unsigned* p)              { return __hip_atomic_load(p, __ATOMIC_RELAXED, __HIP_MEMORY_SCOPE_AGENT); }
__device__ __forceinline__ unsigned xb_add(unsigned* p, unsigned v) { return __hip_atomic_fetch_add(p, v, __ATOMIC_RELAXED, __HIP_MEMORY_SCOPE_AGENT); }
__device__ __forceinline__ unsigned xb_xcc_id() { return (unsigned)__builtin_amdgcn_s_getreg((3 << 11) | 20) & 0xFu; }
#define XB_SPIN(cond, bar) do { unsigned _sp = 0; while (cond) { __builtin_amdgcn_s_sleep(1); \
    if ((++_sp & 255u) == 0u) { if (xb_ld(&(bar)[XB_TMO])) break; if (_sp > XB_SPIN_CAP) { atomicAdd(&(bar)[XB_TMO], 1u); break; } } } } while (0)

struct XcdBarrier {
    unsigned* bar; unsigned x;
    volatile LAS unsigned* st;
};

__device__ __forceinline__ XcdBarrier xcd_barrier_post(unsigned* bar, volatile LAS unsigned* st) {
    XcdBarrier b; b.bar = bar; b.x = xb_xcc_id(); b.st = st;
    if (threadIdx.x == 0) (void)xb_add(&bar[XB_XCNT(b.x)], 1u);
    return b;
}
__device__ __forceinline__ void xcd_barrier_complete(unsigned* bar, unsigned x, unsigned& nloc, unsigned& nx) {
    const unsigned G = gridDim.x * gridDim.y * gridDim.z;
    unsigned sum, cnt, mine, sp = 0u;
    for (;;) {
        sum = 0u; cnt = 0u; mine = 0u;
#pragma unroll
        for (unsigned j = 0; j < 16; ++j) { const unsigned c = xb_ld(&bar[XB_XCNT(j)]); sum += c; cnt += (c > 0u) ? 1u : 0u; mine = (j == x) ? c : mine; }
        if (sum == G) break;
        __builtin_amdgcn_s_sleep(1);
        if ((++sp & 255u) == 0u) { if (xb_ld(&bar[XB_TMO])) break; if (sp > XB_SPIN_CAP) { atomicAdd(&bar[XB_TMO], 1u); break; } }
    }
    nloc = mine > 0u ? mine : 1u; nx = cnt > 0u ? cnt : 1u;
}

__device__ __forceinline__ void xcd_barrier(const XcdBarrier& b) {
    asm volatile("s_waitcnt vmcnt(0)" ::: "memory");
    __syncthreads();
    if (threadIdx.x == 0) {
        unsigned* bar = b.bar;
        __builtin_amdgcn_s_waitcnt(0);
        unsigned nloc = b.st[0], nx = b.st[1];
        if (nloc == 0u) { xcd_barrier_complete(bar, b.x, nloc, nx); b.st[0] = nloc; b.st[1] = nx; }
        const unsigned old = xb_add(&bar[XB_XSUB(b.x)], 1u);
        const unsigned gen = old / nloc;
        if (old + 1u == (gen + 1u) * nloc) {
            __builtin_amdgcn_fence(__ATOMIC_RELEASE, "agent");
            asm volatile("s_waitcnt vmcnt(0)" ::: "memory");
            const unsigned og = xb_add(&bar[XB_TOP], 1u);
            const unsigned tg = og / nx;
            if (og + 1u == (tg + 1u) * nx) xb_add(&bar[XB_TOPGEN], 1u);
            else XB_SPIN(xb_ld(&bar[XB_TOPGEN]) == tg, bar);
            __builtin_amdgcn_fence(__ATOMIC_ACQUIRE, "agent");
            xb_add(&bar[XB_XGEN(b.x)], 1u);
            asm volatile("s_waitcnt vmcnt(0)" ::: "memory");
        } else {
            XB_SPIN(xb_ld(&bar[XB_XGEN(b.x)]) == gen, bar);
            __builtin_amdgcn_fence(__ATOMIC_ACQUIRE, "agent");
            asm volatile("s_waitcnt vmcnt(0)" ::: "memory");
        }
    }
    __syncthreads();
}
constexpr int NWAVES = 8;
constexpr int BATCH = 2, SEQ = 8192, DM = 4096, M = BATCH * SEQ, HD = 128;
constexpr int A_IN = 18432, A_OUT = 2048, A_HEADS = 16;
constexpr int B_IN = 7328, B_IN_PAD = 7424, B_QW = 4096, B_KVW = 1024, IDX_RANK = 1024, IDX_HEADS = 32, TOPK = 256;
constexpr int DFF = 16384;
constexpr float NORM_EPS = 1e-6f;
constexpr float QSCALE = 0.08838834764831845f;
constexpr float IWSCALE = 0.015625f;
constexpr float HID_SCALE = 4.0f, WDOWN_SCALE = 128.0f, WUP_SCALE = 64.0f, OB_SCALE = 32.0f, WOUTB_SCALE = 64.0f, WINB_SCALE = 64.0f;
constexpr float VF8_SCALE = 4.0f, PF8_SCALE = 256.0f;
#ifndef QKVA_F8
#define QKVA_F8 0
#endif
#ifndef QKVA_I8
#define QKVA_I8 1
#endif
#ifndef UP0_I8
#define UP0_I8 1
#endif
#ifndef SP_ASM
#define SP_ASM 1
#endif
#ifndef P9_FILL
#define P9_FILL 0
#endif
#ifndef MERGE2
#define MERGE2 0
#endif
#ifndef SP_LATE
#define SP_LATE 0
#endif
#ifndef TOPK_SPLIT
#define TOPK_SPLIT 1
#endif
#ifndef THIN_PF
#define THIN_PF 2
#endif
#ifndef P0_NT
#define P0_NT 1
#endif
#ifndef DIL_RUN
#define DIL_RUN 0
#endif
#ifndef DIL_STAGGER
#define DIL_STAGGER 1
#endif
#ifndef DIL_PIPE
#define DIL_PIPE 0
#endif
#ifndef TOPK_DESC
#define TOPK_DESC 1
#endif
#ifndef XN_LATE
#define XN_LATE 0
#endif
#ifndef I8_ST_CACHED
#define I8_ST_CACHED 1
#endif
#ifndef P0_ORDER
#define P0_ORDER 1
#endif
#ifndef BASE_NT
#define BASE_NT 0
#endif
#ifndef HB_NT
#define HB_NT 1
#endif
#ifndef XCD_ROWS
#define XCD_ROWS 0
#endif
#ifndef WGM_K16K
#define WGM_K16K 4
#define WGM_K2K 4
#define WGM_K1K 4
#endif
#ifndef SP_VSPLIT
#define SP_VSPLIT 0
#endif
#ifndef SP_ASM2
#define SP_ASM2 1
#endif
#ifndef LATE_BATCH
#define LATE_BATCH 0
#endif
#ifndef IDX_PIPE
#define IDX_PIPE 1
#endif
#ifndef IDX_VPM
#define IDX_VPM 6
#endif
#ifndef IDX_I8
#define IDX_I8 1
#endif
#ifndef IDX_F8
#define IDX_F8 0
#endif
#ifndef LATE_CONV
#define LATE_CONV (!L1_I8)
#endif
#ifndef WOUTA_I8
#define WOUTA_I8 1
#endif
#ifndef IDXG_I8
#define IDXG_I8 1
#endif
#ifndef L1_I8
#define L1_I8 0
#endif
#ifndef DOWN0_F8
#define DOWN0_F8 1
#endif
constexpr float WINA_SCALE = 64.0f;
constexpr int B_QKV = 6144;

constexpr size_t MiB = 1u << 20;
constexpr size_t WS_CTL = 0, CTL_ZERO_BYTES = 1 * MiB;
constexpr size_t WS_SROW = 1 * MiB;
constexpr size_t WS_SCOL_INA = 1 * MiB + 128 * 1024, WS_SCOL_UP0 = 1 * MiB + 256 * 1024;
constexpr size_t WS_SCOL_INB = 1 * MiB + 384 * 1024, WS_SCOL_UP1 = 1 * MiB + 512 * 1024;
constexpr size_t WS_SROW_OM = 1 * MiB + 64 * 1024;
constexpr size_t WS_SCOL_OUTA = 1 * MiB + 576 * 1024, WS_SCOL_INB2 = 1 * MiB + 592 * 1024, WS_SCOL_IDX = 1 * MiB + 600 * 1024, WS_SROW_IQ = 1 * MiB + 640 * 1024;
constexpr size_t WS_SK = 1 * MiB + 704 * 1024;
constexpr size_t WS_ROPE = 2 * MiB;
constexpr size_t WS_W_INA = 16 * MiB;
constexpr size_t WS_W_OUTA = WS_W_INA + 144 * MiB;
constexpr size_t WS_W_INB = WS_W_OUTA + 16 * MiB;
constexpr size_t WS_W_IDX = WS_W_INB + 58 * MiB;
constexpr size_t WS_W_OUTB = WS_W_IDX + 8 * MiB;
constexpr size_t WS_W_UP = WS_W_OUTB + 32 * MiB;
constexpr size_t WS_W_DOWN = WS_W_UP + 256 * MiB;
constexpr size_t WS_W_UP1 = WS_W_UP + 128 * MiB;
constexpr size_t WS_W_DOWN1 = WS_W_DOWN + 128 * MiB;
constexpr size_t WS_W_INB2 = WS_W_INB + 24 * MiB;
constexpr size_t WS_HB = WS_W_INA;
constexpr size_t WS_XN = 800 * MiB;
constexpr size_t WS_MIX = 928 * MiB;
constexpr size_t WS_R1 = 1056 * MiB;
constexpr size_t WS_HID = WS_R1;
constexpr size_t WS_QKVA = WS_R1;
constexpr size_t WS_OG = WS_QKVA + 576 * MiB;
constexpr size_t WS_LSE = WS_OG + 192 * MiB;
constexpr size_t WS_OMERGE = WS_LSE + 4 * MiB;
constexpr size_t WS_QB = WS_R1;
constexpr size_t WS_KB = WS_QB + 128 * MiB;
constexpr size_t WS_VB = WS_KB + 32 * MiB;
constexpr size_t WS_IQL = WS_VB + 32 * MiB;
constexpr size_t WS_IKW = WS_IQL + 32 * MiB;
constexpr size_t WS_IQLN = WS_IKW + 16 * MiB;
constexpr size_t WS_IKB = WS_IQLN + 32 * MiB;
constexpr size_t WS_IWS = WS_IKB + 4 * MiB;
constexpr size_t WS_IQ = WS_IWS + 2 * MiB;
constexpr size_t WS_SEL = WS_IQ + 128 * MiB;
constexpr size_t WS_SCORE = WS_SEL + 16 * MiB;
constexpr size_t WS_XN8 = WS_SCORE;
constexpr size_t WS_OB = WS_IQL;
constexpr size_t WS_END = 1992 * MiB;
static_assert(WS_W_DOWN + 256 * MiB <= WS_XN && WS_OMERGE + 64 * MiB <= WS_END && WS_SCORE + 512 * MiB <= WS_END && WS_OB + 128 * MiB <= WS_SEL && WS_HID + 512 * MiB <= WS_END, "d_ws map");
constexpr int CW_SPQ = 2048;
constexpr int CW_CMAX_INA = 131072, CW_CMAX_UP0 = CW_CMAX_INA + 18432;
constexpr int CW_CMAX_INB = CW_CMAX_UP0 + 16384, CW_CMAX_UP1 = CW_CMAX_INB + 6144;
constexpr int CW_CMAX_OUTA = CW_CMAX_UP1 + 16384, CW_CMAX_INB2 = CW_CMAX_OUTA + 4096, CW_CMAX_IDX = CW_CMAX_INB2 + 1280;
static_assert((CW_CMAX_IDX + 4096) * 4 <= (int)CTL_ZERO_BYTES, "column maxima inside the per-call memset");
constexpr int CW_BAR = 4096;
constexpr int N_PHASES = 20;

constexpr int RING_OFF = 0, RING_BYTES = 131072;
constexpr int LDSCTL_OFF = RING_BYTES, MISC_OFF = LDSCTL_OFF + 320;
constexpr int LDS_BYTES = 163840;
static_assert(MISC_OFF + 128 <= LDS_BYTES, "LDS map");

struct Frame {
    LAS unsigned char* lds;
    volatile LAS unsigned* MISC;
    gu32* ctl;
    int tid, lane, wave;
    int vcu, G;
    unsigned char* ws;
};
__device__ __forceinline__ float wave_sum(float v) {
#pragma unroll
    for (int o = 1; o < 64; o <<= 1) v += __shfl_xor(v, o);
    return v;
}
__device__ __forceinline__ float wave_max(float v) {
#pragma unroll
    for (int o = 1; o < 64; o <<= 1) v = fmaxf(v, __shfl_xor(v, o));
    return v;
}
__device__ __forceinline__ float bf_lo(unsigned u) { return __builtin_bit_cast(float, u << 16); }
__device__ __forceinline__ float bf_hi(unsigned u) { return __builtin_bit_cast(float, u & 0xffff0000u); }

__device__ __forceinline__ void p0_transpose_item(const float* W, int K, int N, bf16* WT, int perm, LAS float* scr, int item, int lane, int drow = 0) {
    const int nblk = N / 32, kb = item / nblk, nb = item % nblk, k0 = 64 * kb, n0 = 32 * nb;
    { float tv[32];
#pragma unroll
      for (int i = 0; i < 32; ++i) tv[i] = W[(size_t)(k0 + 2 * i + (lane >> 5)) * N + n0 + (lane & 31)];
      __builtin_amdgcn_sched_barrier(0);
#pragma unroll
      for (int i = 0; i < 32; ++i) scr[(2 * i + (lane >> 5)) * 33 + (lane & 31)] = tv[i]; }
    LDS_WAIT(); asm volatile("" ::: "memory");
    int d0 = n0;
    if (perm) { const int blk = (n0 >> 6) & 3, sb = (blk == 1) ? 2 : (blk == 2) ? 1 : blk; d0 = (n0 & ~255) + 64 * sb + (n0 & 63); }
    const int c = lane & 7;
#pragma unroll
    for (int j = 0; j < 4; ++j) { const int n = (lane >> 3) + 8 * j; const LAS float* s = scr + (8 * c) * 33 + n;
        v4u o; o.x = pk2(s[0 * 33], s[1 * 33]); o.y = pk2(s[2 * 33], s[3 * 33]); o.z = pk2(s[4 * 33], s[5 * 33]); o.w = pk2(s[6 * 33], s[7 * 33]);
        *(GAS v4u*)(WT + (size_t)(d0 + n - drow) * K + k0 + 8 * c) = o; }
    LDS_WAIT(); asm volatile("" ::: "memory");
}
__device__ __forceinline__ void p0_transpose_item_f8(const float* W, int K, int N, unsigned char* WT, float scale, LAS float* scr, int item, int lane, int perm = 0) {
    const int nblk = N / 32, kb = item / nblk, nb = item % nblk, k0 = 64 * kb, n0 = 32 * nb;
    { float tv[32];
#pragma unroll
      for (int i = 0; i < 32; ++i) tv[i] = P0_NT ? __builtin_nontemporal_load(W + (size_t)(k0 + 2 * i + (lane >> 5)) * N + n0 + (lane & 31)) : W[(size_t)(k0 + 2 * i + (lane >> 5)) * N + n0 + (lane & 31)];
      __builtin_amdgcn_sched_barrier(0);
#pragma unroll
      for (int i = 0; i < 32; ++i) scr[(2 * i + (lane >> 5)) * 33 + (lane & 31)] = tv[i]; }
    LDS_WAIT(); asm volatile("" ::: "memory");
    int d0 = n0;
    if (perm) { const int blk = (n0 >> 6) & 3, sb = (blk == 1) ? 2 : (blk == 2) ? 1 : blk; d0 = (n0 & ~255) + 64 * sb + (n0 & 63); }
    const int c = lane & 7;
#pragma unroll
    for (int j = 0; j < 4; ++j) { const int n = (lane >> 3) + 8 * j; const LAS float* s = scr + (8 * c) * 33 + n;
        int p0 = 0, p1 = 0;
        p0 = __builtin_amdgcn_cvt_pk_fp8_f32(s[0 * 33] * scale, s[1 * 33] * scale, p0, false); p0 = __builtin_amdgcn_cvt_pk_fp8_f32(s[2 * 33] * scale, s[3 * 33] * scale, p0, true);
        p1 = __builtin_amdgcn_cvt_pk_fp8_f32(s[4 * 33] * scale, s[5 * 33] * scale, p1, false); p1 = __builtin_amdgcn_cvt_pk_fp8_f32(s[6 * 33] * scale, s[7 * 33] * scale, p1, true);
        { const unsigned long long pv_ = (unsigned long long)(unsigned)p0 | ((unsigned long long)(unsigned)p1 << 32); unsigned long long* pp_ = (unsigned long long*)(WT + (size_t)(d0 + n) * K + k0 + 8 * c);
          if (P0_NT) __builtin_nontemporal_store(pv_, pp_); else *(GAS unsigned long long*)pp_ = pv_; } }
    LDS_WAIT(); asm volatile("" ::: "memory");
}
__device__ __forceinline__ unsigned pk_i8x4(float a, float b, float c, float d) {
    const int ia = (int)__builtin_rintf(a), ib = (int)__builtin_rintf(b), ic = (int)__builtin_rintf(c), id = (int)__builtin_rintf(d);
    return (unsigned)(ia & 255) | ((unsigned)(ib & 255) << 8) | ((unsigned)(ic & 255) << 16) | ((unsigned)id << 24);
}
__device__ __forceinline__ void p0_colmax_item(const float* W, int K, int N, unsigned* cmax, int item, int lane, int dcol = 0) {
    const int nblk = N / 32, kb = item / nblk, nb = item % nblk, k0 = 64 * kb, n0 = 32 * nb;
    float mx = 0.f;
#pragma unroll
    for (int i = 0; i < 32; ++i) { const int kk = 2 * i + (lane >> 5); mx = fmaxf(mx, __builtin_fabsf(W[(size_t)(k0 + kk) * N + n0 + (lane & 31)])); }
    mx = fmaxf(mx, __shfl_xor(mx, 32));
    if (lane < 32) __hip_atomic_fetch_max(cmax + n0 + lane - dcol, __builtin_bit_cast(unsigned, mx), __ATOMIC_RELAXED, __HIP_MEMORY_SCOPE_AGENT);
}
__device__ __forceinline__ void p0_transpose_item_i8(const float* W, int K, int N, unsigned char* WT, const unsigned* cmax, float* scol, LAS float* scr, int item, int lane, int perm, int drow = 0) {
    const int nblk = N / 32, kb = item / nblk, nb = item % nblk, k0 = 64 * kb, n0 = 32 * nb;
    { float tv[32];
#pragma unroll
      for (int i = 0; i < 32; ++i) tv[i] = P0_NT ? __builtin_nontemporal_load(W + (size_t)(k0 + 2 * i + (lane >> 5)) * N + n0 + (lane & 31)) : W[(size_t)(k0 + 2 * i + (lane >> 5)) * N + n0 + (lane & 31)];
      __builtin_amdgcn_sched_barrier(0);
#pragma unroll
      for (int i = 0; i < 32; ++i) scr[(2 * i + (lane >> 5)) * 33 + (lane & 31)] = tv[i]; }
    LDS_WAIT(); asm volatile("" ::: "memory");
    int d0 = n0;
    if (perm) { const int blk = (n0 >> 6) & 3, sb = (blk == 1) ? 2 : (blk == 2) ? 1 : blk; d0 = (n0 & ~255) + 64 * sb + (n0 & 63); }
    const int c = lane & 7;
#pragma unroll
    for (int j = 0; j < 4; ++j) { const int n = (lane >> 3) + 8 * j; const LAS float* s = scr + (8 * c) * 33 + n;
        const float amax = __builtin_bit_cast(float, cmax[n0 + n - drow]); const float inv = amax > 0.f ? 127.0f / amax : 0.f;
        const unsigned p0 = pk_i8x4(s[0 * 33] * inv, s[1 * 33] * inv, s[2 * 33] * inv, s[3 * 33] * inv), p1 = pk_i8x4(s[4 * 33] * inv, s[5 * 33] * inv, s[6 * 33] * inv, s[7 * 33] * inv);
        { const unsigned long long pv_ = (unsigned long long)p0 | ((unsigned long long)p1 << 32); unsigned long long* pp_ = (unsigned long long*)(WT + (size_t)(d0 + n - drow) * K + k0 + 8 * c);
          if (P0_NT && !I8_ST_CACHED) __builtin_nontemporal_store(pv_, pp_); else *(GAS unsigned long long*)pp_ = pv_; }
        if (kb == 0 && c == 0) scol[d0 + n - drow] = amax * (1.0f / 127.0f); }
    LDS_WAIT(); asm volatile("" ::: "memory");
}
template <int XF8> __device__ __forceinline__ void rms_row_to_bf16(const float* xrow, const float* g, bf16* orow, float* srow_m, int lane) {
    const GAS f32x4* xr = (const GAS f32x4*)xrow + lane; const CAS f32x4* gr = (const CAS f32x4*)g + lane;
    f32x4 v[16]; float s = 0.f;
#pragma unroll
    for (int j = 0; j < 16; ++j) { v[j] = XN_LATE ? __builtin_nontemporal_load((const f32x4*)xrow + lane + 64 * j) : xr[64 * j]; s += (v[j].x * v[j].x + v[j].y * v[j].y) + (v[j].z * v[j].z + v[j].w * v[j].w); }
    const float rs = 1.0f / sqrtf(wave_sum(s) * (1.f / DM) + NORM_EPS);
    GAS unsigned long long* o8 = (GAS unsigned long long*)orow + lane;
    if (XF8 == 2) { float am = 0.f;
#pragma unroll
        for (int j = 0; j < 16; ++j) { const f32x4 gg = gr[64 * j]; v[j] = v[j] * rs * gg; am = fmaxf(fmaxf(am, fmaxf(__builtin_fabsf(v[j].x), __builtin_fabsf(v[j].y))), fmaxf(__builtin_fabsf(v[j].z), __builtin_fabsf(v[j].w))); }
        am = wave_max(am); const float inv = am > 0.f ? 127.0f / am : 0.f;
#pragma unroll
        for (int j = 0; j < 16; ++j) ((GAS unsigned*)orow)[lane + 64 * j] = pk_i8x4(v[j].x * inv, v[j].y * inv, v[j].z * inv, v[j].w * inv);
        if (lane == 0) *srow_m = am * (1.0f / 127.0f);
        return; }
#pragma unroll
    for (int j = 0; j < 16; ++j) { const f32x4 gg = gr[64 * j];
        if (XF8 == 1) { int p = 0; p = __builtin_amdgcn_cvt_pk_fp8_f32(v[j].x * rs * gg.x, v[j].y * rs * gg.y, p, false); p = __builtin_amdgcn_cvt_pk_fp8_f32(v[j].z * rs * gg.z, v[j].w * rs * gg.w, p, true); ((GAS unsigned*)orow)[lane + 64 * j] = (unsigned)p; }
        else o8[64 * j] = (unsigned long long)pk2(v[j].x * rs * gg.x, v[j].y * rs * gg.y) | ((unsigned long long)pk2(v[j].z * rs * gg.z, v[j].w * rs * gg.w) << 32); }
}
template <int XF8, bool BB, bool OB> __device__ __forceinline__ void resid_norm_row(const bf16* mixrow, const void* baserow, const float* gpost, void* outrow, const float* gnext, bf16* xnrow, unsigned char* xn8row, float* srow_m, int lane, const void* pf_mix = nullptr, const void* pf_base = nullptr, LAS unsigned* pf_lds = nullptr) {
    const GAS unsigned long long* mr = (const GAS unsigned long long*)mixrow + lane; const CAS f32x4* gp = (const CAS f32x4*)gpost + lane;
    f32x4 v[16]; float s = 0.f;
#pragma unroll
    for (int j = 0; j < 16; ++j) { const unsigned long long q = P0_NT ? __builtin_nontemporal_load((const unsigned long long*)mixrow + lane + 64 * j) : mr[64 * j]; const unsigned ql = (unsigned)q, qh = (unsigned)(q >> 32); v[j] = (f32x4){bf_lo(ql), bf_hi(ql), bf_lo(qh), bf_hi(qh)};
        s += (v[j].x * v[j].x + v[j].y * v[j].y) + (v[j].z * v[j].z + v[j].w * v[j].w); }
    const float rs = 1.0f / sqrtf(wave_sum(s) * (1.f / DM) + NORM_EPS);
    float s2 = 0.f;
    unsigned long long bq[BB ? 16 : 1]; f32x4 bf[BB ? 1 : 16];
#pragma unroll
    for (int j = 0; j < 16; ++j) { if (BB) bq[j] = BASE_NT ? __builtin_nontemporal_load((const unsigned long long*)baserow + lane + 64 * j) : ((const GAS unsigned long long*)baserow)[lane + 64 * j];
                                   else bf[j] = BASE_NT ? __builtin_nontemporal_load((const f32x4*)baserow + lane + 64 * j) : ((const GAS f32x4*)baserow)[lane + 64 * j]; }
#pragma unroll
    for (int j = 0; j < 16; ++j) { const f32x4 gg = gp[64 * j]; f32x4 bb;
        if (BB) { const unsigned long long q = bq[j]; const unsigned ql = (unsigned)q, qh = (unsigned)(q >> 32); bb = (f32x4){bf_lo(ql), bf_hi(ql), bf_lo(qh), bf_hi(qh)}; }
        else bb = bf[j];
        v[j] = bb + v[j] * rs * gg;
        if (OB) { const unsigned long long hv_ = (unsigned long long)pk2(v[j].x, v[j].y) | ((unsigned long long)pk2(v[j].z, v[j].w) << 32);
                  if (HB_NT) __builtin_nontemporal_store(hv_, (unsigned long long*)outrow + lane + 64 * j); else ((GAS unsigned long long*)outrow)[lane + 64 * j] = hv_; }
        else ((GAS f32x4*)outrow)[lane + 64 * j] = v[j];
        s2 += (v[j].x * v[j].x + v[j].y * v[j].y) + (v[j].z * v[j].z + v[j].w * v[j].w); }
#if THIN_PF == 1
    if (pf_mix) { __builtin_amdgcn_global_load_lds((const unsigned*)((const unsigned char*)pf_mix + 128 * lane), pf_lds, 4, 0, 0);
        __builtin_amdgcn_global_load_lds((const unsigned*)((const unsigned char*)pf_base + 128 * lane), pf_lds, 4, 0, 0);
        if (!BB) __builtin_amdgcn_global_load_lds((const unsigned*)((const unsigned char*)pf_base + 8192 + 128 * lane), pf_lds, 4, 0, 0); }
#endif
    if (xnrow) {
        const float rs2 = 1.0f / sqrtf(wave_sum(s2) * (1.f / DM) + NORM_EPS);
        const CAS f32x4* gn = (const CAS f32x4*)gnext + lane;
#if THIN_PF
        asm volatile("" : "+v"(gn));
#endif
        GAS unsigned long long* o8 = (GAS unsigned long long*)xnrow + lane;
        if (XF8 == 3 || XF8 == 4 || XF8 == 5) { float am = 0.f;
#pragma unroll
            for (int j = 0; j < 16; ++j) { const f32x4 gg = gn[64 * j]; v[j] = v[j] * rs2 * gg; am = fmaxf(fmaxf(am, fmaxf(__builtin_fabsf(v[j].x), __builtin_fabsf(v[j].y))), fmaxf(__builtin_fabsf(v[j].z), __builtin_fabsf(v[j].w))); }
            am = wave_max(am); const float inv = am > 0.f ? 127.0f / am : 0.f;
#pragma unroll
            for (int j = 0; j < 16; ++j) {
                if (XF8 == 5) { int p = 0; p = __builtin_amdgcn_cvt_pk_fp8_f32(v[j].x, v[j].y, p, false); p = __builtin_amdgcn_cvt_pk_fp8_f32(v[j].z, v[j].w, p, true); ((GAS unsigned*)xn8row)[lane + 64 * j] = (unsigned)p;
                                ((GAS unsigned*)xnrow)[lane + 64 * j] = pk_i8x4(v[j].x * inv, v[j].y * inv, v[j].z * inv, v[j].w * inv); continue; }
                ((GAS unsigned*)xn8row)[lane + 64 * j] = pk_i8x4(v[j].x * inv, v[j].y * inv, v[j].z * inv, v[j].w * inv);
                if (XF8 == 4) o8[64 * j] = (unsigned long long)pk2(v[j].x, v[j].y) | ((unsigned long long)pk2(v[j].z, v[j].w) << 32); }
            if (lane == 0) *srow_m = am * (1.0f / 127.0f);
            return; }
#pragma unroll
        for (int j = 0; j < 16; ++j) { const f32x4 gg = gn[64 * j];
            if (XF8 >= 1) { int p = 0; p = __builtin_amdgcn_cvt_pk_fp8_f32(v[j].x * rs2 * gg.x, v[j].y * rs2 * gg.y, p, false); p = __builtin_amdgcn_cvt_pk_fp8_f32(v[j].z * rs2 * gg.z, v[j].w * rs2 * gg.w, p, true);
                       ((GAS unsigned*)xn8row)[lane + 64 * j] = (unsigned)p; }
            if (XF8 != 1) o8[64 * j] = (unsigned long long)pk2(v[j].x * rs2 * gg.x, v[j].y * rs2 * gg.y) | ((unsigned long long)pk2(v[j].z * rs2 * gg.z, v[j].w * rs2 * gg.w) << 32); }
    }
}
struct Args { const void* in[16]; float* out; unsigned char* ws; int ph_lo, ph_hi, li, pad; };

typedef float f32x16 __attribute__((ext_vector_type(16)));
__device__ __forceinline__ int xrow(int gw, int NGW, int G, int i) {
    if (XCD_ROWS && G % 8 == 0) { const int wpx = NGW / 8, l = gw % wpx + wpx * i; return l < M / 8 ? (gw / wpx) * (M / 8) + l : -1; }
    const int m = gw + NGW * i; return m < M ? m : -1;
}
#define MFMA32(a, b, c) __builtin_amdgcn_mfma_f32_32x32x16_bf16((a), (b), (c), 0, 0, 0)

__device__ __forceinline__ void p0_prologue(Frame& F, const Args& a) {
    LAS float* scr = (LAS float*)(F.lds + RING_OFF + F.wave * 16384);
    const int gw = F.vcu * NWAVES + F.wave, NGW = F.G * NWAVES;
    unsigned char* ws = F.ws;
    constexpr int I_INA = (DM / 64) * (A_IN / 32), I_OUTA = (A_OUT / 64) * (DM / 32), I_INB = (DM / 64) * (B_IN / 32), I_IDX = (IDX_RANK / 64) * (4096 / 32),
                  I_OUTB = (4096 / 64) * (DM / 32), I_UP = (DM / 64) * (DFF / 32), I_DOWN = (DFF / 64) * (DM / 32);
    constexpr int NITEMS = I_INA + I_OUTA + I_INB + I_IDX + I_OUTB + 2 * I_UP + 2 * I_DOWN;
#if !P0_ORDER
    for (int it = gw; it < NITEMS; it += NGW) {
        int r = it;
#if QKVA_I8
        if (r < I_INA) { p0_colmax_item((const float*)a.in[6], DM, A_IN, (unsigned*)(F.ctl + CW_CMAX_INA), r, F.lane); continue; } r -= I_INA;
#elif QKVA_F8
        if (r < I_INA) { p0_transpose_item_f8((const float*)a.in[6], DM, A_IN, (unsigned char*)(ws + WS_W_INA), WINA_SCALE, scr, r, F.lane, 1); continue; } r -= I_INA;
#else
        if (r < I_INA) { p0_transpose_item((const float*)a.in[6], DM, A_IN, (bf16*)(ws + WS_W_INA), 1, scr, r, F.lane); continue; } r -= I_INA;
#endif
        if (r < I_OUTA) { if (WOUTA_I8) p0_colmax_item((const float*)a.in[7], A_OUT, DM, (unsigned*)(F.ctl + CW_CMAX_OUTA), r, F.lane);
                          else p0_transpose_item((const float*)a.in[7], A_OUT, DM, (bf16*)(ws + WS_W_OUTA), 0, scr, r, F.lane); continue; } r -= I_OUTA;
        if (r < I_INB) { const int n0 = 32 * (r % (B_IN / 32));
            if (n0 < B_QKV) { if (L1_I8) p0_colmax_item((const float*)a.in[8], DM, B_IN, (unsigned*)(F.ctl + CW_CMAX_INB), r, F.lane);
                              else p0_transpose_item_f8((const float*)a.in[8], DM, B_IN, (unsigned char*)(ws + WS_W_INB), WINB_SCALE, scr, r, F.lane, 1); }
            else if (IDXG_I8) p0_colmax_item((const float*)a.in[8], DM, B_IN, (unsigned*)(F.ctl + CW_CMAX_INB2), r, F.lane, B_QKV);
            else p0_transpose_item((const float*)a.in[8], DM, B_IN, (bf16*)(ws + WS_W_INB2), 1, scr, r, F.lane, B_QKV);
            continue; } r -= I_INB;
        if (r < I_IDX) { if (IDXG_I8) p0_colmax_item((const float*)a.in[10], IDX_RANK, 4096, (unsigned*)(F.ctl + CW_CMAX_IDX), r, F.lane);
                         else p0_transpose_item((const float*)a.in[10], IDX_RANK, 4096, (bf16*)(ws + WS_W_IDX), 1, scr, r, F.lane); continue; } r -= I_IDX;
        if (r < I_OUTB) { if (!LATE_CONV) p0_transpose_item_f8((const float*)a.in[13], 4096, DM, (unsigned char*)(ws + WS_W_OUTB), WOUTB_SCALE, scr, r, F.lane); continue; } r -= I_OUTB;
#if UP0_I8
        if (r < I_UP) { p0_colmax_item((const float*)a.in[14], DM, DFF, (unsigned*)(F.ctl + CW_CMAX_UP0), r, F.lane); continue; } r -= I_UP;
#else
        if (r < I_UP) { p0_transpose_item((const float*)a.in[14], DM, DFF, (bf16*)(ws + WS_W_UP), 0, scr, r, F.lane); continue; } r -= I_UP;
#endif
        if (r < I_UP) { if (L1_I8) p0_colmax_item((const float*)a.in[14] + (size_t)DM * DFF, DM, DFF, (unsigned*)(F.ctl + CW_CMAX_UP1), r, F.lane);
                        else if (!LATE_CONV) p0_transpose_item_f8((const float*)a.in[14] + (size_t)DM * DFF, DM, DFF, (unsigned char*)(ws + WS_W_UP1), WUP_SCALE, scr, r, F.lane); continue; } r -= I_UP;
#if DOWN0_F8
        if (r < I_DOWN) { p0_transpose_item_f8((const float*)a.in[15], DFF, DM, (unsigned char*)(ws + WS_W_DOWN), WDOWN_SCALE, scr, r, F.lane); continue; } r -= I_DOWN;
#else
        if (r < I_DOWN) { p0_transpose_item((const float*)a.in[15], DFF, DM, (bf16*)(ws + WS_W_DOWN), 0, scr, r, F.lane); continue; } r -= I_DOWN;
#endif
        if (!LATE_CONV) p0_transpose_item_f8((const float*)a.in[15] + (size_t)DM * DFF, DFF, DM, (unsigned char*)(ws + WS_W_DOWN1), WDOWN_SCALE, scr, r, F.lane);
    }
#endif
    const int gt = F.vcu * (NWAVES * 64) + F.tid, NGT = F.G * NWAVES * 64;
    { unsigned char* wt = (unsigned char*)(ws + WS_W_INB2); constexpr int RB = IDXG_I8 ? DM : 2 * DM;
      for (int i = gt; i < 96 * (RB / 16); i += NGT) { const int rr = i / (RB / 16), row = (rr < 32 ? 7264 + rr : 7360 + (rr - 32)) - B_QKV; *(GAS v4u*)(wt + (size_t)row * RB + (i % (RB / 16)) * 16) = (v4u){0u, 0u, 0u, 0u}; }
      if (IDXG_I8) { float* sc = (float*)(ws + WS_SCOL_INB2); for (int i = gt; i < 96; i += NGT) sc[(i < 32 ? 7264 + i : 7360 + (i - 32)) - B_QKV] = 0.f; } }
    { const int* pos = (const int*)a.in[1]; float* rope = (float*)(ws + WS_ROPE);
      for (int idx = gt; idx < M * 64; idx += NGT) { const int m = idx >> 6, i = idx & 63;
          double f = 1.0, bs = 0.8659643233600653; int e = i;
#pragma unroll
          for (int s = 0; s < 6; ++s) { if (e & 1) f *= bs; bs *= bs; e >>= 1; }
          const double th = (double)pos[m] * f;
          const double nn = __builtin_rint(th * 0.15915494309189535);
          double rr = __builtin_fma(-nn, 6.283185307179586, th); rr = __builtin_fma(-nn, 2.4492935982947064e-16, rr);
          const double kq = __builtin_rint(rr * 0.6366197723675814);
          double y = __builtin_fma(-kq, 1.5707963267948966, rr); y = __builtin_fma(-kq, 6.123233995736766e-17, y);
          const double y2 = y * y;
          double sp = 1.6059043836821613e-10; sp = sp * y2 - 2.505210838544172e-08; sp = sp * y2 + 2.7557319223985893e-06; sp = sp * y2 - 1.984126984126984e-04; sp = sp * y2 + 8.333333333333333e-03; sp = sp * y2 - 1.6666666666666666e-01; sp = sp * y2 + 1.0;
          const double sy = sp * y;
          double cp = -1.1470745597729725e-11; cp = cp * y2 + 2.08767569878681e-09; cp = cp * y2 - 2.755731922398589e-07; cp = cp * y2 + 2.48015873015873e-05; cp = cp * y2 - 1.388888888888889e-03; cp = cp * y2 + 4.1666666666666664e-02; cp = cp * y2 - 0.5; cp = cp * y2 + 1.0;
          const int q = ((int)kq) & 3;
          const double cs = (q == 0) ? cp : (q == 1) ? -sy : (q == 2) ? -cp : sy;
          const double sn = (q == 0) ? sy : (q == 1) ? cp : (q == 2) ? -sy : -cp;
          rope[(size_t)m * 128 + i] = (float)cs; rope[(size_t)m * 128 + 64 + i] = (float)sn; } }
    if (!XN_LATE)
    { const float* x = (const float*)a.in[0]; const float* g = (const float*)a.in[2]; bf16* xn = (bf16*)(ws + WS_XN);
      for (int i_ = 0, m; (m = xrow(gw, NGW, F.G, i_)) >= 0; ++i_) rms_row_to_bf16<(QKVA_I8 ? 2 : (QKVA_F8 ? 1 : 0))>(x + (size_t)m * DM, g, (QKVA_I8 || QKVA_F8) ? (bf16*)((unsigned char*)xn + (size_t)m * DM) : xn + (size_t)m * DM, (float*)(ws + WS_SROW) + m, F.lane); }
#if P0_ORDER
    for (int it = gw; it < NITEMS; it += NGW) {
        int r = it + (P0_ORDER ? I_INA + I_OUTA + I_INB + I_IDX + I_OUTB + I_UP : 0); if (r >= NITEMS) r -= NITEMS;
#if QKVA_I8
        if (r < I_INA) { p0_colmax_item((const float*)a.in[6], DM, A_IN, (unsigned*)(F.ctl + CW_CMAX_INA), r, F.lane); continue; } r -= I_INA;
#elif QKVA_F8
        if (r < I_INA) { p0_transpose_item_f8((const float*)a.in[6], DM, A_IN, (unsigned char*)(ws + WS_W_INA), WINA_SCALE, scr, r, F.lane, 1); continue; } r -= I_INA;
#else
        if (r < I_INA) { p0_transpose_item((const float*)a.in[6], DM, A_IN, (bf16*)(ws + WS_W_INA), 1, scr, r, F.lane); continue; } r -= I_INA;
#endif
        if (r < I_OUTA) { if (WOUTA_I8) p0_colmax_item((const float*)a.in[7], A_OUT, DM, (unsigned*)(F.ctl + CW_CMAX_OUTA), r, F.lane);
                          else p0_transpose_item((const float*)a.in[7], A_OUT, DM, (bf16*)(ws + WS_W_OUTA), 0, scr, r, F.lane); continue; } r -= I_OUTA;
        if (r < I_INB) { const int n0 = 32 * (r % (B_IN / 32));
            if (n0 < B_QKV) { if (L1_I8) p0_colmax_item((const float*)a.in[8], DM, B_IN, (unsigned*)(F.ctl + CW_CMAX_INB), r, F.lane);
                              else p0_transpose_item_f8((const float*)a.in[8], DM, B_IN, (unsigned char*)(ws + WS_W_INB), WINB_SCALE, scr, r, F.lane, 1); }
            else if (IDXG_I8) p0_colmax_item((const float*)a.in[8], DM, B_IN, (unsigned*)(F.ctl + CW_CMAX_INB2), r, F.lane, B_QKV);
            else p0_transpose_item((const float*)a.in[8], DM, B_IN, (bf16*)(ws + WS_W_INB2), 1, scr, r, F.lane, B_QKV);
            continue; } r -= I_INB;
        if (r < I_IDX) { if (IDXG_I8) p0_colmax_item((const float*)a.in[10], IDX_RANK, 4096, (unsigned*)(F.ctl + CW_CMAX_IDX), r, F.lane);
                         else p0_transpose_item((const float*)a.in[10], IDX_RANK, 4096, (bf16*)(ws + WS_W_IDX), 1, scr, r, F.lane); continue; } r -= I_IDX;
        if (r < I_OUTB) { if (!LATE_CONV) p0_transpose_item_f8((const float*)a.in[13], 4096, DM, (unsigned char*)(ws + WS_W_OUTB), WOUTB_SCALE, scr, r, F.lane); continue; } r -= I_OUTB;
#if UP0_I8
        if (r < I_UP) { p0_colmax_item((const float*)a.in[14], DM, DFF, (unsigned*)(F.ctl + CW_CMAX_UP0), r, F.lane); continue; } r -= I_UP;
#else
        if (r < I_UP) { p0_transpose_item((const float*)a.in[14], DM, DFF, (bf16*)(ws + WS_W_UP), 0, scr, r, F.lane); continue; } r -= I_UP;
#endif
        if (r < I_UP) { if (L1_I8) p0_colmax_item((const float*)a.in[14] + (size_t)DM * DFF, DM, DFF, (unsigned*)(F.ctl + CW_CMAX_UP1), r, F.lane);
                        else if (!LATE_CONV) p0_transpose_item_f8((const float*)a.in[14] + (size_t)DM * DFF, DM, DFF, (unsigned char*)(ws + WS_W_UP1), WUP_SCALE, scr, r, F.lane); continue; } r -= I_UP;
#if DOWN0_F8
        if (r < I_DOWN) { p0_transpose_item_f8((const float*)a.in[15], DFF, DM, (unsigned char*)(ws + WS_W_DOWN), WDOWN_SCALE, scr, r, F.lane); continue; } r -= I_DOWN;
#else
        if (r < I_DOWN) { p0_transpose_item((const float*)a.in[15], DFF, DM, (bf16*)(ws + WS_W_DOWN), 0, scr, r, F.lane); continue; } r -= I_DOWN;
#endif
        if (!LATE_CONV) p0_transpose_item_f8((const float*)a.in[15] + (size_t)DM * DFF, DFF, DM, (unsigned char*)(ws + WS_W_DOWN1), WDOWN_SCALE, scr, r, F.lane);
    }
#endif
}

__device__ __forceinline__ void p0b_quantize(Frame& F, const Args& a) {
    LAS float* scr = (LAS float*)(F.lds + RING_OFF + F.wave * 16384);
    const int gw = F.vcu * NWAVES + F.wave, NGW = F.G * NWAVES;
    unsigned char* ws = F.ws;
    constexpr int I_INA = QKVA_I8 ? (DM / 64) * (A_IN / 32) : 0, I_UP = UP0_I8 ? (DM / 64) * (DFF / 32) : 0, I_INB = (L1_I8 || IDXG_I8) ? (DM / 64) * (B_IN / 32) : 0, I_UP1 = L1_I8 ? (DM / 64) * (DFF / 32) : 0,
                  I_OUTA = WOUTA_I8 ? (A_OUT / 64) * (DM / 32) : 0, I_IDX = IDXG_I8 ? (IDX_RANK / 64) * (4096 / 32) : 0;
    for (int it = gw; it < I_INA + I_UP + I_INB + I_UP1 + I_OUTA + I_IDX; it += NGW) {
        int r = it + (P0_ORDER ? I_INA : 0); if (r >= I_INA + I_UP + I_INB + I_UP1 + I_OUTA + I_IDX) r -= I_INA + I_UP + I_INB + I_UP1 + I_OUTA + I_IDX;
        if (r >= I_INA + I_UP + I_INB + I_UP1) { r -= I_INA + I_UP + I_INB + I_UP1;
            if (r < I_OUTA) p0_transpose_item_i8((const float*)a.in[7], A_OUT, DM, (unsigned char*)(ws + WS_W_OUTA), (const unsigned*)(F.ctl + CW_CMAX_OUTA), (float*)(ws + WS_SCOL_OUTA), scr, r, F.lane, 0);
            else p0_transpose_item_i8((const float*)a.in[10], IDX_RANK, 4096, (unsigned char*)(ws + WS_W_IDX), (const unsigned*)(F.ctl + CW_CMAX_IDX), (float*)(ws + WS_SCOL_IDX), scr, r - I_OUTA, F.lane, 1);
            continue; }
        if (r < I_INA) { p0_transpose_item_i8((const float*)a.in[6], DM, A_IN, (unsigned char*)(ws + WS_W_INA), (const unsigned*)(F.ctl + CW_CMAX_INA), (float*)(ws + WS_SCOL_INA), scr, r, F.lane, 1); continue; } r -= I_INA;
        if (r < I_UP) { p0_transpose_item_i8((const float*)a.in[14], DM, DFF, (unsigned char*)(ws + WS_W_UP), (const unsigned*)(F.ctl + CW_CMAX_UP0), (float*)(ws + WS_SCOL_UP0), scr, r, F.lane, 0); continue; } r -= I_UP;
        if (r < I_INB) { const bool qkv = 32 * (r % (B_IN / 32)) < B_QKV;
            if (qkv && L1_I8) p0_transpose_item_i8((const float*)a.in[8], DM, B_IN, (unsigned char*)(ws + WS_W_INB), (const unsigned*)(F.ctl + CW_CMAX_INB), (float*)(ws + WS_SCOL_INB), scr, r, F.lane, 1);
            if (!qkv && IDXG_I8) p0_transpose_item_i8((const float*)a.in[8], DM, B_IN, (unsigned char*)(ws + WS_W_INB2), (const unsigned*)(F.ctl + CW_CMAX_INB2), (float*)(ws + WS_SCOL_INB2), scr, r, F.lane, 1, B_QKV);
            continue; } r -= I_INB;
        p0_transpose_item_i8((const float*)a.in[14] + (size_t)DM * DFF, DM, DFF, (unsigned char*)(ws + WS_W_UP1), (const unsigned*)(F.ctl + CW_CMAX_UP1), (float*)(ws + WS_SCOL_UP1), scr, r, F.lane, 0);
    }
    if (XN_LATE)
    { const float* x = (const float*)a.in[0]; const float* g = (const float*)a.in[2]; bf16* xn = (bf16*)(ws + WS_XN);
      for (int i_ = 0, m; (m = xrow(gw, NGW, F.G, i_)) >= 0; ++i_) rms_row_to_bf16<(QKVA_I8 ? 2 : (QKVA_F8 ? 1 : 0))>(x + (size_t)m * DM, g, (QKVA_I8 || QKVA_F8) ? (bf16*)((unsigned char*)xn + (size_t)m * DM) : xn + (size_t)m * DM, (float*)(ws + WS_SROW) + m, F.lane); }
}
template <int XF8, bool BB, bool OB> __device__ __forceinline__ void thin_resid(Frame& F, const bf16* mix, const void* base, const float* gpost, void* out, const float* gnext, bf16* xn, unsigned char* xn8, float* srow = nullptr) {
    const int gw = F.vcu * NWAVES + F.wave, NGW = F.G * NWAVES;
    LAS unsigned* pfl = (LAS unsigned*)(F.lds + RING_OFF + F.wave * 256);
    for (int i_ = 0, m; (m = xrow(gw, NGW, F.G, i_)) >= 0; ++i_) { const int mn = xrow(gw, NGW, F.G, i_ + 1);
        resid_norm_row<XF8, BB, OB>(mix + (size_t)m * DM, (const unsigned char*)base + (size_t)m * DM * (BB ? 2 : 4), gpost, (unsigned char*)out + (size_t)m * DM * (OB ? 2 : 4), gnext,
                                    xn ? (XF8 == 5 ? (bf16*)((unsigned char*)xn + (size_t)m * DM) : xn + (size_t)m * DM) : nullptr, xn8 ? xn8 + (size_t)m * DM : nullptr, srow ? srow + m : nullptr, F.lane,
                                    mn >= 0 ? (const void*)(mix + (size_t)mn * DM) : nullptr, (const unsigned char*)base + (size_t)(mn >= 0 ? mn : m) * DM * (BB ? 2 : 4), pfl); }
    asm volatile("s_waitcnt vmcnt(0)" ::: "memory");
}

typedef short s16x4b __attribute__((ext_vector_type(4)));
typedef short v4i16b_t __attribute__((ext_vector_type(4)));
__device__ __forceinline__ s16x4b vtr16(const LAS unsigned char* p) { return __builtin_bit_cast(s16x4b, __builtin_amdgcn_ds_read_tr16_b64_v4i16((LAS v4i16b_t*)p)); }
#if DIL_PIPE
__device__ __forceinline__ void dil_attn_phase(Frame& F) {
    const bf16* QKV = (const bf16*)(F.ws + WS_QKVA); bf16* OG = (bf16*)(F.ws + WS_OG); float* LSE = (float*)(F.ws + WS_LSE);
    const int hb = F.wave >> 2, w = F.wave & 3, lane = F.lane, l31 = lane & 31, half = lane >> 5;
    LAS unsigned char* vt = F.lds + RING_OFF + hb * 65536;
#ifndef DIL_REP
#define DIL_REP 1
#endif
#define DIL_PARAMS(p_, Qp_, nblk_, g_, b_, head_, r_, c_) \
        const int idx_##Qp_ = 2 * (p_) + hb; const int blk_##Qp_ = idx_##Qp_ & 63, head_ = (idx_##Qp_ >> 6) & 15, bg_##Qp_ = idx_##Qp_ >> 10, g_ = bg_##Qp_ % 3, b_ = bg_##Qp_ / 3; \
        const int r_ = (g_ == 0) ? 1 : (g_ == 1) ? 4 : 16, nbk_##Qp_ = 64 / r_, c_ = blk_##Qp_ / nbk_##Qp_, nblk_ = blk_##Qp_ % nbk_##Qp_; \
        const bf16* Qp_ = QKV + ((size_t)(((g_ * 3 + 0) * 16 + head_) * 2 + b_) * SEQ + c_ * (SEQ / r_)) * 128
#define DIL_KLOADP(dst, Kp_, nblk_, k5_) do { const int kj_ = 32 * (w + (k5_)) + l31; int j_ = 128 * ((nblk_) - 1) + kj_; j_ = j_ < 0 ? 0 : j_; \
            const bf16* krow_ = (Kp_) + (size_t)j_ * 128 + 8 * half; \
            _Pragma("unroll") for (int ks = 0; ks < 8; ++ks) dst[ks] = *(const GAS bf16x8*)(krow_ + 16 * ks); } while (0)
#define DIL_QLOADP(Qp_, nblk_) do { const bf16* qrow_ = (Qp_) + (size_t)(128 * (nblk_) + 32 * w + l31) * 128 + 8 * half; \
            _Pragma("unroll") for (int ks = 0; ks < 8; ++ks) qf[ks] = *(const GAS bf16x8*)(qrow_ + 16 * ks); } while (0)
    for (int rep_ = 0; rep_ < DIL_REP; ++rep_) {
    bf16x8 qf[8], ka[8], kb[8], kc[8];
    if (F.vcu < 3072) { DIL_PARAMS(F.vcu, Qp0, nblk0, g0, b0, head0, r0, c0); const bf16* Kp0 = Qp0 + (size_t)16 * 2 * SEQ * 128;
        DIL_QLOADP(Qp0, nblk0); DIL_KLOADP(ka, Kp0, nblk0, 0); }
    for (int p = F.vcu; p < 3072; p += F.G) {
        DIL_PARAMS(p, Qp, nblk, g, b, head, r, c);
        const bf16* Kp = Qp + (size_t)16 * 2 * SEQ * 128; const bf16* Vp = Qp + (size_t)32 * 2 * SEQ * 128;
        const int qi = 32 * w + l31;
        f32x16 S[5];
#define DIL_QK(src, k5_) do { f32x16 acc_; _Pragma("unroll") for (int e = 0; e < 16; ++e) acc_[e] = 0.f; \
            _Pragma("unroll") for (int ks = 0; ks < 8; ++ks) acc_ = MFMA32(src[ks], qf[ks], acc_); S[k5_] = acc_; } while (0)
        DIL_KLOADP(kb, Kp, nblk, 1); DIL_KLOADP(kc, Kp, nblk, 2);
        DIL_QK(ka, 0);
        __builtin_amdgcn_sched_barrier(0);
        DIL_KLOADP(ka, Kp, nblk, 3);
        __builtin_amdgcn_sched_barrier(0);
        asm volatile("" ::: "memory");
        __builtin_amdgcn_s_barrier();
        asm volatile("" ::: "memory");
        DIL_QK(kb, 1); DIL_QK(kc, 2); DIL_QK(ka, 3); DIL_KLOADP(kb, Kp, nblk, 4); DIL_QK(kb, 4);
        __builtin_amdgcn_sched_barrier(0);
#undef DIL_QK
        { const int rl = lane >> 4, sl = lane & 15;
#pragma unroll
          for (int i = 0; i < 16; ++i) { const int kj = 64 * w + 4 * i + rl; int j = 128 * (nblk - 1) + kj; j = j < 0 ? 0 : j;
              const int ch = sl ^ (2 * (kj & 7));
              __builtin_amdgcn_global_load_lds((const unsigned*)(Vp + (size_t)j * 128 + 8 * ch), (LAS unsigned*)(vt + (64 * w + 4 * i) * 256), 16, 0, 0); } }
        __builtin_amdgcn_sched_barrier(0);
        const bool has_next = p + F.G < 3072;
        DIL_PARAMS((has_next ? p + F.G : p), Qpn, nblkn, gn, bn, headn, rn, cn); const bf16* Kpn = Qpn + (size_t)16 * 2 * SEQ * 128;
        if (has_next) { DIL_QLOADP(Qpn, nblkn); DIL_KLOADP(ka, Kpn, nblkn, 0); }
        __builtin_amdgcn_sched_barrier(0);
        float mx = -1e30f;
        {
            float fl = (float)(4 * half - l31);
            asm volatile("" : "+v"(fl));
            const float fk = (nblk == 0) ? (float)(32 * w + 4 * half - 128) : 1e9f;
#pragma unroll
            for (int k5 = 0; k5 < 5; ++k5)
#pragma unroll
                for (int e = 0; e < 16; ++e) { const float C = (float)(32 * k5 + (e & 3) + 8 * (e >> 2));
                    const float tt = fl + C; float bb = fminf(fminf(tt, 128.f - tt), fk + C); bb = fminf(bb, 0.f) * 1e30f;
                    const float x = S[k5][e] + bb; S[k5][e] = x; mx = fmaxf(mx, x); }
        }
        mx = fmaxf(mx, __shfl_xor(mx, 32));
        float sum = 0.f;
#pragma unroll
        for (int k5 = 0; k5 < 5; ++k5)
#pragma unroll
            for (int e = 0; e < 16; ++e) { const float pv = __expf(S[k5][e] - mx); S[k5][e] = pv; sum += pv; }
        sum += __shfl_xor(sum, 32);
        const float inv = 1.0f / sum, lse = mx + __logf(sum);
        v4u Pp[5][2];
#pragma unroll
        for (int k5 = 0; k5 < 5; ++k5)
#pragma unroll
            for (int s = 0; s < 2; ++s) Pp[k5][s] = (v4u){pk2(S[k5][8 * s + 0] * inv, S[k5][8 * s + 1] * inv), pk2(S[k5][8 * s + 2] * inv, S[k5][8 * s + 3] * inv),
                                                           pk2(S[k5][8 * s + 4] * inv, S[k5][8 * s + 5] * inv), pk2(S[k5][8 * s + 6] * inv, S[k5][8 * s + 7] * inv)};
        if (has_next) asm volatile("s_waitcnt vmcnt(16)" ::: "memory"); else asm volatile("s_waitcnt vmcnt(0)" ::: "memory");
        __builtin_amdgcn_s_barrier();
        asm volatile("" ::: "memory");
        const int gI = lane >> 4, q4 = (lane & 15) >> 2, p4 = lane & 3;
        const int lc = (2 * (gI & 1) + (p4 >> 1)) ^ (2 * ((4 * half + q4) & 7));
        const LAS unsigned char* vrow = vt + (32 * w + 4 * half + q4) * 256 + 8 * (p4 & 1);
        const size_t mrow = (size_t)b * SEQ + c + r * (128 * nblk + qi);
        bf16* op = OG + ((size_t)g * M + mrow) * A_OUT + head * 128;
#pragma unroll
        for (int dp = 0; dp < 2; ++dp) {
            f32x16 O[2];
#pragma unroll
            for (int dt = 0; dt < 2; ++dt)
#pragma unroll
                for (int e = 0; e < 16; ++e) O[dt][e] = 0.f;
            const LAS unsigned char* vb2[2];
#pragma unroll
            for (int dt = 0; dt < 2; ++dt) vb2[dt] = vrow + 16 * (lc ^ (4 * (2 * dp + dt)));
#pragma unroll
            for (int k5 = 0; k5 < 5; ++k5)
#pragma unroll
                for (int s = 0; s < 2; ++s) {
                    const bf16x8 pb = __builtin_bit_cast(bf16x8, Pp[k5][s]);
#pragma unroll
                    for (int dt = 0; dt < 2; ++dt) {
                        const s16x4b a0 = vtr16(vb2[dt] + (32 * k5 + 16 * s) * 256), a1 = vtr16(vb2[dt] + (32 * k5 + 16 * s + 8) * 256);
                        const bf16x8 av = {a0[0], a0[1], a0[2], a0[3], a1[0], a1[1], a1[2], a1[3]};
                        O[dt] = MFMA32(av, pb, O[dt]); }
                }
#pragma unroll
            for (int dt = 0; dt < 2; ++dt)
#pragma unroll
                for (int k = 0; k < 4; ++k) { const unsigned long long v = (unsigned long long)pk2(O[dt][4 * k], O[dt][4 * k + 1]) | ((unsigned long long)pk2(O[dt][4 * k + 2], O[dt][4 * k + 3]) << 32);
                    *(GAS unsigned long long*)(op + 32 * (2 * dp + dt) + 8 * k + 4 * half) = v; }
            __builtin_amdgcn_sched_barrier(0);
        }
        if (half == 0) LSE[((size_t)g * M + mrow) * 16 + head] = lse;
    }
    asm volatile("s_waitcnt vmcnt(0)" ::: "memory");
    __syncthreads();
    }
#undef DIL_PARAMS
#undef DIL_KLOADP
#undef DIL_QLOADP
}
#else
__device__ __forceinline__ void dil_attn_phase(Frame& F) {
    const bf16* QKV = (const bf16*)(F.ws + WS_QKVA); bf16* OG = (bf16*)(F.ws + WS_OG); float* LSE = (float*)(F.ws + WS_LSE);
    const int hb = F.wave >> 2, w = F.wave & 3, lane = F.lane, l31 = lane & 31, half = lane >> 5;
    LAS unsigned char* vt = F.lds + RING_OFF + hb * 65536;
#ifndef DIL_REP
#define DIL_REP 1
#endif
#if DIL_STAGGER
    if (hb == 1) __syncthreads();
#endif
    for (int rep_ = 0; rep_ < DIL_REP; ++rep_)
#if DIL_RUN
    for (int p = F.vcu * ((3072 + F.G - 1) / F.G), pe = (p + (3072 + F.G - 1) / F.G < 3072 ? p + (3072 + F.G - 1) / F.G : 3072); p < pe; ++p) {
#else
    for (int p = F.vcu; p < 3072; p += F.G) {
#endif
        const int idx = 2 * p + hb;
        const int blk = idx & 63, head = (idx >> 6) & 15, bg = idx >> 10, g = bg % 3, b = bg / 3;
        const int r = (g == 0) ? 1 : (g == 1) ? 4 : 16, nbk = 64 / r, c = blk / nbk, nblk = blk % nbk;
        const int nsub = SEQ / r;
        const bf16* Qp = QKV + ((size_t)(((g * 3 + 0) * 16 + head) * 2 + b) * SEQ + c * nsub) * 128;
        const bf16* Kp = Qp + (size_t)16 * 2 * SEQ * 128; const bf16* Vp = Qp + (size_t)32 * 2 * SEQ * 128;
        __syncthreads();
        { const int rl = lane >> 4, sl = lane & 15;
#pragma unroll
          for (int i = 0; i < 16; ++i) { const int kj = 64 * w + 4 * i + rl; int j = 128 * (nblk - 1) + kj; j = j < 0 ? 0 : j;
              const int ch = sl ^ (2 * (kj & 7));
              __builtin_amdgcn_global_load_lds((const unsigned*)(Vp + (size_t)j * 128 + 8 * ch), (LAS unsigned*)(vt + (64 * w + 4 * i) * 256), 16, 0, 0); } }
        const int qi = 32 * w + l31;
        bf16x8 qf[8];
        { const bf16* qrow = Qp + (size_t)(128 * nblk + qi) * 128 + 8 * half;
#pragma unroll
          for (int ks = 0; ks < 8; ++ks) qf[ks] = *(const GAS bf16x8*)(qrow + 16 * ks); }
        f32x16 S[5];
#define DIL_KLOAD(dst, k5_) do { const int kj_ = 32 * (w + (k5_)) + l31; int j_ = 128 * (nblk - 1) + kj_; j_ = j_ < 0 ? 0 : j_; \
            const bf16* krow_ = Kp + (size_t)j_ * 128 + 8 * half; \
            _Pragma("unroll") for (int ks = 0; ks < 8; ++ks) dst[ks] = *(const GAS bf16x8*)(krow_ + 16 * ks); } while (0)
#define DIL_QK(src, k5_) do { f32x16 acc_; _Pragma("unroll") for (int e = 0; e < 16; ++e) acc_[e] = 0.f; \
            _Pragma("unroll") for (int ks = 0; ks < 8; ++ks) acc_ = MFMA32(src[ks], qf[ks], acc_); S[k5_] = acc_; } while (0)
        {
            bf16x8 ka[8], kb[8], kc[8];
            DIL_KLOAD(ka, 0); DIL_KLOAD(kb, 1); DIL_KLOAD(kc, 2);
            __builtin_amdgcn_sched_barrier(0);
            DIL_QK(ka, 0); DIL_QK(kb, 1); DIL_QK(kc, 2);
            __builtin_amdgcn_sched_barrier(0);
            DIL_KLOAD(ka, 3); DIL_KLOAD(kb, 4);
            __builtin_amdgcn_sched_barrier(0);
            DIL_QK(ka, 3); DIL_QK(kb, 4);
        }
#undef DIL_KLOAD
#undef DIL_QK
#if DIL_STAGGER
        asm volatile("s_waitcnt vmcnt(0)" ::: "memory");
        __syncthreads();
#endif
        float mx = -1e30f;
        {
            float fl = (float)(4 * half - l31);
            asm volatile("" : "+v"(fl));
            const float fk = (nblk == 0) ? (float)(32 * w + 4 * half - 128) : 1e9f;
#pragma unroll
            for (int k5 = 0; k5 < 5; ++k5)
#pragma unroll
                for (int e = 0; e < 16; ++e) { const float C = (float)(32 * k5 + (e & 3) + 8 * (e >> 2));
                    const float tt = fl + C; float bb = fminf(fminf(tt, 128.f - tt), fk + C); bb = fminf(bb, 0.f) * 1e30f;
                    const float x = S[k5][e] + bb; S[k5][e] = x; mx = fmaxf(mx, x); }
        }
        mx = fmaxf(mx, __shfl_xor(mx, 32));
        float sum = 0.f;
#pragma unroll
        for (int k5 = 0; k5 < 5; ++k5)
#pragma unroll
            for (int e = 0; e < 16; ++e) { const float pv = __expf(S[k5][e] - mx); S[k5][e] = pv; sum += pv; }
        sum += __shfl_xor(sum, 32);
        const float inv = 1.0f / sum, lse = mx + __logf(sum);
#if !DIL_STAGGER
        asm volatile("s_waitcnt vmcnt(0)" ::: "memory");
        __syncthreads();
#endif
        f32x16 O[4];
#pragma unroll
        for (int dt = 0; dt < 4; ++dt)
#pragma unroll
            for (int e = 0; e < 16; ++e) O[dt][e] = 0.f;
        const int gI = lane >> 4, q4 = (lane & 15) >> 2, p4 = lane & 3;
        const int lc = (2 * (gI & 1) + (p4 >> 1)) ^ (2 * ((4 * half + q4) & 7));
        const LAS unsigned char* vrow = vt + (32 * w + 4 * half + q4) * 256 + 8 * (p4 & 1);
        const LAS unsigned char* vb4[4];
#pragma unroll
        for (int dt = 0; dt < 4; ++dt) vb4[dt] = vrow + 16 * (lc ^ (4 * dt));
#pragma unroll
        for (int k5 = 0; k5 < 5; ++k5)
#pragma unroll
            for (int s = 0; s < 2; ++s) {
                bf16x8 pb;
                { const unsigned u0 = pk2(S[k5][8 * s + 0] * inv, S[k5][8 * s + 1] * inv), u1 = pk2(S[k5][8 * s + 2] * inv, S[k5][8 * s + 3] * inv),
                                 u2 = pk2(S[k5][8 * s + 4] * inv, S[k5][8 * s + 5] * inv), u3 = pk2(S[k5][8 * s + 6] * inv, S[k5][8 * s + 7] * inv);
                  const v4u uu = (v4u){u0, u1, u2, u3}; pb = __builtin_bit_cast(bf16x8, uu); }
#pragma unroll
                for (int dt = 0; dt < 4; ++dt) {
                    const s16x4b a0 = vtr16(vb4[dt] + (32 * k5 + 16 * s) * 256), a1 = vtr16(vb4[dt] + (32 * k5 + 16 * s + 8) * 256);
                    const bf16x8 av = {a0[0], a0[1], a0[2], a0[3], a1[0], a1[1], a1[2], a1[3]};
                    O[dt] = MFMA32(av, pb, O[dt]); }
            }
        const size_t mrow = (size_t)b * SEQ + c + r * (128 * nblk + qi);
        bf16* op = OG + ((size_t)g * M + mrow) * A_OUT + head * 128;
#pragma unroll
        for (int dt = 0; dt < 4; ++dt)
#pragma unroll
            for (int k = 0; k < 4; ++k) { const unsigned long long v = (unsigned long long)pk2(O[dt][4 * k], O[dt][4 * k + 1]) | ((unsigned long long)pk2(O[dt][4 * k + 2], O[dt][4 * k + 3]) << 32);
                *(GAS unsigned long long*)(op + 32 * dt + 8 * k + 4 * half) = v; }
        if (half == 0) LSE[((size_t)g * M + mrow) * 16 + head] = lse;
    }
#if DIL_STAGGER
    if (hb == 0) __syncthreads();
#endif
    __syncthreads();
}
#endif
#if MERGE2
__device__ __forceinline__ void merge_phase(Frame& F) {
    const bf16* OG = (const bf16*)(F.ws + WS_OG); const float* LSE = (const float*)(F.ws + WS_LSE); bf16* OM = (bf16*)(F.ws + WS_OMERGE);
    const int gw = F.vcu * NWAVES + F.wave, NGW = F.G * NWAVES, lane = F.lane, h16 = lane & 15;
    static_assert(WOUTA_I8, "MERGE2 writes the int8 row");
    for (int i_ = 0, m; (m = xrow(gw, NGW, F.G, i_)) >= 0; ++i_) {
        const float l0 = LSE[((size_t)0 * M + m) * 16 + h16], l1 = LSE[((size_t)1 * M + m) * 16 + h16], l2 = LSE[((size_t)2 * M + m) * 16 + h16];
        const size_t off = (size_t)m * A_OUT + 8 * lane;
        v4u va[4], vb[4], vc[4];
#pragma unroll
        for (int c4 = 0; c4 < 4; ++c4) { va[c4] = *(const GAS v4u*)(OG + off + 512 * c4); vb[c4] = *(const GAS v4u*)(OG + (size_t)M * A_OUT + off + 512 * c4); vc[c4] = *(const GAS v4u*)(OG + (size_t)2 * M * A_OUT + off + 512 * c4); }
        __builtin_amdgcn_sched_barrier(0);
        const float mx = fmaxf(l0, fmaxf(l1, l2)); float e0 = __expf(l0 - mx), e1 = __expf(l1 - mx), e2 = __expf(l2 - mx); const float inv0 = 1.0f / (e0 + e1 + e2); e0 *= inv0; e1 *= inv0; e2 *= inv0;
        float ov[32]; float am = 0.f;
#pragma unroll
        for (int c4 = 0; c4 < 4; ++c4) { const int hd = 4 * c4 + (lane >> 4);
            const float f0 = __shfl(e0, hd), f1 = __shfl(e1, hd), f2 = __shfl(e2, hd);
#pragma unroll
            for (int k = 0; k < 4; ++k) { const float lo = f0 * bf_lo(va[c4][k]) + f1 * bf_lo(vb[c4][k]) + f2 * bf_lo(vc[c4][k]), hi = f0 * bf_hi(va[c4][k]) + f1 * bf_hi(vb[c4][k]) + f2 * bf_hi(vc[c4][k]);
                ov[8 * c4 + 2 * k] = lo; ov[8 * c4 + 2 * k + 1] = hi; am = fmaxf(am, fmaxf(__builtin_fabsf(lo), __builtin_fabsf(hi))); } }
        am = wave_max(am); const float inv = am > 0.f ? 127.0f / am : 0.f;
        unsigned char* o8 = (unsigned char*)OM + (size_t)m * A_OUT + 8 * lane;
#pragma unroll
        for (int c4 = 0; c4 < 4; ++c4) { const unsigned long long o = (unsigned long long)pk_i8x4(ov[8 * c4] * inv, ov[8 * c4 + 1] * inv, ov[8 * c4 + 2] * inv, ov[8 * c4 + 3] * inv)
                | ((unsigned long long)pk_i8x4(ov[8 * c4 + 4] * inv, ov[8 * c4 + 5] * inv, ov[8 * c4 + 6] * inv, ov[8 * c4 + 7] * inv) << 32);
            *(GAS unsigned long long*)(o8 + 512 * c4) = o; }
        if (lane == 0) ((float*)(F.ws + WS_SROW_OM))[m] = am * (1.0f / 127.0f);
    }
}
#else
__device__ __forceinline__ void merge_phase(Frame& F) {
    const bf16* OG = (const bf16*)(F.ws + WS_OG); const float* LSE = (const float*)(F.ws + WS_LSE); bf16* OM = (bf16*)(F.ws + WS_OMERGE);
    const int gw = F.vcu * NWAVES + F.wave, NGW = F.G * NWAVES, lane = F.lane, head = lane >> 2, d0 = (lane & 3) * 32;
    for (int i_ = 0, m; (m = xrow(gw, NGW, F.G, i_)) >= 0; ++i_) {
        const float l0 = LSE[((size_t)0 * M + m) * 16 + head], l1 = LSE[((size_t)1 * M + m) * 16 + head], l2 = LSE[((size_t)2 * M + m) * 16 + head];
        const float mx = fmaxf(l0, fmaxf(l1, l2)); float e0 = __expf(l0 - mx), e1 = __expf(l1 - mx), e2 = __expf(l2 - mx); const float inv = 1.0f / (e0 + e1 + e2); e0 *= inv; e1 *= inv; e2 *= inv;
        const size_t off = (size_t)m * A_OUT + head * 128 + d0;
        v4u va[4], vb[4], vc[4];
#pragma unroll
        for (int c4 = 0; c4 < 4; ++c4) { va[c4] = *(const GAS v4u*)(OG + off + 8 * c4); vb[c4] = *(const GAS v4u*)(OG + (size_t)M * A_OUT + off + 8 * c4); vc[c4] = *(const GAS v4u*)(OG + (size_t)2 * M * A_OUT + off + 8 * c4); }
        if (WOUTA_I8) {
            float ov[32]; float am = 0.f;
#pragma unroll
            for (int c4 = 0; c4 < 4; ++c4)
#pragma unroll
                for (int k = 0; k < 4; ++k) { const float lo = e0 * bf_lo(va[c4][k]) + e1 * bf_lo(vb[c4][k]) + e2 * bf_lo(vc[c4][k]), hi = e0 * bf_hi(va[c4][k]) + e1 * bf_hi(vb[c4][k]) + e2 * bf_hi(vc[c4][k]);
                    ov[8 * c4 + 2 * k] = lo; ov[8 * c4 + 2 * k + 1] = hi; am = fmaxf(am, fmaxf(__builtin_fabsf(lo), __builtin_fabsf(hi))); }
            am = wave_max(am); const float inv = am > 0.f ? 127.0f / am : 0.f;
            unsigned char* o8 = (unsigned char*)OM + (size_t)m * A_OUT + head * 128 + d0;
#pragma unroll
            for (int h2 = 0; h2 < 2; ++h2) { v4u o;
#pragma unroll
                for (int k = 0; k < 4; ++k) o[k] = pk_i8x4(ov[16 * h2 + 4 * k] * inv, ov[16 * h2 + 4 * k + 1] * inv, ov[16 * h2 + 4 * k + 2] * inv, ov[16 * h2 + 4 * k + 3] * inv);
                *(GAS v4u*)(o8 + 16 * h2) = o; }
            if (lane == 0) ((float*)(F.ws + WS_SROW_OM))[m] = am * (1.0f / 127.0f);
        } else {
#pragma unroll
        for (int c4 = 0; c4 < 4; ++c4) {
            const v4u a = va[c4], bq = vb[c4], cq = vc[c4];
            v4u o;
#pragma unroll
            for (int k = 0; k < 4; ++k) { const float lo = e0 * bf_lo(a[k]) + e1 * bf_lo(bq[k]) + e2 * bf_lo(cq[k]), hi = e0 * bf_hi(a[k]) + e1 * bf_hi(bq[k]) + e2 * bf_hi(cq[k]); o[k] = pk2(lo, hi); }
            *(GAS v4u*)(OM + off + 8 * c4) = o; } }
    }
}
#endif
__device__ __forceinline__ void idx_prep_phase(Frame& F, const Args& a) {
    const bf16* IQL = (const bf16*)(F.ws + WS_IQL); const float* IKW = (const float*)(F.ws + WS_IKW); bf16* IQLN = (bf16*)(F.ws + WS_IQLN); bf16* IKB = (bf16*)(F.ws + WS_IKB); float* IWS = (float*)(F.ws + WS_IWS);
    const float* rope = (const float*)(F.ws + WS_ROPE); const float* gq = (const float*)a.in[9]; const float* kw = (const float*)a.in[11]; const float* kb = (const float*)a.in[12];
    const int gw = F.vcu * NWAVES + F.wave, NGW = F.G * NWAVES, lane = F.lane;
    for (int i_ = 0, m; (m = xrow(gw, NGW, F.G, i_)) >= 0; ++i_) {
        const v4u x0 = *(const GAS v4u*)(IQL + (size_t)m * 1024 + 8 * lane), x1 = *(const GAS v4u*)(IQL + (size_t)m * 1024 + 512 + 8 * lane);
        float xv[16];
#pragma unroll
        for (int k = 0; k < 4; ++k) { xv[2 * k] = bf_lo(x0[k]); xv[2 * k + 1] = bf_hi(x0[k]); xv[8 + 2 * k] = bf_lo(x1[k]); xv[8 + 2 * k + 1] = bf_hi(x1[k]); }
        float ss = 0.f;
#pragma unroll
        for (int k = 0; k < 16; ++k) ss += xv[k] * xv[k];
        const float rs = 1.0f / sqrtf(wave_sum(ss) * (1.f / 1024.f) + NORM_EPS);
        v4u o0, o1;
#pragma unroll
        for (int k = 0; k < 4; ++k) { o0[k] = pk2(xv[2 * k] * rs * gq[8 * lane + 2 * k], xv[2 * k + 1] * rs * gq[8 * lane + 2 * k + 1]);
                                      o1[k] = pk2(xv[8 + 2 * k] * rs * gq[512 + 8 * lane + 2 * k], xv[8 + 2 * k + 1] * rs * gq[512 + 8 * lane + 2 * k + 1]); }
        if (IDXG_I8) {
            float nv[16]; float am = 0.f;
#pragma unroll
            for (int k = 0; k < 8; ++k) { nv[k] = xv[k] * rs * gq[8 * lane + k]; nv[8 + k] = xv[8 + k] * rs * gq[512 + 8 * lane + k]; am = fmaxf(am, fmaxf(__builtin_fabsf(nv[k]), __builtin_fabsf(nv[8 + k]))); }
            am = wave_max(am); const float inv = am > 0.f ? 127.0f / am : 0.f;
            unsigned char* q8 = (unsigned char*)IQLN + (size_t)m * 1024;
            *(GAS unsigned long long*)(q8 + 8 * lane) = (unsigned long long)pk_i8x4(nv[0] * inv, nv[1] * inv, nv[2] * inv, nv[3] * inv) | ((unsigned long long)pk_i8x4(nv[4] * inv, nv[5] * inv, nv[6] * inv, nv[7] * inv) << 32);
            *(GAS unsigned long long*)(q8 + 512 + 8 * lane) = (unsigned long long)pk_i8x4(nv[8] * inv, nv[9] * inv, nv[10] * inv, nv[11] * inv) | ((unsigned long long)pk_i8x4(nv[12] * inv, nv[13] * inv, nv[14] * inv, nv[15] * inv) << 32);
            if (lane == 0) ((float*)(F.ws + WS_SROW_IQ))[m] = am * (1.0f / 127.0f);
        } else { *(GAS v4u*)(IQLN + (size_t)m * 1024 + 8 * lane) = o0; *(GAS v4u*)(IQLN + (size_t)m * 1024 + 512 + 8 * lane) = o1; }
        const float k1 = IKW[(size_t)m * 256 + lane], k2 = IKW[(size_t)m * 256 + 64 + lane];
        const float mu = wave_sum(k1 + k2) * (1.f / 128.f); const float c1 = k1 - mu, c2 = k2 - mu;
        const float rv = 1.0f / sqrtf(wave_sum(c1 * c1 + c2 * c2) * (1.f / 128.f) + NORM_EPS);
        const float y1 = c1 * rv * kw[lane] + kb[lane], y2 = c2 * rv * kw[64 + lane] + kb[64 + lane];
        const float cs = rope[(size_t)m * 128 + lane], sn = rope[(size_t)m * 128 + 64 + lane];
        if (IDX_I8) { const float o1 = y1 * cs - y2 * sn, o2 = y2 * cs + y1 * sn; const float am = wave_max(fmaxf(__builtin_fabsf(o1), __builtin_fabsf(o2))); const float inv = am > 0.f ? 127.0f / am : 0.f;
            unsigned char* k8 = (unsigned char*)IKB + (size_t)m * 128;
            k8[lane] = (unsigned char)((int)__builtin_rintf(o1 * inv) & 255); k8[64 + lane] = (unsigned char)((int)__builtin_rintf(o2 * inv) & 255);
            if (lane == 0) ((float*)(F.ws + WS_SK))[m] = am * (1.0f / 127.0f); }
        else if (IDX_F8) { unsigned char* k8 = (unsigned char*)IKB + (size_t)m * 128;
            k8[lane] = (unsigned char)__builtin_amdgcn_cvt_pk_fp8_f32(y1 * cs - y2 * sn, 0.f, 0, false); k8[64 + lane] = (unsigned char)__builtin_amdgcn_cvt_pk_fp8_f32(y2 * cs + y1 * sn, 0.f, 0, false); }
        else { IKB[(size_t)m * 128 + lane] = (bf16)f2bf(y1 * cs - y2 * sn); IKB[(size_t)m * 128 + 64 + lane] = (bf16)f2bf(y2 * cs + y1 * sn); }
        if (lane < 32) IWS[(size_t)m * 32 + lane] = IKW[(size_t)m * 256 + 128 + lane] * IWSCALE;
    }
}
typedef short s16x2_t __attribute__((ext_vector_type(2)));
__device__ __forceinline__ unsigned pkmax0(unsigned x) { const s16x2_t z = {0, 0}; return __builtin_bit_cast(unsigned, __builtin_elementwise_max(__builtin_bit_cast(s16x2_t, x), z)); }
typedef int v8i_idx __attribute__((ext_vector_type(8)));
__device__ __forceinline__ void idx_score_phase_f8(Frame& F) {
    const unsigned char* IQ8 = (const unsigned char*)(F.ws + WS_IQ); const unsigned char* IK8 = (const unsigned char*)(F.ws + WS_IKB); const float* IWS = (const float*)(F.ws + WS_IWS); float* SC = (float*)(F.ws + WS_SCORE);
    const int w = F.wave, lane = F.lane, l31 = lane & 31, half = lane >> 5;
    constexpr int NB = 4, NQ = 4;
    LAS unsigned char* ring = F.lds + RING_OFF;
    const int dmaR = 8 * w + (lane >> 3), dmaCh = (lane & 7) ^ ((dmaR >> 1) & 7);
    const int fsw = (l31 >> 1) & 7;
    for (int i = blockIdx.x; i < 512; i += F.G) {
        const int b = i >> 8, jj = i & 255, qb = (b == 0) ? jj : 255 - jj;
        const int t0 = 32 * qb + NQ * w;
        v8i_idx af[NQ][2]; bf16x8 wf[NQ][2];
#pragma unroll
        for (int q = 0; q < NQ; ++q) { const size_t m = (size_t)b * SEQ + t0 + q; const unsigned char* arow = IQ8 + m * 4096 + l31 * 128 + 32 * half;
#pragma unroll
            for (int ks = 0; ks < 2; ++ks) { const v4u a0 = *(const GAS v4u*)(arow + 64 * ks), a1 = *(const GAS v4u*)(arow + 64 * ks + 16);
                af[q][ks] = (v8i_idx){(int)a0.x, (int)a0.y, (int)a0.z, (int)a0.w, (int)a1.x, (int)a1.y, (int)a1.z, (int)a1.w}; }
#pragma unroll
            for (int s2 = 0; s2 < 2; ++s2) { const f32x4 w0 = *(const GAS f32x4*)(IWS + m * 32 + 16 * s2 + 4 * half), w1 = *(const GAS f32x4*)(IWS + m * 32 + 16 * s2 + 8 + 4 * half);
                const v4u uu = (v4u){pk2(w0.x, w0.y), pk2(w0.z, w0.w), pk2(w1.x, w1.y), pk2(w1.z, w1.w)}; wf[q][s2] = __builtin_bit_cast(bf16x8, uu); } }
        const int ntrip = (qb >> 1) + 1;
        const unsigned char* ksrc = IK8 + ((size_t)b * SEQ + dmaR) * 128 + 16 * dmaCh;
        float* scb = SC + ((size_t)b * SEQ + t0) * 8192 + l31;
#define IDX_DMA(dt_) do { const int dtc_ = (dt_) < 127 ? (dt_) : 127; \
            __builtin_amdgcn_global_load_lds((const unsigned*)(ksrc + (size_t)(64 * dtc_) * 128), (LAS unsigned*)(ring + ((dt_) & (NB - 1)) * 8192 + w * 1024), 16, 0, 0); } while (0)
        __syncthreads();
#pragma unroll
        for (int j = 0; j < NB - 1; ++j) IDX_DMA(j);
        for (int t = 0; t < ntrip; ++t) {
            if (t >= 3) asm volatile("s_waitcnt vmcnt(26)" ::: "memory");
            else if (t == 0) asm volatile("s_waitcnt vmcnt(2)" ::: "memory"); else if (t == 1) asm volatile("s_waitcnt vmcnt(10)" ::: "memory"); else asm volatile("s_waitcnt vmcnt(18)" ::: "memory");
            __builtin_amdgcn_s_barrier();
            asm volatile("" ::: "memory");
            IDX_DMA(t + NB - 1);
#pragma unroll
            for (int tt = 0; tt < 2; ++tt) {
                const LAS unsigned char* rb = ring + (t & (NB - 1)) * 8192 + (32 * tt + l31) * 128;
                v8i_idx bfr[2];
#pragma unroll
                for (int ks = 0; ks < 2; ++ks) { const v4u b0 = *(const LAS v4u*)(rb + 16 * ((4 * ks + 2 * half) ^ fsw)), b1 = *(const LAS v4u*)(rb + 16 * ((4 * ks + 2 * half + 1) ^ fsw));
                    bfr[ks] = (v8i_idx){(int)b0.x, (int)b0.y, (int)b0.z, (int)b0.w, (int)b1.x, (int)b1.y, (int)b1.z, (int)b1.w}; }
#pragma unroll
                for (int q = 0; q < NQ; ++q) { f32x16 acc;
#pragma unroll
                    for (int e = 0; e < 16; ++e) acc[e] = 0.f;
                    acc = __builtin_amdgcn_mfma_scale_f32_32x32x64_f8f6f4(af[q][0], bfr[0], acc, 0, 0, 0, 0, 0, 0);
                    acc = __builtin_amdgcn_mfma_scale_f32_32x32x64_f8f6f4(af[q][1], bfr[1], acc, 0, 0, 0, 0, 0, 0);
                    const v4u x0 = (v4u){pkmax0(pg8::cvt_pk_bf16(acc[0], acc[1])), pkmax0(pg8::cvt_pk_bf16(acc[2], acc[3])), pkmax0(pg8::cvt_pk_bf16(acc[4], acc[5])), pkmax0(pg8::cvt_pk_bf16(acc[6], acc[7]))};
                    const v4u x1 = (v4u){pkmax0(pg8::cvt_pk_bf16(acc[8], acc[9])), pkmax0(pg8::cvt_pk_bf16(acc[10], acc[11])), pkmax0(pg8::cvt_pk_bf16(acc[12], acc[13])), pkmax0(pg8::cvt_pk_bf16(acc[14], acc[15]))};
                    f32x16 y;
#pragma unroll
                    for (int e = 0; e < 16; ++e) y[e] = 0.f;
                    y = MFMA32(wf[q][0], __builtin_bit_cast(bf16x8, x0), y); y = MFMA32(wf[q][1], __builtin_bit_cast(bf16x8, x1), y);
                    scb[(size_t)q * 8192 + 64 * t + 32 * tt] = y[0]; }
            }
        }
        asm volatile("s_waitcnt vmcnt(0)" ::: "memory");
#undef IDX_DMA
    }
}
typedef int i32x16_t __attribute__((ext_vector_type(16)));
__device__ __forceinline__ void idx_score_phase_i8(Frame& F) {
    const unsigned char* IQ8 = (const unsigned char*)(F.ws + WS_IQ); const unsigned char* IK8 = (const unsigned char*)(F.ws + WS_IKB); const float* IWS = (const float*)(F.ws + WS_IWS); float* SC = (float*)(F.ws + WS_SCORE);
    const int w = F.wave, lane = F.lane, l31 = lane & 31, half = lane >> 5;
    constexpr int NB = 4, NQ = 4;
    LAS unsigned char* ring = F.lds + RING_OFF;
    const int dmaR = 8 * w + (lane >> 3), dmaCh = (lane & 7) ^ ((dmaR >> 1) & 7);
    const int fsw = (l31 >> 1) & 7;
    for (int i = blockIdx.x; i < 512; i += F.G) {
        const int b = i >> 8, jj = i & 255, qb = (b == 0) ? jj : 255 - jj;
        const int t0 = 32 * qb + NQ * w;
        pg8::v4i_t af[NQ][4]; bf16x8 wf[NQ][2];
#pragma unroll
        for (int q = 0; q < NQ; ++q) { const size_t m = (size_t)b * SEQ + t0 + q; const bf16* arow = (const bf16*)IQ8 + m * 4096 + l31 * 128 + 16 * half;
            v4u raw[4][2]; float am = 0.f;
#pragma unroll
            for (int ks = 0; ks < 4; ++ks) { raw[ks][0] = *(const GAS v4u*)(arow + 32 * ks); raw[ks][1] = *(const GAS v4u*)(arow + 32 * ks + 8);
#pragma unroll
                for (int e = 0; e < 2; ++e)
#pragma unroll
                    for (int c = 0; c < 4; ++c) am = fmaxf(am, fmaxf(__builtin_fabsf(bf_lo(raw[ks][e][c])), __builtin_fabsf(bf_hi(raw[ks][e][c])))); }
            am = fmaxf(am, __shfl_xor(am, 32));
            const float inv = am > 0.f ? 127.0f / am : 0.f, aq = am * (1.0f / 127.0f);
#pragma unroll
            for (int ks = 0; ks < 4; ++ks) { pg8::v4i_t o;
#pragma unroll
                for (int e = 0; e < 2; ++e) { o[2 * e] = (int)pk_i8x4(bf_lo(raw[ks][e][0]) * inv, bf_hi(raw[ks][e][0]) * inv, bf_lo(raw[ks][e][1]) * inv, bf_hi(raw[ks][e][1]) * inv);
                                              o[2 * e + 1] = (int)pk_i8x4(bf_lo(raw[ks][e][2]) * inv, bf_hi(raw[ks][e][2]) * inv, bf_lo(raw[ks][e][3]) * inv, bf_hi(raw[ks][e][3]) * inv); }
                af[q][ks] = o; }
#pragma unroll
            for (int s2 = 0; s2 < 2; ++s2) { float wq[8];
#pragma unroll
                for (int j = 0; j < 8; ++j) { const int hd = 16 * s2 + 8 * (j >> 2) + 4 * half + (j & 3); wq[j] = IWS[m * 32 + hd] * __shfl(aq, hd); }
                const v4u uu = (v4u){pk2(wq[0], wq[1]), pk2(wq[2], wq[3]), pk2(wq[4], wq[5]), pk2(wq[6], wq[7])}; wf[q][s2] = __builtin_bit_cast(bf16x8, uu); } }
        const int ntrip = (qb >> 1) + 1;
        const unsigned char* ksrc = IK8 + ((size_t)b * SEQ + dmaR) * 128 + 16 * dmaCh;
        float* scb = SC + ((size_t)b * SEQ + t0) * 8192 + l31;
        const float* SKp = (const float*)(F.ws + WS_SK) + (size_t)b * SEQ;
#define IDX_DMA(dt_) do { const int dtc_ = (dt_) < 127 ? (dt_) : 127; \
            __builtin_amdgcn_global_load_lds((const unsigned*)(ksrc + (size_t)(64 * dtc_) * 128), (LAS unsigned*)(ring + ((dt_) & (NB - 1)) * 8192 + w * 1024), 16, 0, 0); } while (0)
#if IDX_PIPE
        LAS unsigned char* sclw = ring + NB * 8192 + w * (NB * 256);
#define IDX_SDMA(dt_) do { const int dtc_ = (dt_) < 127 ? (dt_) : 127; \
            __builtin_amdgcn_global_load_lds((const unsigned*)(SKp + 64 * dtc_ + lane), (LAS unsigned*)(sclw + ((dt_) & (NB - 1)) * 256), 4, 0, 0); } while (0)
        __syncthreads();
#pragma unroll
        for (int j = 0; j < NB - 1; ++j) { IDX_DMA(j); IDX_SDMA(j); }
        for (int t = 0; t < ntrip; ++t) {
            if (t >= 3) asm volatile("s_waitcnt vmcnt(28)" ::: "memory");
            else if (t == 0) asm volatile("s_waitcnt vmcnt(4)" ::: "memory"); else if (t == 1) asm volatile("s_waitcnt vmcnt(12)" ::: "memory"); else asm volatile("s_waitcnt vmcnt(20)" ::: "memory");
            __builtin_amdgcn_s_barrier();
            asm volatile("" ::: "memory");
            IDX_DMA(t + NB - 1); IDX_SDMA(t + NB - 1);
            __builtin_amdgcn_sched_barrier(0);
            pg8::v4i_t bfr[2][4]; float skv[2];
#pragma unroll
            for (int tt = 0; tt < 2; ++tt) { const LAS unsigned char* rb = ring + (t & (NB - 1)) * 8192 + (32 * tt + l31) * 128;
#pragma unroll
                for (int ks = 0; ks < 4; ++ks) bfr[tt][ks] = *(const LAS pg8::v4i_t*)(rb + 16 * ((2 * ks + half) ^ fsw));
                skv[tt] = *(const LAS float*)(sclw + (t & (NB - 1)) * 256 + (32 * tt + l31) * 4); }
            i32x16_t accn;
#pragma unroll
            for (int e = 0; e < 16; ++e) accn[e] = 0;
#pragma unroll
            for (int ks = 0; ks < 4; ++ks) accn = __builtin_amdgcn_mfma_i32_32x32x32_i8(af[0][ks], bfr[0][ks], accn, 0, 0, 0);
            __builtin_amdgcn_sched_barrier(0);
            unsigned xo[8] = {0u, 0u, 0u, 0u, 0u, 0u, 0u, 0u};
#define IDX_CP(j_) xn[j_] = pkmax0(pg8::cvt_pk_bf16((float)acci[2 * (j_)], (float)acci[2 * (j_) + 1]))
#define IDX_FENCE __builtin_amdgcn_sched_barrier(0)
            float yk = 0.f;
#pragma unroll
            for (int it = 0; it < 10; ++it) {
                const i32x16_t acci = accn; f32x16 y; unsigned xn[8];
                const int qp = (it - 1) & 3, qs = (it - 2) & 3, ts = (it - 2) >> 2, q1 = (it + 1) & 3, t1 = (it + 1) >> 2;
                if (it < 7) {
#pragma unroll
                    for (int e = 0; e < 16; ++e) accn[e] = 0;
                    accn = __builtin_amdgcn_mfma_i32_32x32x32_i8(af[q1][0], bfr[t1][0], accn, 0, 0, 0); }
                if (it < 8) { IDX_CP(0); IDX_CP(1); } IDX_FENCE;
                if (it < 7) accn = __builtin_amdgcn_mfma_i32_32x32x32_i8(af[q1][1], bfr[t1][1], accn, 0, 0, 0);
                if (it < 8) { IDX_CP(2); IDX_CP(3); } IDX_FENCE;
                if (it < 7) accn = __builtin_amdgcn_mfma_i32_32x32x32_i8(af[q1][2], bfr[t1][2], accn, 0, 0, 0);
                if (it < 8) { IDX_CP(4); }
                if (it >= 2) scb[(size_t)qs * 8192 + 64 * t + 32 * ts] = yk * skv[ts];
                IDX_FENCE;
                if (it < 7) accn = __builtin_amdgcn_mfma_i32_32x32x32_i8(af[q1][3], bfr[t1][3], accn, 0, 0, 0);
                if (it < 8) { IDX_CP(5); } IDX_FENCE;
                if (it >= 1 && it < 9) {
#pragma unroll
                    for (int e = 0; e < 16; ++e) y[e] = 0.f;
                    y = MFMA32(wf[qp][0], __builtin_bit_cast(bf16x8, ((v4u){xo[0], xo[1], xo[2], xo[3]})), y); }
                if (it < 8) { IDX_CP(6); IDX_CP(7); } IDX_FENCE;
                if (it >= 1 && it < 9) { y = MFMA32(wf[qp][1], __builtin_bit_cast(bf16x8, ((v4u){xo[4], xo[5], xo[6], xo[7]})), y); yk = y[0]; }
                IDX_FENCE;
                if (it < 8) {
#pragma unroll
                    for (int j = 0; j < 8; ++j) xo[j] = xn[j]; }
            }
#undef IDX_CP
#undef IDX_FENCE
            __builtin_amdgcn_sched_barrier(0);
        }
#undef IDX_SDMA
#else
        __syncthreads();
#pragma unroll
        for (int j = 0; j < NB - 1; ++j) IDX_DMA(j);
        for (int t = 0; t < ntrip; ++t) {
            if (t >= 3) asm volatile("s_waitcnt vmcnt(32)" ::: "memory");
            else if (t == 0) asm volatile("s_waitcnt vmcnt(2)" ::: "memory"); else if (t == 1) asm volatile("s_waitcnt vmcnt(12)" ::: "memory"); else asm volatile("s_waitcnt vmcnt(22)" ::: "memory");
            __builtin_amdgcn_s_barrier();
            asm volatile("" ::: "memory");
            IDX_DMA(t + NB - 1);
            float skv[2];
#pragma unroll
            for (int tt = 0; tt < 2; ++tt) { const int kidx = 64 * t + 32 * tt + l31; skv[tt] = SKp[kidx < SEQ ? kidx : SEQ - 1]; }
            asm volatile("" ::: "memory");
#pragma unroll
            for (int tt = 0; tt < 2; ++tt) {
                const LAS unsigned char* rb = ring + (t & (NB - 1)) * 8192 + (32 * tt + l31) * 128;
                pg8::v4i_t bfr[4];
#pragma unroll
                for (int ks = 0; ks < 4; ++ks) bfr[ks] = *(const LAS pg8::v4i_t*)(rb + 16 * ((2 * ks + half) ^ fsw));
#pragma unroll
                for (int q = 0; q < NQ; ++q) { i32x16_t acci;
#pragma unroll
                    for (int e = 0; e < 16; ++e) acci[e] = 0;
#pragma unroll
                    for (int ks = 0; ks < 4; ++ks) acci = __builtin_amdgcn_mfma_i32_32x32x32_i8(af[q][ks], bfr[ks], acci, 0, 0, 0);
                    const f32x16 acc = __builtin_convertvector(acci, f32x16);
                    const v4u x0 = (v4u){pkmax0(pg8::cvt_pk_bf16(acc[0], acc[1])), pkmax0(pg8::cvt_pk_bf16(acc[2], acc[3])), pkmax0(pg8::cvt_pk_bf16(acc[4], acc[5])), pkmax0(pg8::cvt_pk_bf16(acc[6], acc[7]))};
                    const v4u x1 = (v4u){pkmax0(pg8::cvt_pk_bf16(acc[8], acc[9])), pkmax0(pg8::cvt_pk_bf16(acc[10], acc[11])), pkmax0(pg8::cvt_pk_bf16(acc[12], acc[13])), pkmax0(pg8::cvt_pk_bf16(acc[14], acc[15]))};
                    f32x16 y;
#pragma unroll
                    for (int e = 0; e < 16; ++e) y[e] = 0.f;
                    y = MFMA32(wf[q][0], __builtin_bit_cast(bf16x8, x0), y); y = MFMA32(wf[q][1], __builtin_bit_cast(bf16x8, x1), y);
                    scb[(size_t)q * 8192 + 64 * t + 32 * tt] = y[0] * skv[tt]; }
            }
        }
#endif
        asm volatile("s_waitcnt vmcnt(0)" ::: "memory");
#undef IDX_DMA
    }
}
__device__ __forceinline__ void idx_score_phase(Frame& F) {
    const bf16* IQ = (const bf16*)(F.ws + WS_IQ); const bf16* IKB = (const bf16*)(F.ws + WS_IKB); const float* IWS = (const float*)(F.ws + WS_IWS); float* SC = (float*)(F.ws + WS_SCORE);
    const int w = F.wave, lane = F.lane, l31 = lane & 31, half = lane >> 5;
    constexpr int NB = 8, NQ = 4;
    LAS unsigned char* ring = F.lds + RING_OFF;
    const int dmaR = 4 * w + (lane >> 4), dmaCh = (lane & 15) ^ (dmaR & 15);
    const int rdoff = l31 * 256;
    for (int i = blockIdx.x; i < 512; i += F.G) {
        const int b = i >> 8, jj = i & 255, qb = (b == 0) ? jj : 255 - jj;
        const int t0 = 32 * qb + NQ * w;
        bf16x8 af[NQ][8], wf[NQ][2];
#pragma unroll
        for (int q = 0; q < NQ; ++q) { const size_t m = (size_t)b * SEQ + t0 + q; const bf16* arow = IQ + m * 4096 + l31 * 128 + 8 * half;
#pragma unroll
            for (int ks = 0; ks < 8; ++ks) af[q][ks] = *(const GAS bf16x8*)(arow + 16 * ks);
#pragma unroll
            for (int s2 = 0; s2 < 2; ++s2) { const f32x4 w0 = *(const GAS f32x4*)(IWS + m * 32 + 16 * s2 + 4 * half), w1 = *(const GAS f32x4*)(IWS + m * 32 + 16 * s2 + 8 + 4 * half);
                const v4u uu = (v4u){pk2(w0.x, w0.y), pk2(w0.z, w0.w), pk2(w1.x, w1.y), pk2(w1.z, w1.w)}; wf[q][s2] = __builtin_bit_cast(bf16x8, uu); } }
        const int npair = (qb + 2) >> 1;
        const bf16* ksrc = IKB + ((size_t)b * SEQ + dmaR) * 128 + 8 * dmaCh;
        float* scb = SC + ((size_t)b * SEQ + t0) * 8192 + l31;
#define IDX_DMA(kt_) do { const int ktc_ = (kt_) < 255 ? (kt_) : 255; \
            __builtin_amdgcn_global_load_lds((const unsigned*)(ksrc + (size_t)(32 * ktc_) * 128), (LAS unsigned*)(ring + ((kt_) & (NB - 1)) * 8192 + w * 1024), 16, 0, 0); } while (0)
        __syncthreads();
#pragma unroll
        for (int j = 0; j < NB - 2; ++j) IDX_DMA(j);
        for (int ip = 0; ip < npair; ++ip) {
            if (ip >= 3) asm volatile("s_waitcnt vmcnt(28)" ::: "memory");
            else if (ip == 0) asm volatile("s_waitcnt vmcnt(4)" ::: "memory"); else if (ip == 1) asm volatile("s_waitcnt vmcnt(12)" ::: "memory"); else asm volatile("s_waitcnt vmcnt(20)" ::: "memory");
            __builtin_amdgcn_s_barrier();
            asm volatile("" ::: "memory");
            IDX_DMA(2 * ip + NB - 2); IDX_DMA(2 * ip + NB - 1);
#pragma unroll
            for (int tt = 0; tt < 2; ++tt) { const int kt = 2 * ip + tt;
            const LAS unsigned char* sl = ring + (kt & (NB - 1)) * 8192 + rdoff;
            bf16x8 bfr[8];
#pragma unroll
            for (int ks = 0; ks < 8; ++ks) bfr[ks] = *(const LAS bf16x8*)(sl + 16 * ((2 * ks + half) ^ (l31 & 15)));
#pragma unroll
            for (int q = 0; q < NQ; ++q) { f32x16 acc;
#pragma unroll
                for (int e = 0; e < 16; ++e) acc[e] = 0.f;
#pragma unroll
                for (int ks = 0; ks < 8; ++ks) acc = MFMA32(af[q][ks], bfr[ks], acc);
                const v4u x0 = (v4u){pkmax0(pg8::cvt_pk_bf16(acc[0], acc[1])), pkmax0(pg8::cvt_pk_bf16(acc[2], acc[3])), pkmax0(pg8::cvt_pk_bf16(acc[4], acc[5])), pkmax0(pg8::cvt_pk_bf16(acc[6], acc[7]))};
                const v4u x1 = (v4u){pkmax0(pg8::cvt_pk_bf16(acc[8], acc[9])), pkmax0(pg8::cvt_pk_bf16(acc[10], acc[11])), pkmax0(pg8::cvt_pk_bf16(acc[12], acc[13])), pkmax0(pg8::cvt_pk_bf16(acc[14], acc[15]))};
                f32x16 y;
#pragma unroll
                for (int e = 0; e < 16; ++e) y[e] = 0.f;
                y = MFMA32(wf[q][0], __builtin_bit_cast(bf16x8, x0), y); y = MFMA32(wf[q][1], __builtin_bit_cast(bf16x8, x1), y);
                const int ktc = kt < 255 ? kt : 255;
                scb[(size_t)q * 8192 + 32 * ktc] = y[0]; }
            }
        }
        asm volatile("s_waitcnt vmcnt(0)" ::: "memory");
#undef IDX_DMA
    }
}
__device__ __forceinline__ unsigned okey(float f) { const unsigned u = __builtin_bit_cast(unsigned, f); return u ^ ((unsigned)((int)u >> 31) | 0x80000000u); }
__device__ __forceinline__ int wave_sum_i(int v) {
#pragma unroll
    for (int o = 1; o < 64; o <<= 1) v += __shfl_xor(v, o);
    return v;
}
__device__ __forceinline__ int mbcnt64(unsigned long long m) { return (int)__builtin_amdgcn_mbcnt_hi((unsigned)(m >> 32), __builtin_amdgcn_mbcnt_lo((unsigned)m, 0u)); }
template <int NJ> __device__ __forceinline__ void topk_row(const float* sc, int n, int* sel, int lane_in) {
    int lane = lane_in; asm volatile("" : "+v"(lane));
    unsigned k[NJ];
    const float* p = sc + lane;
#pragma unroll
    for (int j = 0; j < NJ; ++j) { k[j] = okey(P0_NT ? __builtin_nontemporal_load(p + 64 * j) : p[64 * j]) & (unsigned)((64 * j + lane - n) >> 31); if ((j & 31) == 31) __builtin_amdgcn_sched_barrier(0); }
    unsigned Mx = 0u;
#pragma unroll
    for (int j = 0; j < NJ; ++j) Mx = k[j] > Mx ? k[j] : Mx;
#pragma unroll
    for (int o = 1; o < 64; o <<= 1) { const unsigned ot = (unsigned)__shfl_xor((int)Mx, o); Mx = ot > Mx ? ot : Mx; }
    unsigned T = 0u, pref = Mx & 0xFF800000u; bool exact = false, pmode = pref >= 0x00800000u; int bit = 31, tries = 0;
    for (;;) {
        if (!pmode && bit < 0) break;
        const unsigned cand = pmode ? pref : (T | (1u << bit)); int cnt = 0;
#pragma unroll
        for (int j = 0; j < NJ; ++j) { cnt += __builtin_popcountll(__ballot(k[j] >= cand)); if ((j & 7) == 7) __builtin_amdgcn_sched_barrier(0); }
        if (pmode) {
            if (cnt >= TOPK) { T = pref; bit = 22; pmode = false; if (cnt == TOPK) { exact = true; break; } }
            else { ++tries; if (tries >= 3 || pref < 0x01000000u) { pmode = false; T = 0u; bit = 31; } else pref -= 0x00800000u; }
        } else {
            if (cnt >= TOPK) T = cand;
            if (cnt == TOPK) { exact = true; break; }
            --bit; }
    }
    unsigned T2 = exact ? T - 1u : T; asm volatile("" : "+v"(T2));
    int cgt = 0;
#pragma unroll
    for (int j = 0; j < NJ; ++j) { const int pc = __builtin_popcountll(__ballot(k[j] > T2)); asm volatile("s_add_i32 %0, %0, %1" : "+s"(cgt) : "s"(pc) : "scc"); }
    const int need = TOPK - cgt; int cur = 0, eqb = 0;
    int lane2 = lane_in; asm volatile("" : "+v"(lane2));
    unsigned T3 = T2; asm volatile("" : "+v"(T3));
#pragma unroll
    for (int j = 0; j < NJ; ++j) { const bool gt = k[j] > T3, eq = k[j] == T3; const unsigned long long me = __ballot(eq); const bool take = gt || (eq && (eqb + mbcnt64(me)) < need);
        const unsigned long long mt = __ballot(take); if (take) sel[cur + mbcnt64(mt)] = 64 * j + lane2; cur += __builtin_popcountll(mt); eqb += __builtin_popcountll(me);
        __builtin_amdgcn_sched_barrier(0); }
}
constexpr int LATE_OUTB = (4096 / 64) * (DM / 32), LATE_UP = (DM / 64) * (DFF / 32), LATE_DOWN = (DFF / 64) * (DM / 32), NLATE = LATE_CONV ? LATE_OUTB + LATE_UP + LATE_DOWN : 0;
constexpr int LATE_P9 = (TOPK_SPLIT && P9_FILL && LATE_CONV) ? 12288 : 0;
constexpr int LATE_SPLIT = (TOPK_SPLIT && SP_LATE) ? LATE_OUTB + LATE_UP : NLATE;
__device__ __forceinline__ void late_conv_item(Frame& F, const Args& a, LAS float* scr, int r) {
    unsigned char* ws = F.ws;
    if (r < LATE_OUTB) { p0_transpose_item_f8((const float*)a.in[13], 4096, DM, (unsigned char*)(ws + WS_W_OUTB), WOUTB_SCALE, scr, r, F.lane); return; } r -= LATE_OUTB;
    if (r < LATE_UP) { p0_transpose_item_f8((const float*)a.in[14] + (size_t)DM * DFF, DM, DFF, (unsigned char*)(ws + WS_W_UP1), WUP_SCALE, scr, r, F.lane); return; } r -= LATE_UP;
    p0_transpose_item_f8((const float*)a.in[15] + (size_t)DM * DFF, DFF, DM, (unsigned char*)(ws + WS_W_DOWN1), WDOWN_SCALE, scr, r, F.lane);
}
struct LateP { const float* W; unsigned char* WT; int K, N; float scale; };
__device__ __forceinline__ LateP late_conv_params(Frame& F, const Args& a, int& r) {
    unsigned char* ws = F.ws;
    if (r < LATE_OUTB) return LateP{(const float*)a.in[13], (unsigned char*)(ws + WS_W_OUTB), 4096, DM, WOUTB_SCALE}; r -= LATE_OUTB;
    if (r < LATE_UP) return LateP{(const float*)a.in[14] + (size_t)DM * DFF, (unsigned char*)(ws + WS_W_UP1), DM, DFF, WUP_SCALE}; r -= LATE_UP;
    return LateP{(const float*)a.in[15] + (size_t)DM * DFF, (unsigned char*)(ws + WS_W_DOWN1), DFF, DM, WDOWN_SCALE};
}
template <int NBT> __device__ __forceinline__ void late_conv_batch(Frame& F, const Args& a, LAS float* scr, int li, int stride) {
    const int lane = F.lane;
    float tv[NBT][32]; LateP P[NBT]; int k0[NBT], n0[NBT];
#pragma unroll
    for (int b = 0; b < NBT; ++b) { int r = li + b * stride; P[b] = late_conv_params(F, a, r); const int nblk = P[b].N / 32; k0[b] = 64 * (r / nblk); n0[b] = 32 * (r % nblk);
        const float* src = P[b].W + (size_t)(k0[b] + (lane >> 5)) * P[b].N + n0[b] + (lane & 31);
#pragma unroll
        for (int i = 0; i < 32; ++i) tv[b][i] = src[(size_t)(2 * i) * P[b].N]; }
    __builtin_amdgcn_sched_barrier(0);
#pragma unroll
    for (int b = 0; b < NBT; ++b) {
#pragma unroll
        for (int i = 0; i < 32; ++i) scr[(2 * i + (lane >> 5)) * 33 + (lane & 31)] = tv[b][i];
        LDS_WAIT(); asm volatile("" ::: "memory");
        const int c = lane & 7; const float scale = P[b].scale;
#pragma unroll
        for (int j = 0; j < 4; ++j) { const int n = (lane >> 3) + 8 * j; const LAS float* s = scr + (8 * c) * 33 + n;
            int p0 = 0, p1 = 0;
            p0 = __builtin_amdgcn_cvt_pk_fp8_f32(s[0 * 33] * scale, s[1 * 33] * scale, p0, false); p0 = __builtin_amdgcn_cvt_pk_fp8_f32(s[2 * 33] * scale, s[3 * 33] * scale, p0, true);
            p1 = __builtin_amdgcn_cvt_pk_fp8_f32(s[4 * 33] * scale, s[5 * 33] * scale, p1, false); p1 = __builtin_amdgcn_cvt_pk_fp8_f32(s[6 * 33] * scale, s[7 * 33] * scale, p1, true);
            *(GAS unsigned long long*)(P[b].WT + (size_t)(n0[b] + n) * P[b].K + k0[b] + 8 * c) = (unsigned long long)(unsigned)p0 | ((unsigned long long)(unsigned)p1 << 32); }
        LDS_WAIT(); asm volatile("" ::: "memory");
        __builtin_amdgcn_sched_barrier(0); }
}
#if TOPK_SPLIT
__device__ __forceinline__ void topk_phase(Frame& F, const Args& a) {
    const float* SC = (const float*)(F.ws + WS_SCORE); int* SEL = (int*)(F.ws + WS_SEL);
    LAS float* scr = (LAS float*)(F.lds + RING_OFF + F.wave * 16384);
    LAS unsigned* ctr = (LAS unsigned*)(F.lds + RING_OFF + 16000);
    if (F.tid == 0) *ctr = 0u;
    __syncthreads();
    if (LATE_CONV && F.wave >= 4) { const int cw = F.vcu * 4 + (F.wave - 4), NCW = F.G * 4;
        int li = LATE_P9 + cw;
        for (; li + 4 * NCW < LATE_SPLIT; li += 5 * NCW) late_conv_batch<5>(F, a, scr, li, NCW);
#pragma unroll 1
        for (; li < LATE_SPLIT; li += NCW) late_conv_item(F, a, scr, li); }
    const int nrows = (M - F.vcu + F.G - 1) / F.G;
    for (;;) {
        unsigned i_ = 0u; if (F.lane == 0) i_ = __hip_atomic_fetch_add(ctr, 1u, __ATOMIC_RELAXED, __HIP_MEMORY_SCOPE_WORKGROUP);
        const int i = __builtin_amdgcn_readfirstlane((int)i_);
        if (i >= nrows) break;
        const int m = F.vcu + F.G * (TOPK_DESC ? nrows - 1 - i : i);
        const int t = m & (SEQ - 1), n = t + 1; int* sel = SEL + (size_t)m * 256; const float* sc = SC + (size_t)m * 8192;
        if (n <= 256) { const int lane = F.lane;
#pragma unroll
            for (int i2 = 0; i2 < 4; ++i2) sel[64 * i2 + lane] = (64 * i2 + lane < n) ? 64 * i2 + lane : 0;
        } else if (n <= 2048) topk_row<32>(sc, n, sel, F.lane);
        else if (n <= 4096) topk_row<64>(sc, n, sel, F.lane);
        else topk_row<128>(sc, n, sel, F.lane);
    }
    __syncthreads();
}
#else
__device__ __forceinline__ void topk_phase(Frame& F, const Args& a) {
    const float* SC = (const float*)(F.ws + WS_SCORE); int* SEL = (int*)(F.ws + WS_SEL);
    const int gw = F.vcu * NWAVES + F.wave, NGW = F.G * NWAVES;
    LAS float* scr = (LAS float*)(F.lds + RING_OFF + F.wave * 16384);
    int li = gw;
    for (int m = gw; m < M; m += NGW) {
        if (LATE_CONV) {
            if (LATE_BATCH && li + 4 * NGW < NLATE) { late_conv_batch<5>(F, a, scr, li, NGW); li += 5 * NGW; }
            else {
#pragma unroll 1
                for (int j = 0; j < 5 && li < NLATE; ++j, li += NGW) late_conv_item(F, a, scr, li); } }
        const int t = m & (SEQ - 1), n = t + 1; int* sel = SEL + (size_t)m * 256; const float* sc = SC + (size_t)m * 8192;
        if (n <= 256) { const int lane = F.lane;
#pragma unroll
            for (int i = 0; i < 4; ++i) sel[64 * i + lane] = (64 * i + lane < n) ? 64 * i + lane : 0;
        } else if (n <= 2048) topk_row<32>(sc, n, sel, F.lane);
        else if (n <= 4096) topk_row<64>(sc, n, sel, F.lane);
        else topk_row<128>(sc, n, sel, F.lane);
    }
    if (LATE_CONV) {
#pragma unroll 1
        for (; li < NLATE; li += NGW) late_conv_item(F, a, scr, li); }
}
#endif
#define MFMA16(a, b, c) __builtin_amdgcn_mfma_f32_16x16x32_bf16((a), (b), (c), 0, 0, 0)
#define MFMA16F8(a, b, c) __builtin_amdgcn_mfma_f32_16x16x32_fp8_fp8((a), (b), (c), 0, 0, 0)
constexpr float QF8_SCALE = 16.0f;
constexpr float OSC = OB_SCALE / (PF8_SCALE * VF8_SCALE);
typedef int v2i_t __attribute__((ext_vector_type(2)));
typedef short s16x4 __attribute__((ext_vector_type(4)));
typedef short v4i16_t __attribute__((ext_vector_type(4)));
__device__ __forceinline__ s16x4 vtr(const LAS unsigned char* p) { return __builtin_bit_cast(s16x4, __builtin_amdgcn_ds_read_tr16_b64_v4i16((LAS v4i16_t*)p)); }
__device__ __forceinline__ void sparse_attn_phase(Frame& F, const Args& a) {
    const bf16* QB = (const bf16*)(F.ws + WS_QB); const unsigned char* KB8 = (const unsigned char*)(F.ws + WS_KB); const unsigned char* VB8 = (const unsigned char*)(F.ws + WS_VB); const int* SEL = (const int*)(F.ws + WS_SEL); unsigned char* OB = (unsigned char*)(F.ws + WS_OB);
    const int w = F.wave, lane = F.lane, r16 = lane & 15, c4 = lane >> 4;
    LAS unsigned char* ring = F.lds + RING_OFF + w * 16384;
    LAS int* selb = (LAS int*)(F.lds + RING_BYTES + 1024 + w * 2048);
    unsigned* qctr = (unsigned*)(F.ctl + CW_SPQ);
    const unsigned xcc = xb_xcc_id() & 7u;
    unsigned qx = xcc; int tries = 0;
#define SP_POP_BLOCKING(vout) do { unsigned x2_ = 0u; if (lane == 0) x2_ = xb_add(qctr + 64 * qx, 1u); vout = (unsigned)__builtin_amdgcn_readfirstlane((int)x2_); \
        while (vout >= 16384u && tries < 8) { ++tries; qx = (qx + 1u) & 7u; x2_ = 0u; if (lane == 0) x2_ = xb_add(qctr + 64 * qx, 1u); vout = (unsigned)__builtin_amdgcn_readfirstlane((int)x2_); } } while (0)
#define SP_PREFETCH(v_, g_, selv_, qv_) do { const size_t m_ = (size_t)((v_) >> 13) * SEQ + ((v_) & 8191u); selv_ = *(const GAS v4u*)(SEL + m_ * 256 + 4 * lane); \
        const bf16* qrow_ = QB + m_ * 4096 + ((g_) * 4 + (r16 & 3)) * 128 + 32 * c4; \
        _Pragma("unroll") for (int ks = 0; ks < 4; ++ks) qv_[ks] = *(const GAS v4u*)(qrow_ + 8 * ks); } while (0)
#define SP_VSWZ(R) ((((R) >> 1) & 3) | ((((R) >> 4) & 1) << 2))
    const int selo = lane >> 3;
    const unsigned kslot = 16u * (unsigned)(lane & 7);
    const unsigned vslot0 = 16u * (unsigned)((lane & 7) ^ ((lane >> 4) & 3)), vslot1 = 16u * (unsigned)((lane & 7) ^ (((lane >> 4) & 3) | 4));
#define SP_ROWS(rows_, sel_, cnt_, chunk_) do { \
        _Pragma("unroll") for (int i4 = 0; i4 < 4; ++i4) rows_[i4] = (sel_)[selo + 32 * (chunk_) + 8 * i4]; } while (0)
#define SP_ISSUE(base_, rows_, slot_, isv_) do { \
        _Pragma("unroll") for (int i4 = 0; i4 < 4; ++i4) { const unsigned off_ = ((unsigned)rows_[i4] << 10) + ((isv_) ? ((i4 & 2) ? vslot1 : vslot0) : kslot); \
        __builtin_amdgcn_global_load_lds((const unsigned*)((base_) + off_), (LAS unsigned*)(ring + (slot_) * 4096 + i4 * 1024), 16, 0, 0); } } while (0)
#define SP_CHUNK_DMA(base_, sel_, cnt_, chunk_, slot_, isv_) do { int rws_[4]; SP_ROWS(rws_, sel_, cnt_, chunk_); SP_ISSUE(base_, rws_, slot_, isv_); } while (0)
#if TOPK_SPLIT && SP_LATE
    if (LATE_CONV && w >= 4) {
        LAS float* scr_ = (LAS float*)(F.lds + RING_OFF + w * 16384); const int NCW = F.G * 4; int li = LATE_SPLIT + F.vcu * 4 + (w - 4);
        for (; li + 4 * NCW < NLATE; li += 5 * NCW) late_conv_batch<5>(F, a, scr_, li, NCW);
#pragma unroll 1
        for (; li < NLATE; li += NCW) late_conv_item(F, a, scr_, li); }
#endif
    unsigned v; SP_POP_BLOCKING(v);
    if (v < 16384u) {
    int g = (int)qx, cur = 0;
    v4u selv, qv[4];
    SP_PREFETCH(v, g, selv, qv);
    unsigned nxt = 0u;
#if SP_ASM2
    LAS unsigned char* qbuf = F.lds + RING_BYTES + 1024 + NWAVES * 2048 + w * 1024;
    { const size_t m0_ = (size_t)(v >> 13) * SEQ + (v & 8191u);
      __builtin_amdgcn_global_load_lds((const unsigned*)((const unsigned char*)(QB + m0_ * 4096 + g * 512) + 16 * lane), (LAS unsigned*)qbuf, 16, 0, 0); }
    bool first = true;
#endif
    if (lane == 0) nxt = xb_add(qctr + 64 * qx, 1u);
    *(LAS v4u*)(selb + 4 * lane) = selv;
    LDS_WAIT();
#if SP_ASM2
    asm volatile("s_waitcnt vmcnt(0)" ::: "memory");
#endif
    { const int b0 = (int)(v >> 13), t0 = (int)(v & 8191u), cnt0 = (t0 + 1 < TOPK) ? t0 + 1 : TOPK;
      const unsigned char* KB0 = KB8 + (size_t)b0 * SEQ * 1024 + g * 128;
      SP_CHUNK_DMA(KB0, selb, cnt0, 0, 0, 0); SP_CHUNK_DMA(KB0, selb, cnt0, 1, 1, 0); SP_CHUNK_DMA(KB0, selb, cnt0, 2, 2, 0); }
    for (;;) {
        const int b = (int)(v >> 13), t = (int)(v & 8191u), cnt = (t + 1 < TOPK) ? t + 1 : TOPK;
        const size_t m = (size_t)b * SEQ + t;
        LAS int* sel_l = selb + cur * 256;
        const unsigned char* KBg = KB8 + (size_t)b * SEQ * 1024 + g * 128;
        const unsigned char* VBg = VB8 + (size_t)b * SEQ * 1024 + g * 128;
        long long qf[4];
#pragma unroll
        for (int ks = 0; ks < 4; ++ks) {
#if SP_ASM2
            const v4u qq4 = *(const LAS v4u*)(qbuf + (r16 & 3) * 256 + (32 * c4 + 8 * ks) * 2);
#else
            const v4u qq4 = qv[ks];
#endif
            int lo = 0, hi = 0;
            lo = __builtin_amdgcn_cvt_pk_fp8_f32(bf_lo(qq4.x) * QF8_SCALE, bf_hi(qq4.x) * QF8_SCALE, lo, false); lo = __builtin_amdgcn_cvt_pk_fp8_f32(bf_lo(qq4.y) * QF8_SCALE, bf_hi(qq4.y) * QF8_SCALE, lo, true);
            hi = __builtin_amdgcn_cvt_pk_fp8_f32(bf_lo(qq4.z) * QF8_SCALE, bf_hi(qq4.z) * QF8_SCALE, hi, false); hi = __builtin_amdgcn_cvt_pk_fp8_f32(bf_lo(qq4.w) * QF8_SCALE, bf_hi(qq4.w) * QF8_SCALE, hi, true);
            const long long qq = (long long)((unsigned long long)(unsigned)lo | ((unsigned long long)(unsigned)hi << 32));
            qf[ks] = (r16 < 4) ? qq : 0ll; }
        unsigned vn = (unsigned)__builtin_amdgcn_readfirstlane((int)nxt);
        if (vn >= 16384u && tries < 8) { ++tries; qx = (qx + 1u) & 7u; SP_POP_BLOCKING(vn); }
        const bool have_next = vn < 16384u; const int gn = (int)qx;
        v4u selv_n = selv, qv_n[4] = {qv[0], qv[1], qv[2], qv[3]};
#if SP_ASM2
        if (have_next) {
            const size_t mn_ = (size_t)(vn >> 13) * SEQ + (vn & 8191u);
            __builtin_amdgcn_global_load_lds((const unsigned*)(SEL + mn_ * 256 + 4 * lane), (LAS unsigned*)(selb + (cur ^ 1) * 256), 16, 0, 0);
            asm volatile("s_waitcnt lgkmcnt(0)" ::: "memory");
            __builtin_amdgcn_global_load_lds((const unsigned*)((const unsigned char*)(QB + mn_ * 4096 + gn * 512) + 16 * lane), (LAS unsigned*)qbuf, 16, 0, 0);
            if (lane == 0) { const unsigned long long ap_ = (unsigned long long)(qctr + 64 * qx); const unsigned one_ = 1u;
                asm volatile("global_atomic_add %0, %1, %2, off sc0" : "+v"(nxt) : "v"(ap_), "v"(one_) : "memory"); } }
#elif SP_ASM
        if (have_next) {
            const size_t mn_ = (size_t)(vn >> 13) * SEQ + (vn & 8191u);
            __builtin_amdgcn_global_load_lds((const unsigned*)(SEL + mn_ * 256 + 4 * lane), (LAS unsigned*)(selb + (cur ^ 1) * 256), 16, 0, 0);
            const bf16* qrow_ = QB + mn_ * 4096 + (gn * 4 + (r16 & 3)) * 128 + 32 * c4;
#pragma unroll
            for (int ks = 0; ks < 4; ++ks) qv_n[ks] = *(const GAS v4u*)(qrow_ + 8 * ks);
            if (lane == 0) nxt = xb_add(qctr + 64 * qx, 1u); }
#else
        if (have_next) { SP_PREFETCH(vn, gn, selv_n, qv_n); if (lane == 0) nxt = xb_add(qctr + 64 * qx, 1u); }
#endif
        f32x4 S[16];
#pragma unroll
        for (int c = 0; c < 8; ++c) {
            int rw[4]; SP_ROWS(rw, sel_l, cnt, (c + 3) & 7);
#if SP_ASM2
            if (c < 3) { if (have_next) { if (first) asm volatile("s_waitcnt vmcnt(11)" ::: "memory"); else asm volatile("s_waitcnt vmcnt(19)" ::: "memory"); }
                         else { if (first) asm volatile("s_waitcnt vmcnt(8)" ::: "memory"); else asm volatile("s_waitcnt vmcnt(16)" ::: "memory"); } }
            else asm volatile("s_waitcnt vmcnt(8)" ::: "memory");
#else
            asm volatile("s_waitcnt vmcnt(8)" ::: "memory");
#endif
            if (c + 3 < 8) SP_ISSUE(KBg, rw, (c + 3) & 3, 0); else SP_ISSUE(VBg, rw, (c + 3) & 3, 1);
            const LAS unsigned char* kb = ring + (c & 3) * 4096 + r16 * 128 + 32 * c4;
#pragma unroll
            for (int tl = 0; tl < 2; ++tl) { const v4u k0 = *(const LAS v4u*)(kb + tl * 2048), k1 = *(const LAS v4u*)(kb + tl * 2048 + 16);
                f32x4 acc = {0.f, 0.f, 0.f, 0.f};
                acc = MFMA16F8((long long)((unsigned long long)k0.x | ((unsigned long long)k0.y << 32)), qf[0], acc);
                acc = MFMA16F8((long long)((unsigned long long)k0.z | ((unsigned long long)k0.w << 32)), qf[1], acc);
                acc = MFMA16F8((long long)((unsigned long long)k1.x | ((unsigned long long)k1.y << 32)), qf[2], acc);
                acc = MFMA16F8((long long)((unsigned long long)k1.z | ((unsigned long long)k1.w << 32)), qf[3], acc);
                S[2 * c + tl] = acc; }
            __builtin_amdgcn_sched_barrier(0);
        }
        if (cnt < TOPK) {
            const float fb = (float)(cnt - 1 - 4 * c4);
#pragma unroll
            for (int tau = 0; tau < 16; ++tau)
#pragma unroll
                for (int i = 0; i < 4; ++i) S[tau][i] += fminf(fb - (float)(16 * tau + i), 0.f) * 1e30f; }
        float mx = -1e30f;
#pragma unroll
        for (int tau = 0; tau < 16; ++tau) mx = fmaxf(fmaxf(mx, fmaxf(S[tau][0], S[tau][1])), fmaxf(S[tau][2], S[tau][3]));
        mx = fmaxf(mx, __shfl_xor(mx, 16)); mx = fmaxf(mx, __shfl_xor(mx, 32));
        float sum = 0.f;
#pragma unroll
        for (int tau = 0; tau < 16; ++tau)
#pragma unroll
            for (int i = 0; i < 4; ++i) { const float pv = __builtin_amdgcn_exp2f((S[tau][i] - mx) * (1.4426950408889634f / QF8_SCALE)); S[tau][i] = pv; sum += pv; }
        sum += __shfl_xor(sum, 16); sum += __shfl_xor(sum, 32);
        const float inv = 1.0f / sum;
        LAS int* sel_n = selb + (cur ^ 1) * 256;
        const int bn = (int)(vn >> 13), tn = (int)(vn & 8191u), cntn = (tn + 1 < TOPK) ? tn + 1 : TOPK;
        const unsigned char* KBn = KB8 + (size_t)bn * SEQ * 1024 + gn * 128;
#if !SP_ASM
        if (have_next) { *(LAS v4u*)(sel_n + 4 * lane) = selv_n; }
#endif
        f32x4 O[8];
#pragma unroll
        for (int dt = 0; dt < 8; ++dt) O[dt] = (f32x4){0.f, 0.f, 0.f, 0.f};
        const int q8 = r16 >> 1, p8 = r16 & 1;
        const int Rr = (q8 < 4) ? 4 * c4 + q8 : 16 + 4 * c4 + (q8 - 4);
        const int rbase = Rr * 128 + 8 * p8, rsw = SP_VSWZ(Rr);
        const float pscale = inv * PF8_SCALE;
#if SP_ASM
        unsigned vaddr[8];
#pragma unroll
        for (int dt = 0; dt < 8; ++dt) vaddr[dt] = (unsigned)(size_t)ring + (unsigned)(rbase + 16 * (dt ^ rsw));
#endif
#pragma unroll
        for (int s = 0; s < 8; ++s) {
            int rw[4];
            if (s + 3 < 8) SP_ROWS(rw, sel_l, cnt, s + 3); else SP_ROWS(rw, sel_n, cntn, s + 3 - 8);
            if (have_next || s < 6) asm volatile("s_waitcnt vmcnt(8)" ::: "memory"); else asm volatile("s_waitcnt vmcnt(0)" ::: "memory");
            if (s + 3 < 8) SP_ISSUE(VBg, rw, (s + 3) & 3, 1);
            else if (have_next) SP_ISSUE(KBn, rw, (s + 3) & 3, 0);
            long long pb;
            { int lo = 0, hi = 0;
              lo = __builtin_amdgcn_cvt_pk_fp8_f32(S[2 * s][0] * pscale, S[2 * s][1] * pscale, lo, false); lo = __builtin_amdgcn_cvt_pk_fp8_f32(S[2 * s][2] * pscale, S[2 * s][3] * pscale, lo, true);
              hi = __builtin_amdgcn_cvt_pk_fp8_f32(S[2 * s + 1][0] * pscale, S[2 * s + 1][1] * pscale, hi, false); hi = __builtin_amdgcn_cvt_pk_fp8_f32(S[2 * s + 1][2] * pscale, S[2 * s + 1][3] * pscale, hi, true);
              pb = (long long)((unsigned long long)(unsigned)lo | ((unsigned long long)(unsigned)hi << 32)); }
#if SP_ASM
            v2i_t a8[8];
#if SP_VSPLIT
            asm volatile("ds_read_b64_tr_b8 %0, %8 offset:%16\n\tds_read_b64_tr_b8 %1, %9 offset:%16\n\tds_read_b64_tr_b8 %2, %10 offset:%16\n\tds_read_b64_tr_b8 %3, %11 offset:%16\n\t"
                         "ds_read_b64_tr_b8 %4, %12 offset:%16\n\tds_read_b64_tr_b8 %5, %13 offset:%16\n\tds_read_b64_tr_b8 %6, %14 offset:%16\n\tds_read_b64_tr_b8 %7, %15 offset:%16\n\ts_waitcnt lgkmcnt(4)"
                         : "=&v"(a8[0]), "=&v"(a8[1]), "=&v"(a8[2]), "=&v"(a8[3]), "=&v"(a8[4]), "=&v"(a8[5]), "=&v"(a8[6]), "=&v"(a8[7])
                         : "v"(vaddr[0]), "v"(vaddr[1]), "v"(vaddr[2]), "v"(vaddr[3]), "v"(vaddr[4]), "v"(vaddr[5]), "v"(vaddr[6]), "v"(vaddr[7]), "n"((s & 3) * 4096) : "memory");
#pragma unroll
            for (int dt = 0; dt < 4; ++dt) { const long long av = (long long)((unsigned long long)(unsigned)a8[dt].x | ((unsigned long long)(unsigned)a8[dt].y << 32));
                O[dt] = MFMA16F8(av, pb, O[dt]); }
            __builtin_amdgcn_sched_barrier(0);
            asm volatile("s_waitcnt lgkmcnt(0)" : "+v"(a8[4]), "+v"(a8[5]), "+v"(a8[6]), "+v"(a8[7]) :: "memory");
#pragma unroll
            for (int dt = 4; dt < 8; ++dt) { const long long av = (long long)((unsigned long long)(unsigned)a8[dt].x | ((unsigned long long)(unsigned)a8[dt].y << 32));
                O[dt] = MFMA16F8(av, pb, O[dt]); }
#else
            asm volatile("ds_read_b64_tr_b8 %0, %8 offset:%16\n\tds_read_b64_tr_b8 %1, %9 offset:%16\n\tds_read_b64_tr_b8 %2, %10 offset:%16\n\tds_read_b64_tr_b8 %3, %11 offset:%16\n\t"
                         "ds_read_b64_tr_b8 %4, %12 offset:%16\n\tds_read_b64_tr_b8 %5, %13 offset:%16\n\tds_read_b64_tr_b8 %6, %14 offset:%16\n\tds_read_b64_tr_b8 %7, %15 offset:%16\n\ts_waitcnt lgkmcnt(0)"
                         : "=&v"(a8[0]), "=&v"(a8[1]), "=&v"(a8[2]), "=&v"(a8[3]), "=&v"(a8[4]), "=&v"(a8[5]), "=&v"(a8[6]), "=&v"(a8[7])
                         : "v"(vaddr[0]), "v"(vaddr[1]), "v"(vaddr[2]), "v"(vaddr[3]), "v"(vaddr[4]), "v"(vaddr[5]), "v"(vaddr[6]), "v"(vaddr[7]), "n"((s & 3) * 4096) : "memory");
#pragma unroll
            for (int dt = 0; dt < 8; ++dt) { const long long av = (long long)((unsigned long long)(unsigned)a8[dt].x | ((unsigned long long)(unsigned)a8[dt].y << 32));
                O[dt] = MFMA16F8(av, pb, O[dt]); }
#endif
#else
            const LAS unsigned char* vb = ring + (s & 3) * 4096 + rbase;
#pragma unroll
            for (int dt = 0; dt < 8; ++dt) { const v2i_t a8 = __builtin_amdgcn_ds_read_tr8_b64_v2i32((LAS v2i_t*)(vb + 16 * (dt ^ rsw)));
                const long long av = (long long)((unsigned long long)(unsigned)a8.x | ((unsigned long long)(unsigned)a8.y << 32));
                O[dt] = MFMA16F8(av, pb, O[dt]); }
#endif
            __builtin_amdgcn_sched_barrier(0);
        }
        if (r16 < 4) { unsigned char* op = OB + m * 4096 + (g * 4 + r16) * 128 + 4 * c4;
#pragma unroll
            for (int dt = 0; dt < 8; ++dt) { int pq = 0; pq = __builtin_amdgcn_cvt_pk_fp8_f32(fminf(fmaxf(O[dt][0] * OSC, -448.f), 448.f), fminf(fmaxf(O[dt][1] * OSC, -448.f), 448.f), pq, false);
                pq = __builtin_amdgcn_cvt_pk_fp8_f32(fminf(fmaxf(O[dt][2] * OSC, -448.f), 448.f), fminf(fmaxf(O[dt][3] * OSC, -448.f), 448.f), pq, true); *(GAS unsigned*)(op + 16 * dt) = (unsigned)pq; } }
        if (!have_next) break;
#if SP_ASM2
        v = vn; g = gn; cur ^= 1; first = false;
#else
        v = vn; g = gn; cur ^= 1; selv = selv_n; qv[0] = qv_n[0]; qv[1] = qv_n[1]; qv[2] = qv_n[2]; qv[3] = qv_n[3];
#endif
    }
    }
    asm volatile("s_waitcnt vmcnt(0)" ::: "memory");
#undef SP_POP_BLOCKING
#undef SP_PREFETCH
#undef SP_CHUNK_DMA
#undef SP_ROWS
#undef SP_ISSUE
#undef SP_VSWZ
}
struct TileQKVA { bf16* out; float s8;
    __device__ __forceinline__ pg8::HeadTile operator()(int pn) const { const int gw = pn >> 3, which = gw % 3, g = gw / 3;
        return pg8::HeadTile{out + ((size_t)(gw * 16 + 2 * (pn & 7)) * 2) * 8192 * 128, nullptr, A_IN, pn * 256, which < 2 ? 1 : 0, (which == 0 ? QSCALE : 1.f) * s8, nullptr, 2 * g}; } };
struct TileINB { bf16 *qb, *kb, *vb, *iql; float* ikw; int pn0; float s8;
    __device__ __forceinline__ pg8::HeadTile operator()(int pnl) const { const int pn = pnl + pn0;
        if (pn < 16) return pg8::HeadTile{qb, nullptr, 4096, pn * 256, 1, QSCALE * s8, nullptr, -1};
        if (pn < 20) return pg8::HeadTile{nullptr, nullptr, 1024, (pn - 16) * 256, 1, s8, (unsigned char*)kb, -1};
        if (pn < 24) return pg8::HeadTile{nullptr, nullptr, 1024, (pn - 20) * 256, 0, s8 * VF8_SCALE, (unsigned char*)vb, -1};
        if (pn < 28) return pg8::HeadTile{iql, nullptr, 1024, (pn - 24) * 256, 0, 1.f, nullptr, -1};
        return pg8::HeadTile{nullptr, ikw, 256, 0, 0, 1.f, nullptr, -1}; } };
struct TileIQ { bf16* out; __device__ __forceinline__ pg8::HeadTile operator()(int pn) const { return (IDX_F8 && !IDX_I8) ? pg8::HeadTile{nullptr, nullptr, 4096, pn * 256, 1, 1.f, (unsigned char*)out, -1} : pg8::HeadTile{out, nullptr, 4096, pn * 256, 1, 1.f, nullptr, -1}; } };

#ifndef SP2_I8
#define SP2_I8 true
#endif
#ifndef MK_PER_PHASE
#define MK_PER_PHASE 0
#endif
__global__ void __launch_bounds__(NWAVES * 64, 2) fwd(Args args) {
    extern __shared__ __attribute__((aligned(16))) unsigned char lds[];
    Frame F;
    F.lds = (LAS unsigned char*)lds;
    F.MISC = (volatile LAS unsigned*)(F.lds + MISC_OFF);
    F.tid = threadIdx.x; F.lane = F.tid & 63; F.wave = __builtin_amdgcn_readfirstlane(F.tid >> 6);
    F.G = gridDim.x; { const int bx = blockIdx.x; F.vcu = (F.G % 8 == 0) ? (bx % 8) * (F.G / 8) + bx / 8 : bx; }
    F.ws = args.ws; unsigned char* ws = args.ws;
    F.ctl = (gu32*)(ws + WS_CTL);
    for (int u = F.tid; u < (LDS_BYTES - LDSCTL_OFF) / 4; u += NWAVES * 64) ((LAS unsigned*)(F.lds + LDSCTL_OFF))[u] = 0u;
    __syncthreads();
    const int lo = args.ph_lo, hi = args.ph_hi;
    XcdBarrier bar; bar.bar = (unsigned*)(F.ctl + CW_BAR) + args.li * XCD_BAR_WORDS; bar.x = 0; bar.st = nullptr;
    if (hi - lo > 1) bar = xcd_barrier_post((unsigned*)(F.ctl + CW_BAR) + args.li * XCD_BAR_WORDS, F.MISC + 8);
#ifdef ONLY_PHASE
#define IN(k) ((k) == ONLY_PHASE && lo <= (k) && (k) < hi)
#else
#define IN(k) (lo <= (k) && (k) < hi)
#endif
#ifndef REPEAT_MASK
#define REPEAT_MASK 0
#endif
#define REP(k) ((((REPEAT_MASK) >> (k)) & 1) ? 2 : 1)
#ifdef BAR2
#define SEAM(k) do { if (IN(k) && IN((k) + 1)) { xcd_barrier(bar); xcd_barrier(bar); } } while (0)
#else
#define SEAM(k) do { if (IN(k) && IN((k) + 1)) xcd_barrier(bar); } while (0)
#endif
    const float* x = (const float*)args.in[0];
    const float* g_attn_pre = (const float*)args.in[2]; const float* g_attn_post = (const float*)args.in[3];
    const float* g_mlp_pre = (const float*)args.in[4]; const float* g_mlp_post = (const float*)args.in[5];
    bf16* XN = (bf16*)(ws + WS_XN); bf16* MIX = (bf16*)(ws + WS_MIX); unsigned char* HID = (unsigned char*)(ws + WS_HID);
    const float* rope = (const float*)(ws + WS_ROPE);
    float* out = args.out;
    bf16* HB = (bf16*)(ws + WS_HB);

    if (IN(0)) { { p0_prologue(F, args); } if (REP(0) == 2) { p0_prologue(F, args); } } SEAM(0);
#if QKVA_I8 || UP0_I8 || L1_I8 || WOUTA_I8 || IDXG_I8
    if (IN(0) && IN(1)) { p0b_quantize(F, args); xcd_barrier(bar); }
#endif
    if (IN(1)) { { pg8::Gemm g{XN, (const bf16*)(ws + WS_W_INA), M, A_IN, (QKVA_F8 || QKVA_I8) ? DM / 2 : DM}; pg8::StaticOrder S; S.init(M, A_IN, F.G, (int)blockIdx.x);
        pg8::EpiHead<TileQKVA> E{TileQKVA{(bf16*)(ws + WS_QKVA), QKVA_F8 ? 1.0f / WINA_SCALE : 1.0f}, rope, QKVA_I8 ? (const float*)(ws + WS_SROW) : nullptr, QKVA_I8 ? (const float*)(ws + WS_SCOL_INA) : nullptr};
        pg8::gemm_phase<pg8::EpiHead<TileQKVA>, pg8::StaticOrder, true, SP2_I8, (QKVA_I8 ? 2 : (QKVA_F8 ? 1 : 0))>(F.lds + RING_OFF, g, S, E); } if (REP(1) == 2) { pg8::Gemm g{XN, (const bf16*)(ws + WS_W_INA), M, A_IN, (QKVA_F8 || QKVA_I8) ? DM / 2 : DM}; pg8::StaticOrder S; S.init(M, A_IN, F.G, (int)blockIdx.x);
        pg8::EpiHead<TileQKVA> E{TileQKVA{(bf16*)(ws + WS_QKVA), QKVA_F8 ? 1.0f / WINA_SCALE : 1.0f}, rope, QKVA_I8 ? (const float*)(ws + WS_SROW) : nullptr, QKVA_I8 ? (const float*)(ws + WS_SCOL_INA) : nullptr};
        pg8::gemm_phase<pg8::EpiHead<TileQKVA>, pg8::StaticOrder, true, SP2_I8, (QKVA_I8 ? 2 : (QKVA_F8 ? 1 : 0))>(F.lds + RING_OFF, g, S, E); } } SEAM(1);
    if (IN(2)) { { dil_attn_phase(F); } if (REP(2) == 2) { dil_attn_phase(F); } } SEAM(2);
    if (IN(3)) { { merge_phase(F); } if (REP(3) == 2) { merge_phase(F); } } SEAM(3);
    if (IN(4)) { { pg8::Gemm g{(const bf16*)(ws + WS_OMERGE), (const bf16*)(ws + WS_W_OUTA), M, DM, WOUTA_I8 ? A_OUT / 2 : A_OUT}; pg8::StaticOrder S; S.init(M, DM, F.G, (int)blockIdx.x, WGM_K2K);
        pg8::EpiBf16<0> E{MIX, DM, 1.0f, WOUTA_I8 ? (const float*)(ws + WS_SROW_OM) : nullptr, WOUTA_I8 ? (const float*)(ws + WS_SCOL_OUTA) : nullptr};
        pg8::gemm_phase<pg8::EpiBf16<0>, pg8::StaticOrder, true, true, (WOUTA_I8 ? 2 : 0)>(F.lds + RING_OFF, g, S, E); } if (REP(4) == 2) { pg8::Gemm g{(const bf16*)(ws + WS_OMERGE), (const bf16*)(ws + WS_W_OUTA), M, DM, WOUTA_I8 ? A_OUT / 2 : A_OUT}; pg8::StaticOrder S; S.init(M, DM, F.G, (int)blockIdx.x, WGM_K2K);
        pg8::EpiBf16<0> E{MIX, DM, 1.0f, WOUTA_I8 ? (const float*)(ws + WS_SROW_OM) : nullptr, WOUTA_I8 ? (const float*)(ws + WS_SCOL_OUTA) : nullptr};
        pg8::gemm_phase<pg8::EpiBf16<0>, pg8::StaticOrder, true, true, (WOUTA_I8 ? 2 : 0)>(F.lds + RING_OFF, g, S, E); } } SEAM(4);
    if (IN(5)) { { thin_resid<(UP0_I8 ? 3 : 0), false, true>(F, MIX, x, g_attn_post, HB, g_mlp_pre, XN, (unsigned char*)XN, (float*)(ws + WS_SROW)); } if (REP(5) == 2) { thin_resid<(UP0_I8 ? 3 : 0), false, true>(F, MIX, x, g_attn_post, HB, g_mlp_pre, XN, (unsigned char*)XN, (float*)(ws + WS_SROW)); } } SEAM(5);
    if (IN(6)) { { pg8::Gemm g{XN, (const bf16*)(ws + WS_W_UP), M, DFF, UP0_I8 ? DM / 2 : DM}; pg8::StaticOrder S; S.init(M, DFF, F.G, (int)blockIdx.x);
        const float* sr6 = UP0_I8 ? (const float*)(ws + WS_SROW) : nullptr; const float* sc6 = UP0_I8 ? (const float*)(ws + WS_SCOL_UP0) : nullptr;
#if DOWN0_F8
        pg8::EpiSqReluF8 E{HID, DFF, 1.0f, HID_SCALE, sr6, sc6};
        pg8::gemm_phase<pg8::EpiSqReluF8, pg8::StaticOrder, true, SP2_I8, (UP0_I8 ? 2 : 0)>(F.lds + RING_OFF, g, S, E);
#else
        pg8::EpiBf16<1> E{(bf16*)HID, DFF, 1.0f, sr6, sc6};
        pg8::gemm_phase<pg8::EpiBf16<1>, pg8::StaticOrder, true, SP2_I8, (UP0_I8 ? 2 : 0)>(F.lds + RING_OFF, g, S, E);
#endif
 } if (REP(6) == 2) { pg8::Gemm g{XN, (const bf16*)(ws + WS_W_UP), M, DFF, UP0_I8 ? DM / 2 : DM}; pg8::StaticOrder S; S.init(M, DFF, F.G, (int)blockIdx.x);
        const float* sr6 = UP0_I8 ? (const float*)(ws + WS_SROW) : nullptr; const float* sc6 = UP0_I8 ? (const float*)(ws + WS_SCOL_UP0) : nullptr;
#if DOWN0_F8
        pg8::EpiSqReluF8 E{HID, DFF, 1.0f, HID_SCALE, sr6, sc6};
        pg8::gemm_phase<pg8::EpiSqReluF8, pg8::StaticOrder, true, SP2_I8, (UP0_I8 ? 2 : 0)>(F.lds + RING_OFF, g, S, E);
#else
        pg8::EpiBf16<1> E{(bf16*)HID, DFF, 1.0f, sr6, sc6};
        pg8::gemm_phase<pg8::EpiBf16<1>, pg8::StaticOrder, true, SP2_I8, (UP0_I8 ? 2 : 0)>(F.lds + RING_OFF, g, S, E);
#endif
 } } SEAM(6);
    if (IN(7)) { {
#if DOWN0_F8
        pg8::Gemm g{(const bf16*)HID, (const bf16*)(ws + WS_W_DOWN), M, DM, DFF / 2}; pg8::StaticOrder S; S.init(M, DM, F.G, (int)blockIdx.x, WGM_K16K);
        pg8::EpiBf16<0> E{MIX, DM, 1.0f / (HID_SCALE * WDOWN_SCALE), nullptr, nullptr};
        pg8::gemm_phase<pg8::EpiBf16<0>, pg8::StaticOrder, true, true, true>(F.lds + RING_OFF, g, S, E);
#else
        pg8::Gemm g{(const bf16*)HID, (const bf16*)(ws + WS_W_DOWN), M, DM, DFF}; pg8::StaticOrder S; S.init(M, DM, F.G, (int)blockIdx.x, WGM_K16K);
        pg8::EpiBf16<0> E{MIX, DM, 1.0f, nullptr, nullptr};
        pg8::gemm_phase<pg8::EpiBf16<0>, pg8::StaticOrder, true, true>(F.lds + RING_OFF, g, S, E);
#endif
 } if (REP(7) == 2) {
#if DOWN0_F8
        pg8::Gemm g{(const bf16*)HID, (const bf16*)(ws + WS_W_DOWN), M, DM, DFF / 2}; pg8::StaticOrder S; S.init(M, DM, F.G, (int)blockIdx.x, WGM_K16K);
        pg8::EpiBf16<0> E{MIX, DM, 1.0f / (HID_SCALE * WDOWN_SCALE), nullptr, nullptr};
        pg8::gemm_phase<pg8::EpiBf16<0>, pg8::StaticOrder, true, true, true>(F.lds + RING_OFF, g, S, E);
#else
        pg8::Gemm g{(const bf16*)HID, (const bf16*)(ws + WS_W_DOWN), M, DM, DFF}; pg8::StaticOrder S; S.init(M, DM, F.G, (int)blockIdx.x, WGM_K16K);
        pg8::EpiBf16<0> E{MIX, DM, 1.0f, nullptr, nullptr};
        pg8::gemm_phase<pg8::EpiBf16<0>, pg8::StaticOrder, true, true>(F.lds + RING_OFF, g, S, E);
#endif
 } } SEAM(7);
    if (IN(8)) { { thin_resid<(L1_I8 ? 4 : (IDXG_I8 ? 5 : 2)), true, true>(F, MIX, HB, g_mlp_post, HB, g_attn_pre + DM, XN, (unsigned char*)(ws + WS_XN8), (float*)(ws + WS_SROW)); } if (REP(8) == 2) { thin_resid<(L1_I8 ? 4 : (IDXG_I8 ? 5 : 2)), true, true>(F, MIX, HB, g_mlp_post, HB, g_attn_pre + DM, XN, (unsigned char*)(ws + WS_XN8), (float*)(ws + WS_SROW)); } } SEAM(8);
    if (IN(9)) { { { pg8::Gemm g{(const bf16*)(ws + WS_XN8), (const bf16*)(ws + WS_W_INB), M, B_QKV, DM / 2}; pg8::StaticOrder S; S.init(M, B_QKV, F.G, (int)blockIdx.x);
          pg8::EpiHead<TileINB> E{TileINB{(bf16*)(ws + WS_QB), (bf16*)(ws + WS_KB), (bf16*)(ws + WS_VB), (bf16*)(ws + WS_IQL), (float*)(ws + WS_IKW), 0, L1_I8 ? 1.0f : 1.0f / WINB_SCALE}, rope, L1_I8 ? (const float*)(ws + WS_SROW) : nullptr, L1_I8 ? (const float*)(ws + WS_SCOL_INB) : nullptr};
          pg8::gemm_phase<pg8::EpiHead<TileINB>, pg8::StaticOrder, true, true, (L1_I8 ? 2 : 1)>(F.lds + RING_OFF, g, S, E); }
        { pg8::Gemm g{XN, (const bf16*)(ws + WS_W_INB2), M, B_IN_PAD - B_QKV, (IDXG_I8 && !L1_I8) ? DM / 2 : DM}; pg8::StaticOrder S; S.init(M, B_IN_PAD - B_QKV, F.G, (int)blockIdx.x);
          pg8::EpiHead<TileINB> E{TileINB{(bf16*)(ws + WS_QB), (bf16*)(ws + WS_KB), (bf16*)(ws + WS_VB), (bf16*)(ws + WS_IQL), (float*)(ws + WS_IKW), 24, 1.0f}, rope, (IDXG_I8 && !L1_I8) ? (const float*)(ws + WS_SROW) : nullptr, (IDXG_I8 && !L1_I8) ? (const float*)(ws + WS_SCOL_INB2) : nullptr};
          pg8::gemm_phase<pg8::EpiHead<TileINB>, pg8::StaticOrder, true, true, ((IDXG_I8 && !L1_I8) ? 2 : 0)>(F.lds + RING_OFF, g, S, E); }
#if P9_FILL
        if (LATE_CONV) { const int nb2 = (M / 256) * ((B_IN_PAD - B_QKV) / 256) - F.G, first_idle = (nb2 > 0 && nb2 < F.G) ? nb2 : 0;
            if ((int)blockIdx.x >= first_idle) { LAS float* scr_ = (LAS float*)(F.lds + RING_OFF + F.wave * 16384); const int NCW = (F.G - first_idle) * NWAVES; int li = ((int)blockIdx.x - first_idle) * NWAVES + F.wave;
                for (; li + 3 * NCW < LATE_P9; li += 4 * NCW) late_conv_batch<4>(F, args, scr_, li, NCW);
#pragma unroll 1
                for (; li < LATE_P9; li += NCW) late_conv_item(F, args, scr_, li); } }
#endif
        } if (REP(9) == 2) { { pg8::Gemm g{(const bf16*)(ws + WS_XN8), (const bf16*)(ws + WS_W_INB), M, B_QKV, DM / 2}; pg8::StaticOrder S; S.init(M, B_QKV, F.G, (int)blockIdx.x);
          pg8::EpiHead<TileINB> E{TileINB{(bf16*)(ws + WS_QB), (bf16*)(ws + WS_KB), (bf16*)(ws + WS_VB), (bf16*)(ws + WS_IQL), (float*)(ws + WS_IKW), 0, L1_I8 ? 1.0f : 1.0f / WINB_SCALE}, rope, L1_I8 ? (const float*)(ws + WS_SROW) : nullptr, L1_I8 ? (const float*)(ws + WS_SCOL_INB) : nullptr};
          pg8::gemm_phase<pg8::EpiHead<TileINB>, pg8::StaticOrder, true, true, (L1_I8 ? 2 : 1)>(F.lds + RING_OFF, g, S, E); }
        { pg8::Gemm g{XN, (const bf16*)(ws + WS_W_INB2), M, B_IN_PAD - B_QKV, (IDXG_I8 && !L1_I8) ? DM / 2 : DM}; pg8::StaticOrder S; S.init(M, B_IN_PAD - B_QKV, F.G, (int)blockIdx.x);
          pg8::EpiHead<TileINB> E{TileINB{(bf16*)(ws + WS_QB), (bf16*)(ws + WS_KB), (bf16*)(ws + WS_VB), (bf16*)(ws + WS_IQL), (float*)(ws + WS_IKW), 24, 1.0f}, rope, (IDXG_I8 && !L1_I8) ? (const float*)(ws + WS_SROW) : nullptr, (IDXG_I8 && !L1_I8) ? (const float*)(ws + WS_SCOL_INB2) : nullptr};
          pg8::gemm_phase<pg8::EpiHead<TileINB>, pg8::StaticOrder, true, true, ((IDXG_I8 && !L1_I8) ? 2 : 0)>(F.lds + RING_OFF, g, S, E); } } } SEAM(9);
    if (IN(10)) { { idx_prep_phase(F, args); } if (REP(10) == 2) { idx_prep_phase(F, args); } } SEAM(10);
    if (IN(11)) { { pg8::Gemm g{(const bf16*)(ws + WS_IQLN), (const bf16*)(ws + WS_W_IDX), M, 4096, IDXG_I8 ? IDX_RANK / 2 : IDX_RANK}; pg8::StaticOrder S; S.init(M, 4096, F.G, (int)blockIdx.x, WGM_K1K);
        pg8::EpiHead<TileIQ> E{TileIQ{(bf16*)(ws + WS_IQ)}, rope, IDXG_I8 ? (const float*)(ws + WS_SROW_IQ) : nullptr, IDXG_I8 ? (const float*)(ws + WS_SCOL_IDX) : nullptr};
        pg8::gemm_phase<pg8::EpiHead<TileIQ>, pg8::StaticOrder, true, true, (IDXG_I8 ? 2 : 0)>(F.lds + RING_OFF, g, S, E); } if (REP(11) == 2) { pg8::Gemm g{(const bf16*)(ws + WS_IQLN), (const bf16*)(ws + WS_W_IDX), M, 4096, IDXG_I8 ? IDX_RANK / 2 : IDX_RANK}; pg8::StaticOrder S; S.init(M, 4096, F.G, (int)blockIdx.x, WGM_K1K);
        pg8::EpiHead<TileIQ> E{TileIQ{(bf16*)(ws + WS_IQ)}, rope, IDXG_I8 ? (const float*)(ws + WS_SROW_IQ) : nullptr, IDXG_I8 ? (const float*)(ws + WS_SCOL_IDX) : nullptr};
        pg8::gemm_phase<pg8::EpiHead<TileIQ>, pg8::StaticOrder, true, true, (IDXG_I8 ? 2 : 0)>(F.lds + RING_OFF, g, S, E); } } SEAM(11);
    if (IN(12)) { { if (IDX_I8) idx_score_phase_i8(F); else if (IDX_F8) idx_score_phase_f8(F); else idx_score_phase(F); } if (REP(12) == 2) { if (IDX_I8) idx_score_phase_i8(F); else if (IDX_F8) idx_score_phase_f8(F); else idx_score_phase(F); } } SEAM(12);
    if (IN(13)) { { topk_phase(F, args); } if (REP(13) == 2) { topk_phase(F, args); } } SEAM(13);
    if (IN(14)) { { sparse_attn_phase(F, args); } if (REP(14) == 2) { sparse_attn_phase(F, args); } } SEAM(14);
    if (IN(15)) { { pg8::Gemm g{(const bf16*)(ws + WS_OB), (const bf16*)(ws + WS_W_OUTB), M, DM, 4096 / 2}; pg8::StaticOrder S; S.init(M, DM, F.G, (int)blockIdx.x);
        pg8::EpiBf16<0> E{MIX, DM, 1.0f / (OB_SCALE * WOUTB_SCALE), nullptr, nullptr};
        pg8::gemm_phase<pg8::EpiBf16<0>, pg8::StaticOrder, true, true, true>(F.lds + RING_OFF, g, S, E); } if (REP(15) == 2) { pg8::Gemm g{(const bf16*)(ws + WS_OB), (const bf16*)(ws + WS_W_OUTB), M, DM, 4096 / 2}; pg8::StaticOrder S; S.init(M, DM, F.G, (int)blockIdx.x);
        pg8::EpiBf16<0> E{MIX, DM, 1.0f / (OB_SCALE * WOUTB_SCALE), nullptr, nullptr};
        pg8::gemm_phase<pg8::EpiBf16<0>, pg8::StaticOrder, true, true, true>(F.lds + RING_OFF, g, S, E); } } SEAM(15);
    if (IN(16)) { { thin_resid<(L1_I8 ? 3 : 1), true, true>(F, MIX, HB, g_attn_post + DM, HB, g_mlp_pre + DM, XN, (unsigned char*)XN, (float*)(ws + WS_SROW)); } if (REP(16) == 2) { thin_resid<(L1_I8 ? 3 : 1), true, true>(F, MIX, HB, g_attn_post + DM, HB, g_mlp_pre + DM, XN, (unsigned char*)XN, (float*)(ws + WS_SROW)); } } SEAM(16);
    if (IN(17)) { { pg8::Gemm g{XN, (const bf16*)(ws + WS_W_UP1), M, DFF, DM / 2}; pg8::StaticOrder S; S.init(M, DFF, F.G, (int)blockIdx.x);
        pg8::EpiSqReluF8 E{HID, DFF, L1_I8 ? 1.0f : 1.0f / WUP_SCALE, HID_SCALE, L1_I8 ? (const float*)(ws + WS_SROW) : nullptr, L1_I8 ? (const float*)(ws + WS_SCOL_UP1) : nullptr};
        pg8::gemm_phase<pg8::EpiSqReluF8, pg8::StaticOrder, true, true, (L1_I8 ? 2 : 1)>(F.lds + RING_OFF, g, S, E); } if (REP(17) == 2) { pg8::Gemm g{XN, (const bf16*)(ws + WS_W_UP1), M, DFF, DM / 2}; pg8::StaticOrder S; S.init(M, DFF, F.G, (int)blockIdx.x);
        pg8::EpiSqReluF8 E{HID, DFF, L1_I8 ? 1.0f : 1.0f / WUP_SCALE, HID_SCALE, L1_I8 ? (const float*)(ws + WS_SROW) : nullptr, L1_I8 ? (const float*)(ws + WS_SCOL_UP1) : nullptr};
        pg8::gemm_phase<pg8::EpiSqReluF8, pg8::StaticOrder, true, true, (L1_I8 ? 2 : 1)>(F.lds + RING_OFF, g, S, E); } } SEAM(17);
    if (IN(18)) { { pg8::Gemm g{(const bf16*)HID, (const bf16*)(ws + WS_W_DOWN1), M, DM, DFF / 2}; pg8::StaticOrder S; S.init(M, DM, F.G, (int)blockIdx.x, WGM_K16K);
        pg8::EpiBf16<0> E{MIX, DM, 1.0f / (HID_SCALE * WDOWN_SCALE), nullptr, nullptr};
        pg8::gemm_phase<pg8::EpiBf16<0>, pg8::StaticOrder, true, true, true>(F.lds + RING_OFF, g, S, E); } if (REP(18) == 2) { pg8::Gemm g{(const bf16*)HID, (const bf16*)(ws + WS_W_DOWN1), M, DM, DFF / 2}; pg8::StaticOrder S; S.init(M, DM, F.G, (int)blockIdx.x, WGM_K16K);
        pg8::EpiBf16<0> E{MIX, DM, 1.0f / (HID_SCALE * WDOWN_SCALE), nullptr, nullptr};
        pg8::gemm_phase<pg8::EpiBf16<0>, pg8::StaticOrder, true, true, true>(F.lds + RING_OFF, g, S, E); } } SEAM(18);
    if (IN(19)) { { thin_resid<0, true, false>(F, MIX, HB, g_mlp_post + DM, out, nullptr, nullptr, nullptr); } if (REP(19) == 2) { thin_resid<0, true, false>(F, MIX, HB, g_mlp_post + DM, out, nullptr, nullptr, nullptr); } }
#undef IN
#undef SEAM
}

extern "C" void kernel_launch(void* const* d_in, const int* in_sizes, int n_in, void* d_out, int out_size, void* d_ws, size_t ws_size, hipStream_t stream) {
    static int grid = 0;
    if (grid == 0) {
        if (n_in != 16 || in_sizes[0] != M * DM || out_size != M * DM || ws_size < WS_END) { fprintf(stderr, "kernel_launch: unexpected shapes (n_in %d, in0 %d, out %d, ws %zu)\n", n_in, n_in > 0 ? in_sizes[0] : -1, out_size, ws_size); grid = -1; return; }
        int dev = 0, cus = 0, per_cu = 0;
        if (hipGetDevice(&dev) != hipSuccess || hipDeviceGetAttribute(&cus, hipDeviceAttributeMultiprocessorCount, dev) != hipSuccess) { grid = -1; return; }
        if (hipFuncSetAttribute((const void*)fwd, hipFuncAttributeMaxDynamicSharedMemorySize, LDS_BYTES) != hipSuccess) { fprintf(stderr, "kernel_launch: hipFuncSetAttribute failed\n"); grid = -1; return; }
        if (hipOccupancyMaxActiveBlocksPerMultiprocessor(&per_cu, (const void*)fwd, NWAVES * 64, LDS_BYTES) != hipSuccess || per_cu < 1) fprintf(stderr, "kernel_launch: occupancy query reports %d\n", per_cu);
        (void)hipGetLastError();
        grid = cus;
    }
    if (grid < 0) return;
    if (hipMemsetAsync((char*)d_ws + WS_CTL, 0, CTL_ZERO_BYTES, stream) != hipSuccess) return;
    Args a{};
    for (int i = 0; i < 16; ++i) a.in[i] = d_in[i];
    a.out = (float*)d_out; a.ws = (unsigned char*)d_ws; a.pad = 0;
#if MK_PER_PHASE
#ifndef LAST_PHASE
#define LAST_PHASE N_PHASES
#endif
    for (int li = 0; li < LAST_PHASE; ++li) { a.ph_lo = li; a.ph_hi = li + 1; a.li = li;
        hipLaunchKernelGGL(fwd, dim3(grid), dim3(NWAVES * 64), LDS_BYTES, stream, a); }
#else
    a.ph_lo = 0; a.ph_hi = N_PHASES; a.li = 0;
    hipLaunchKernelGGL(fwd, dim3(grid), dim3(NWAVES * 64), LDS_BYTES, stream, a);
#endif
}
```
